# Optimizing an MI355X kernel written in HIP

```python
import jax, jax.numpy as jnp
from jax import lax
import numpy as np

D_MODEL = 2048
BATCH = 4
SEQ = 2048
DEPTH = 2
DEC_BATCH = 32
DEC_SEQ = 64
PAST_LEN = 2048

CHUNK = 64
Q_BLOCK = 128
SB_HEAD_DIM = 128
SB_HEADS = D_MODEL // 256
SB_WIDTH = SB_HEADS * SB_HEAD_DIM
SGU_GROUP_DIM = 128
SGU_GROUPS = D_MODEL // 256
SGU_WIDTH = SGU_GROUPS * SGU_GROUP_DIM
SGU_LEN = 128
D_FF = -(-8 * D_MODEL // (3 * 256)) * 256
IN_COLS = 3 * SB_WIDTH + 2 * SGU_WIDTH + 2 * D_MODEL
EPS = 1e-6

kernel_name = "stickbreak_sgu_hybrid_stream_step"


def rmsnorm(x, g):
    x32 = x.astype(jnp.float32)
    y = x32 * lax.rsqrt(jnp.mean(x32 * x32, axis=-1, keepdims=True) + EPS)
    return (y * g.astype(jnp.float32)).astype(x.dtype)


def stick_breaking_block(q_blk, q_pos, k, v, k_pos):
    z = jnp.einsum('bqhd,bkhd->bhqk', q_blk.astype(jnp.float32), k.astype(jnp.float32)) * (SB_HEAD_DIM ** -0.5)
    mask = k_pos[None, :] < q_pos[:, None]
    log_beta = jax.nn.log_sigmoid(z)
    log_stay = jnp.where(mask, jax.nn.log_sigmoid(-z), 0.0)
    log_rest = lax.cumsum(log_stay, axis=3, reverse=True) - log_stay
    w = jnp.where(mask, jnp.exp(log_beta + log_rest), 0.0)
    o = jnp.einsum('bhqk,bkhd->bqhd', w, v.astype(jnp.float32))
    return o.astype(q_blk.dtype)


def stick_breaking_prompt(q, k, v):
    B, S = q.shape[0], q.shape[1]
    nb = S // Q_BLOCK
    pos = jnp.arange(S)
    qb = q.reshape(B, nb, Q_BLOCK, SB_HEADS, SB_HEAD_DIM).transpose(1, 0, 2, 3, 4)
    pb = pos.reshape(nb, Q_BLOCK)
    out = lax.map(lambda a: stick_breaking_block(a[0], a[1], k, v, pos), (qb, pb))
    return out.transpose(1, 0, 2, 3, 4).reshape(B, S, SB_HEADS, SB_HEAD_DIM)


def stick_breaking_sample(q, k_new, v_new, cache_k_l, cache_v_l):
    past = cache_k_l.shape[1]
    t = q.shape[1]
    k = jnp.concatenate([cache_k_l, k_new], axis=1)
    v = jnp.concatenate([cache_v_l, v_new], axis=1)
    return stick_breaking_block(q, past + jnp.arange(t), k, v, jnp.arange(past + t))


def spatial_gate(u, vn, w_s, b_s):
    B, T = vn.shape[0], vn.shape[1]
    L = min(T, SGU_LEN)
    nb = T // L
    c = jnp.arange(L) // CHUNK
    mask = c[None, :] <= c[:, None]
    w = jnp.where(mask, w_s[:, :L, :L], 0.0)
    vg = vn.reshape(B, nb, L, SGU_GROUPS, SGU_GROUP_DIM)
    s = jnp.einsum('gts,bnsgc->bntgc', w, vg) + b_s[:, :L].T[None, None, :, :, None]
    return u * s.reshape(B, T, SGU_WIDTH)


def layer(x, l, cache_k, cache_v, norm_mix, w_in, b_gate, sgu_norm, w_spatial, b_spatial,
          w_branch_a, w_branch_b, w_out, norm_ffn, w_gate_up, w_down):
    B, T = x.shape[0], x.shape[1]
    xn = rmsnorm(x, norm_mix[l])
    proj = xn @ w_in[l]
    q, k, v, u, vs, g = jnp.split(proj, [SB_WIDTH, 2 * SB_WIDTH, 3 * SB_WIDTH,
                                         3 * SB_WIDTH + SGU_WIDTH, 3 * SB_WIDTH + 2 * SGU_WIDTH], axis=-1)
    q = q.reshape(B, T, SB_HEADS, SB_HEAD_DIM)
    k = k.reshape(B, T, SB_HEADS, SB_HEAD_DIM)
    v = v.reshape(B, T, SB_HEADS, SB_HEAD_DIM)
    if cache_k is None:
        a = stick_breaking_prompt(q, k, v)
    else:
        a = stick_breaking_sample(q, k, v, cache_k[l], cache_v[l])
    a = a.reshape(B, T, SB_WIDTH)
    u = jax.nn.gelu(u)
    vs = rmsnorm(jax.nn.gelu(vs), sgu_norm[l])
    bb = spatial_gate(u, vs, w_spatial[l], b_spatial[l])
    gates = jax.nn.sigmoid(g + b_gate[l])
    g_a, g_b = gates[..., :D_MODEL], gates[..., D_MODEL:]
    merged = g_a * (a @ w_branch_a[l]) + g_b * (bb @ w_branch_b[l])
    h = x + merged @ w_out[l]
    hn = rmsnorm(h, norm_ffn[l])
    gu = hn @ w_gate_up[l]
    h = h + (jax.nn.silu(gu[..., :D_FF]) * gu[..., D_FF:]) @ w_down[l]
    return h, k, v, vs


def trunk(x, cache_k, cache_v, norm_mix, w_in, b_gate, sgu_norm, w_spatial, b_spatial,
          w_branch_a, w_branch_b, w_out, norm_ffn, w_gate_up, w_down, norm_final):
    ks, vs_list, svs = [], [], []
    for l in range(DEPTH):
        x, k, v, sv = layer(x, l, cache_k, cache_v, norm_mix, w_in, b_gate, sgu_norm, w_spatial,
                            b_spatial, w_branch_a, w_branch_b, w_out, norm_ffn, w_gate_up, w_down)
        ks.append(k)
        vs_list.append(v)
        svs.append(sv)
    return rmsnorm(x, norm_final), jnp.stack(ks), jnp.stack(vs_list), jnp.stack(svs)


def setup_inputs(seed: int = 0) -> dict:
    key = jax.random.key(seed)
    ks = jax.random.split(key, 20)
    f32 = jnp.float32
    n = lambda k, shape, s: (jax.random.normal(k, shape, f32) * s)
    return {
        "x_prompt": n(ks[0], (BATCH, SEQ, D_MODEL), 1.0),
        "x_sample": n(ks[1], (DEC_BATCH, DEC_SEQ, D_MODEL), 1.0),
        "cache_k": n(ks[2], (DEPTH, DEC_BATCH, PAST_LEN, SB_HEADS, SB_HEAD_DIM), 1.0),
        "cache_v": n(ks[3], (DEPTH, DEC_BATCH, PAST_LEN, SB_HEADS, SB_HEAD_DIM), 1.0),
        "norm_mix": 1.0 + n(ks[4], (DEPTH, D_MODEL), 0.02),
        "w_in": n(ks[5], (DEPTH, D_MODEL, IN_COLS), D_MODEL ** -0.5),
        "b_gate": n(ks[6], (DEPTH, 2 * D_MODEL), 0.02),
        "sgu_norm": 1.0 + n(ks[7], (DEPTH, SGU_WIDTH), 0.02),
        "w_spatial": n(ks[8], (DEPTH, SGU_GROUPS, SGU_LEN, SGU_LEN), SGU_LEN ** -0.5),
        "b_spatial": 1.0 + n(ks[9], (DEPTH, SGU_GROUPS, SGU_LEN), 0.1),
        "w_branch_a": n(ks[10], (DEPTH, SB_WIDTH, D_MODEL), SB_WIDTH ** -0.5),
        "w_branch_b": n(ks[11], (DEPTH, SGU_WIDTH, D_MODEL), SGU_WIDTH ** -0.5),
        "w_out": n(ks[12], (DEPTH, D_MODEL, D_MODEL), D_MODEL ** -0.5),
        "norm_ffn": 1.0 + n(ks[13], (DEPTH, D_MODEL), 0.02),
        "w_gate_up": n(ks[14], (DEPTH, D_MODEL, 2 * D_FF), D_MODEL ** -0.5),
        "w_down": n(ks[15], (DEPTH, D_FF, D_MODEL), D_FF ** -0.5),
        "norm_final": 1.0 + n(ks[16], (D_MODEL,), 0.02),
    }


def reference(x_prompt, x_sample, cache_k, cache_v, norm_mix, w_in, b_gate, sgu_norm, w_spatial,
              b_spatial, w_branch_a, w_branch_b, w_out, norm_ffn, w_gate_up, w_down, norm_final):
    y_prompt, k_prompt, v_prompt, _ = trunk(
        x_prompt, None, None, norm_mix, w_in, b_gate, sgu_norm, w_spatial, b_spatial,
        w_branch_a, w_branch_b, w_out, norm_ffn, w_gate_up, w_down, norm_final)
    y_sample, k_sample, v_sample, sgu_v_sample = trunk(
        x_sample, cache_k, cache_v, norm_mix, w_in, b_gate, sgu_norm, w_spatial, b_spatial,
        w_branch_a, w_branch_b, w_out, norm_ffn, w_gate_up, w_down, norm_final)
    return (y_prompt, y_sample, k_prompt, v_prompt, k_sample, v_sample, sgu_v_sample)
```

```cpp
#include <hip/hip_runtime.h>
#include <cstdio>
#include <cstdint>
namespace slow {
constexpr int M = 10240, MP = 8192, MS = 2048, DM = 2048, NIN = 9216, FF = 5632, SBW = 1024;
constexpr float EPS = 1e-6f;

__global__ __launch_bounds__(256) void sgemm(const float* __restrict__ A, int lda, const float* __restrict__ B, int ldb, float* __restrict__ C, int ldc, int K) {
    __shared__ __attribute__((aligned(16))) float As[16][68];
    __shared__ __attribute__((aligned(16))) float Bs[16][68];
    const int tid = threadIdx.x, tx = tid & 15, ty = tid >> 4;
    const int m0 = blockIdx.y * 64, n0 = blockIdx.x * 64;
    float acc[4][4];
#pragma unroll
    for (int i = 0; i < 4; ++i)
#pragma unroll
        for (int j = 0; j < 4; ++j) acc[i][j] = 0.f;
    for (int k0 = 0; k0 < K; k0 += 16) {
#pragma unroll
        for (int i = 0; i < 4; ++i) { const int e = tid + 256 * i; const int m = e >> 4, k = e & 15; As[k][m] = A[(size_t)(m0 + m) * lda + k0 + k]; }
#pragma unroll
        for (int i = 0; i < 4; ++i) { const int e = tid + 256 * i; const int k = e >> 6, n = e & 63; Bs[k][n] = B[(size_t)(k0 + k) * ldb + n0 + n]; }
        __syncthreads();
#pragma unroll
        for (int k = 0; k < 16; ++k) {
            const float4 a = *(const float4*)&As[k][ty * 4];
            const float4 b = *(const float4*)&Bs[k][tx * 4];
            const float av[4] = {a.x, a.y, a.z, a.w}, bv[4] = {b.x, b.y, b.z, b.w};
#pragma unroll
            for (int i = 0; i < 4; ++i)
#pragma unroll
                for (int j = 0; j < 4; ++j) acc[i][j] = fmaf(av[i], bv[j], acc[i][j]);
        }
        __syncthreads();
    }
#pragma unroll
    for (int i = 0; i < 4; ++i) { float4 o = {acc[i][0], acc[i][1], acc[i][2], acc[i][3]}; *(float4*)&C[(size_t)(m0 + ty * 4 + i) * ldc + n0 + tx * 4] = o; }
}
__device__ __forceinline__ float wsum(float v) {
#pragma unroll
    for (int o = 1; o < 64; o <<= 1) v += __shfl_xor(v, o);
    return v;
}
__device__ __forceinline__ float gelu_tanh(float x) { const float u = 0.7978845608028654f * (x + 0.044715f * x * x * x); return 0.5f * x * (1.f + tanhf(u)); }
__device__ __forceinline__ float sigmoidf(float x) { return 1.f / (1.f + expf(-x)); }
__global__ __launch_bounds__(256) void rmsnorm_rows(const float* __restrict__ in, int ldi, const float* __restrict__ g, float* __restrict__ out, int ldo, int D, int rows) {
    const int row = blockIdx.x * 4 + (threadIdx.x >> 6), lane = threadIdx.x & 63; if (row >= rows) return;
    const float* p = in + (size_t)row * ldi; float s = 0.f;
    for (int c = lane; c < D; c += 64) { const float v = p[c]; s += v * v; }
    s = wsum(s); const float r = rsqrtf(s / (float)D + EPS);
    float* o = out + (size_t)row * ldo;
    for (int c = lane; c < D; c += 64) o[c] = p[c] * r * g[c];
}
__global__ void copy_x(const float* __restrict__ xp, const float* __restrict__ xs, float* __restrict__ H) {
    const size_t n = (size_t)M * DM, np = (size_t)MP * DM;
    for (size_t i = (size_t)blockIdx.x * blockDim.x + threadIdx.x; i < n; i += (size_t)gridDim.x * blockDim.x) H[i] = i < np ? xp[i] : xs[i - np];
}
__global__ void post_proj(float* __restrict__ proj, float* __restrict__ out, int l) {
    const size_t n = (size_t)M * 4096;
    for (size_t i = (size_t)blockIdx.x * blockDim.x + threadIdx.x; i < n; i += (size_t)gridDim.x * blockDim.x) {
        const int row = (int)(i / 4096), c = (int)(i % 4096) + 1024; float* p = proj + (size_t)row * NIN + c; const float v = *p;
        if (c < 3072) { const int isv = c >= 2048; const int cc = c - (isv ? 2048 : 1024);
            if (row < MP) out[(isv ? 37748736u : 20971520u) + ((size_t)l * MP + row) * 1024 + cc] = v;
            else out[(isv ? 58720256u : 54525952u) + ((size_t)l * MS + (row - MP)) * 1024 + cc] = v;
        } else *p = gelu_tanh(v);
    }
}
__global__ void copy_sgu_out(const float* __restrict__ vn, float* __restrict__ out, int l) {
    const size_t n = (size_t)MS * 1024;
    for (size_t i = (size_t)blockIdx.x * blockDim.x + threadIdx.x; i < n; i += (size_t)gridDim.x * blockDim.x) out[62914560u + (size_t)l * n + i] = vn[(size_t)MP * 1024 + i];
}
__global__ __launch_bounds__(256) void attn_naive(const float* __restrict__ proj, const float* __restrict__ ck, const float* __restrict__ cv, float* __restrict__ att) {
    __shared__ float qs[4][128];
    const int w = threadIdx.x >> 6, lane = threadIdx.x & 63;
    const int gid = blockIdx.x * 4 + w; const int row = gid >> 3, h = gid & 7;
    const bool samp = row >= MP; const int b = samp ? (row - MP) / 64 : row / 2048, t = samp ? (row - MP) % 64 : row % 2048;
    const int nk = samp ? 2048 + t : t;
    const float* q = proj + (size_t)row * NIN + h * 128; qs[w][lane] = q[lane]; qs[w][lane + 64] = q[lane + 64];
    __syncthreads();
    float o0 = 0.f, o1 = 0.f, carry = 0.f;
    for (int hi = nk; hi > 0; hi -= 64) {
        const int key = hi - 1 - lane; const bool valid = key >= 0;
        const float* kp; const float* vp;
        { const int kk = valid ? key : 0;
          if (samp) { if (kk < 2048) { kp = ck + (((size_t)b * 2048 + kk) * 8 + h) * 128; vp = cv + (((size_t)b * 2048 + kk) * 8 + h) * 128; }
                      else { kp = proj + (size_t)(MP + b * 64 + kk - 2048) * NIN + 1024 + h * 128; vp = kp + 1024; } }
          else { kp = proj + (size_t)(b * 2048 + kk) * NIN + 1024 + h * 128; vp = kp + 1024; } }
        float z = 0.f;
        for (int d = 0; d < 128; d += 4) { const float4 kv = *(const float4*)(kp + d); z += qs[w][d] * kv.x + qs[w][d + 1] * kv.y + qs[w][d + 2] * kv.z + qs[w][d + 3] * kv.w; }
        z *= 0.08838834764831845f;
        const float lb = fminf(z, 0.f) - log1pf(expf(-fabsf(z)));
        const float ls = valid ? lb - z : 0.f;
        float incl = ls;
#pragma unroll
        for (int o = 1; o < 64; o <<= 1) { const float tt = __shfl_up(incl, o); if (lane >= o) incl += tt; }
        const float rest = carry + incl - ls;
        const float wgt = valid ? expf(lb + rest) : 0.f;
        carry += __shfl(incl, 63);
        for (int j = 0; j < 64; ++j) { const float wj = __shfl(wgt, j); const unsigned long long pv = __shfl((unsigned long long)(uintptr_t)vp, j);
            if (hi - 1 - j >= 0) { const float2 vv = *(const float2*)((const float*)(uintptr_t)pv + 2 * lane); o0 += wj * vv.x; o1 += wj * vv.y; } }
    }
    float* op = att + (size_t)row * SBW + h * 128 + 2 * lane; op[0] = o0; op[1] = o1;
}
__global__ void sgu_naive(const float* __restrict__ proj, const float* __restrict__ vn, const float* __restrict__ wsp, const float* __restrict__ bsp, float* __restrict__ bb) {
    const size_t n = (size_t)M * 1024;
    for (size_t i = (size_t)blockIdx.x * blockDim.x + threadIdx.x; i < n; i += (size_t)gridDim.x * blockDim.x) {
        const int row = (int)(i >> 10), c = (int)(i & 1023), g = c >> 7;
        const bool samp = row >= MP; const int L = samp ? 64 : 128; const int t = samp ? (row - MP) % 64 : row % 128; const int r0 = row - t;
        float s = 0.f;
        for (int sp = 0; sp < L; ++sp) if ((sp >> 6) <= (t >> 6)) s += wsp[((size_t)g * 128 + t) * 128 + sp] * vn[(size_t)(r0 + sp) * 1024 + c];
        s += bsp[g * 128 + t];
        bb[i] = proj[(size_t)row * NIN + 3072 + c] * s;
    }
}
__global__ void merge_gates(const float* __restrict__ proj, const float* __restrict__ bg, const float* __restrict__ pa, const float* __restrict__ pb, float* __restrict__ mg) {
    const size_t n = (size_t)M * DM;
    for (size_t i = (size_t)blockIdx.x * blockDim.x + threadIdx.x; i < n; i += (size_t)gridDim.x * blockDim.x) {
        const int row = (int)(i >> 11), c = (int)(i & 2047); const float* g = proj + (size_t)row * NIN + 5120;
        mg[i] = sigmoidf(g[c] + bg[c]) * pa[i] + sigmoidf(g[2048 + c] + bg[2048 + c]) * pb[i];
    }
}
__global__ void add_inplace(float* __restrict__ h, const float* __restrict__ t, size_t n) {
    for (size_t i = (size_t)blockIdx.x * blockDim.x + threadIdx.x; i < n; i += (size_t)gridDim.x * blockDim.x) h[i] += t[i];
}
__global__ void swiglu(const float* __restrict__ gu, float* __restrict__ act) {
    const size_t n = (size_t)M * FF;
    for (size_t i = (size_t)blockIdx.x * blockDim.x + threadIdx.x; i < n; i += (size_t)gridDim.x * blockDim.x) {
        const size_t row = i / FF, c = i % FF; const float g = gu[row * 2 * FF + c], u = gu[row * 2 * FF + FF + c]; act[i] = g * sigmoidf(g) * u; }
}
constexpr size_t MiB = 1u << 20;
constexpr size_t O_H = 0, O_XN = 84 * MiB, O_BIG = 168 * MiB  , O_ATT = 608 * MiB, O_BB = 648 * MiB, O_VN = 688 * MiB, O_PA = 728 * MiB, O_PB = 808 * MiB,
                 O_MG = 888 * MiB, O_T = 968 * MiB, O_ACT = 728 * MiB  , O_END = 1048 * MiB;
struct Bufs { float *H, *XN, *BIG, *ATT, *BB, *VN, *PA, *PB, *MG, *T, *ACT; };
static inline Bufs bufs(char* base) { Bufs b; b.H = (float*)(base + O_H); b.XN = (float*)(base + O_XN); b.BIG = (float*)(base + O_BIG); b.ATT = (float*)(base + O_ATT); b.BB = (float*)(base + O_BB);
    b.VN = (float*)(base + O_VN); b.PA = (float*)(base + O_PA); b.PB = (float*)(base + O_PB); b.MG = (float*)(base + O_MG); b.T = (float*)(base + O_T); b.ACT = (float*)(base + O_ACT); return b; }
struct In { const float *xp, *xs, *ck, *cv, *nmix, *win, *bgate, *sgun, *wsp, *bsp, *wa, *wb, *wout, *nffn, *wgu, *wd, *nfin; };
static inline void gemm(hipStream_t st, const float* A, int lda, const float* B, int ldb, float* C, int ldc, int Mm, int N, int K) {
    hipLaunchKernelGGL(sgemm, dim3(N / 64, Mm / 64), dim3(256), 0, st, A, lda, B, ldb, C, ldc, K); }
static inline void stage_init(hipStream_t st, const In& I, const Bufs& B) { hipLaunchKernelGGL(copy_x, dim3(2048), dim3(256), 0, st, I.xp, I.xs, B.H); }
static inline void stage_proj(hipStream_t st, const In& I, const Bufs& B, float* out, int l) {
    hipLaunchKernelGGL(rmsnorm_rows, dim3(M / 4), dim3(256), 0, st, (const float*)B.H, DM, I.nmix + (size_t)l * DM, B.XN, DM, DM, M);
    gemm(st, B.XN, DM, I.win + (size_t)l * DM * NIN, NIN, B.BIG, NIN, M, NIN, DM);
    hipLaunchKernelGGL(post_proj, dim3(4096), dim3(256), 0, st, B.BIG, out, l);
    hipLaunchKernelGGL(rmsnorm_rows, dim3(M / 4), dim3(256), 0, st, (const float*)(B.BIG + 4096), NIN, I.sgun + (size_t)l * 1024, B.VN, 1024, 1024, M);
    hipLaunchKernelGGL(copy_sgu_out, dim3(1024), dim3(256), 0, st, (const float*)B.VN, out, l);
}
static inline void stage_mix(hipStream_t st, const In& I, const Bufs& B, int l) {
    const size_t co = (size_t)l * 32 * 2048 * 1024;
    hipLaunchKernelGGL(attn_naive, dim3(M * 8 / 4), dim3(256), 0, st, (const float*)B.BIG, I.ck + co, I.cv + co, B.ATT);
    hipLaunchKernelGGL(sgu_naive, dim3(4096), dim3(256), 0, st, (const float*)B.BIG, (const float*)B.VN, I.wsp + (size_t)l * 8 * 128 * 128, I.bsp + (size_t)l * 8 * 128, B.BB);
}
static inline void stage_merge(hipStream_t st, const In& I, const Bufs& B, int l) {
    gemm(st, B.ATT, 1024, I.wa + (size_t)l * 1024 * DM, DM, B.PA, DM, M, DM, 1024);
    gemm(st, B.BB, 1024, I.wb + (size_t)l * 1024 * DM, DM, B.PB, DM, M, DM, 1024);
    hipLaunchKernelGGL(merge_gates, dim3(4096), dim3(256), 0, st, (const float*)B.BIG, I.bgate + (size_t)l * 4096, (const float*)B.PA, (const float*)B.PB, B.MG);
}
static inline void stage_out(hipStream_t st, const In& I, const Bufs& B, int l) {
    gemm(st, B.MG, DM, I.wout + (size_t)l * DM * DM, DM, B.T, DM, M, DM, DM);
    hipLaunchKernelGGL(add_inplace, dim3(4096), dim3(256), 0, st, B.H, (const float*)B.T, (size_t)M * DM);
}
static inline void stage_up(hipStream_t st, const In& I, const Bufs& B, int l) {
    hipLaunchKernelGGL(rmsnorm_rows, dim3(M / 4), dim3(256), 0, st, (const float*)B.H, DM, I.nffn + (size_t)l * DM, B.XN, DM, DM, M);
    gemm(st, B.XN, DM, I.wgu + (size_t)l * DM * 2 * FF, 2 * FF, B.BIG, 2 * FF, M, 2 * FF, DM);
    hipLaunchKernelGGL(swiglu, dim3(4096), dim3(256), 0, st, (const float*)B.BIG, B.ACT);
}
static inline void stage_down(hipStream_t st, const In& I, const Bufs& B, int l) {
    gemm(st, B.ACT, FF, I.wd + (size_t)l * FF * DM, DM, B.T, DM, M, DM, FF);
    hipLaunchKernelGGL(add_inplace, dim3(4096), dim3(256), 0, st, B.H, (const float*)B.T, (size_t)M * DM);
}
static inline void stage_final(hipStream_t st, const In& I, const Bufs& B, float* out) {
    hipLaunchKernelGGL(rmsnorm_rows, dim3(M / 4), dim3(256), 0, st, (const float*)B.H, DM, I.nfin, out, DM, DM, M);
}
static inline void forward(hipStream_t st, const In& I, char* base, float* out) {
    const Bufs B = bufs(base); stage_init(st, I, B);
    for (int l = 0; l < 2; ++l) { stage_proj(st, I, B, out, l); stage_mix(st, I, B, l); stage_merge(st, I, B, l); stage_out(st, I, B, l); stage_up(st, I, B, l); stage_down(st, I, B, l); }
    stage_final(st, I, B, out);
}
}
extern "C" void kernel_launch(void* const* d_in, const int* in_sizes, int n_in, void* d_out, int out_size, void* d_ws, size_t ws_size, hipStream_t stream) {
    slow::In I; const float* const* p = (const float* const*)d_in;
    I.xp = p[0]; I.xs = p[1]; I.ck = p[2]; I.cv = p[3]; I.nmix = p[4]; I.win = p[5]; I.bgate = p[6]; I.sgun = p[7]; I.wsp = p[8]; I.bsp = p[9];
    I.wa = p[10]; I.wb = p[11]; I.wout = p[12]; I.nffn = p[13]; I.wgu = p[14]; I.wd = p[15]; I.nfin = p[16];
    slow::forward(stream, I, (char*)d_ws, (float*)d_out);
}
```

```cpp
#include <hip/hip_runtime.h>
#include <cstdio>
#include <cstdint>
#ifndef MK_N_LAUNCHES
#define MK_N_LAUNCHES 1
#endif
namespace pg8 {
#define PG8_LAS __attribute__((address_space(3)))
typedef unsigned short bf16_t;
typedef short bf16x8 __attribute__((ext_vector_type(8)));
typedef float f32x4 __attribute__((ext_vector_type(4)));
typedef unsigned u32x4 __attribute__((ext_vector_type(4)));
constexpr int BM = 256, BK = 64, HALF = 128, HTB = HALF * BK * 2  , STAGE_BYTES = 8 * HTB, NXCD = 8, WGM = 8;

__host__ __device__ __forceinline__ int lds_byte(int r, int c) { const int st = (r >> 4) * 2 + (c >> 5), rr = r & 15, cc = c & 31, ob = rr * 64 + cc * 2; return st * 1024 + (ob ^ (((ob >> 9) & 1) << 5)); }
__host__ __device__ __forceinline__ void stage_rc(int b, int& R, int& C) { const int st = b / 1024, sb = b % 1024, swz = sb ^ (((sb >> 9) & 1) << 5); R = (st >> 1) * 16 + swz / 64; C = (st & 1) * 32 + (swz % 64) / 2; }
__host__ __device__ __forceinline__ int perm32(int rho) { const int n = rho >> 4, i = rho & 15; return 8 * (i >> 2) + 4 * n + (i & 3); }

struct Unit { int pm, pn, br; };
template <class Epi, class Sched, bool ALIGN_EPI = true, bool SP2 = true>
__device__ __forceinline__ void gemm_phase(PG8_LAS unsigned char* lds, const Sched& S, const Epi& E) {
    int tid_ = threadIdx.x; asm volatile("" : "+v"(tid_));
    const int tid = tid_, wid = __builtin_amdgcn_readfirstlane(tid >> 6), lane = tid & 63, wr = wid >> 2, wc = wid & 3, fr = lane & 15, fq = lane >> 4;
    const int K = S.K, nt = S.KT / BK;
    unsigned voffA[2], voffB[2];
#pragma unroll
    for (int i = 0; i < 2; ++i) { int R, C; stage_rc(tid * 16 + i * 8192, R, C); const int Rb = Epi::PERM ? ((R & ~31) + perm32(R & 31)) : R;
        voffA[i] = (unsigned)(R * K + C) * 2u; voffB[i] = (unsigned)(Rb * K + C) * 2u; }
    const size_t kstep = (size_t)(BK * 2);
    const size_t hstep = (size_t)HALF * K * 2;
        const unsigned ldsw = (unsigned)wid * 1024u;
    const int aoff = lds_byte(wr * 64 + fr, fq * 8), boff = lds_byte(wc * 32 + fr, fq * 8);
#define PG8_SA(b, h) (((b) * 2 + (h)) * HTB)
#define PG8_SB(b, h) ((4 + (b) * 2 + (h)) * HTB)
#define PG8_STAGE(bufoff, gbase, voff) do { _Pragma("unroll") for (int _i = 0; _i < 2; ++_i) \
        __builtin_amdgcn_global_load_lds((const unsigned*)((const char*)(gbase) + (voff)[_i]), (PG8_LAS unsigned*)(lds + (bufoff) + ldsw + _i * 8192), 16, 0, 0); } while (0)
#define PG8_LDA(dst, b, h) do { _Pragma("unroll") for (int m = 0; m < 4; ++m) _Pragma("unroll") for (int k = 0; k < 2; ++k) dst[m][k] = *(const PG8_LAS bf16x8*)(lds + PG8_SA(b, h) + aoff + m * 2048 + k * 1024); } while (0)
#define PG8_LDB(dst, b, h) do { _Pragma("unroll") for (int n = 0; n < 2; ++n) _Pragma("unroll") for (int k = 0; k < 2; ++k) dst[n][k] = *(const PG8_LAS bf16x8*)(lds + PG8_SB(b, h) + boff + n * 2048 + k * 1024); } while (0)
#define PG8_MMA(ai, bj, At, Bt) do { __builtin_amdgcn_s_setprio(1); _Pragma("unroll") for (int m = 0; m < 4; ++m) _Pragma("unroll") for (int n = 0; n < 2; ++n) _Pragma("unroll") for (int k = 0; k < 2; ++k) \
        acc[ai][bj][m][n] = __builtin_amdgcn_mfma_f32_16x16x32_bf16(Bt[n][k], At[m][k], acc[ai][bj][m][n], 0, 0, 0); __builtin_amdgcn_s_setprio(0); } while (0)
#define PG8_WAIT_V(n) asm volatile("s_waitcnt vmcnt(" #n ")" ::: "memory")
#define PG8_WAIT_L(n) asm volatile("s_waitcnt lgkmcnt(" #n ")" ::: "memory")
#define PG8_BAR __builtin_amdgcn_s_barrier()
#define PG8_SCHED __builtin_amdgcn_sched_barrier(0)
    Unit cur, nxt; int ui = 0;
    if (!S.next(0, cur)) return;
    f32x4 acc[2][2][4][2];
#pragma unroll
    for (int a = 0; a < 2; ++a)
#pragma unroll
        for (int b = 0; b < 2; ++b)
#pragma unroll
            for (int m = 0; m < 4; ++m)
#pragma unroll
                for (int n = 0; n < 2; ++n) acc[a][b][m][n] = (f32x4){0.f, 0.f, 0.f, 0.f};
    bf16x8 At[4][2], B0[2][2], B1[2][2];
    const char* cA = S.a_base(cur); const char* cB = S.b_base(cur);
    if constexpr (SP2) {
        PG8_STAGE(PG8_SB(0, 0), cB, voffB); PG8_STAGE(PG8_SB(0, 1), cB + hstep, voffB); PG8_STAGE(PG8_SA(0, 0), cA, voffA); PG8_STAGE(PG8_SA(0, 1), cA + hstep, voffA);
        if (wr == 1) PG8_BAR;
        PG8_WAIT_V(2); PG8_BAR;
        PG8_STAGE(PG8_SB(1, 0), cB + kstep, voffB); PG8_STAGE(PG8_SA(1, 0), cA + kstep, voffA); PG8_STAGE(PG8_SB(1, 1), cB + hstep + kstep, voffB);
        PG8_WAIT_V(6); PG8_BAR;
    } else {
        PG8_STAGE(PG8_SB(0, 0), cB, voffB); PG8_STAGE(PG8_SA(0, 0), cA, voffA); PG8_STAGE(PG8_SB(0, 1), cB + hstep, voffB); PG8_STAGE(PG8_SA(0, 1), cA + hstep, voffA);
        if (wr == 1) PG8_BAR;
        PG8_WAIT_V(4); PG8_BAR;
        PG8_STAGE(PG8_SB(1, 0), cB + kstep, voffB); PG8_STAGE(PG8_SA(1, 0), cA + kstep, voffA); PG8_STAGE(PG8_SB(1, 1), cB + hstep + kstep, voffB);
        PG8_WAIT_V(6); PG8_BAR;
    }
    for (;;) {
        const bool has_next = S.next(ui + 1, nxt);
        const char* nA = has_next ? S.a_base(nxt) : cA; const char* nB = has_next ? S.b_base(nxt) : cB;
        for (int t = 0; t < nt; t += 2) {
            const bool last = (t == nt - 2);
            const char* a1 = cA + (size_t)(t + 1) * kstep;
            const char* a2 = last ? nA : cA + (size_t)(t + 2) * kstep; const char* b2 = last ? nB : cB + (size_t)(t + 2) * kstep;
            const char* a3 = a2 + kstep; const char* b3 = b2 + kstep;
            if constexpr (SP2) {
            PG8_LDB(B0, 0, 0); PG8_LDB(B1, 0, 1); PG8_SCHED; PG8_LDA(At, 0, 0); PG8_STAGE(PG8_SA(1, 1), a1 + hstep, voffA);
            PG8_WAIT_V(8); PG8_WAIT_L(0); PG8_BAR; PG8_MMA(0, 0, At, B0); PG8_MMA(0, 1, At, B1); PG8_BAR; PG8_SCHED;
            PG8_LDA(At, 0, 1); PG8_STAGE(PG8_SB(0, 0), b2, voffB); PG8_STAGE(PG8_SB(0, 1), b2 + hstep, voffB); PG8_STAGE(PG8_SA(0, 0), a2, voffA);
            PG8_WAIT_V(8); PG8_WAIT_L(0); PG8_BAR; PG8_MMA(1, 0, At, B0); PG8_MMA(1, 1, At, B1); PG8_BAR; PG8_SCHED;
            PG8_LDB(B0, 1, 0); PG8_LDB(B1, 1, 1); PG8_SCHED; PG8_LDA(At, 1, 0); PG8_STAGE(PG8_SA(0, 1), a2 + hstep, voffA);
            PG8_WAIT_V(8); PG8_WAIT_L(0); PG8_BAR; PG8_MMA(0, 0, At, B0); PG8_MMA(0, 1, At, B1); PG8_BAR; PG8_SCHED;
            PG8_LDA(At, 1, 1); PG8_STAGE(PG8_SB(1, 0), b3, voffB); PG8_STAGE(PG8_SB(1, 1), b3 + hstep, voffB); PG8_STAGE(PG8_SA(1, 0), a3, voffA);
            PG8_WAIT_V(8); PG8_WAIT_L(0); PG8_BAR; PG8_MMA(1, 0, At, B0); PG8_MMA(1, 1, At, B1); PG8_BAR; PG8_SCHED;
            } else {
            PG8_LDB(B0, 0, 0); PG8_SCHED; PG8_LDA(At, 0, 0); PG8_STAGE(PG8_SA(1, 1), a1 + hstep, voffA);
            PG8_WAIT_L(8); PG8_BAR; PG8_WAIT_L(0); PG8_MMA(0, 0, At, B0); PG8_BAR; PG8_SCHED;
            PG8_LDB(B1, 0, 1); PG8_STAGE(PG8_SB(0, 0), b2, voffB);
            PG8_BAR; PG8_WAIT_L(0); PG8_MMA(0, 1, At, B1); PG8_BAR;
            PG8_LDA(At, 0, 1); PG8_STAGE(PG8_SA(0, 0), a2, voffA);
            PG8_BAR; PG8_WAIT_L(0); PG8_MMA(1, 0, At, B0); PG8_BAR; PG8_SCHED;
            PG8_STAGE(PG8_SB(0, 1), b2 + hstep, voffB);
            PG8_WAIT_V(6); PG8_BAR; PG8_MMA(1, 1, At, B1); PG8_BAR;
            PG8_LDB(B0, 1, 0); PG8_SCHED; PG8_LDA(At, 1, 0); PG8_STAGE(PG8_SA(0, 1), a2 + hstep, voffA);
            PG8_WAIT_L(8); PG8_BAR; PG8_WAIT_L(0); PG8_MMA(0, 0, At, B0); PG8_BAR; PG8_SCHED;
            PG8_LDB(B1, 1, 1); PG8_STAGE(PG8_SB(1, 0), b3, voffB);
            PG8_BAR; PG8_WAIT_L(0); PG8_MMA(0, 1, At, B1); PG8_BAR;
            PG8_LDA(At, 1, 1); PG8_STAGE(PG8_SA(1, 0), a3, voffA);
            PG8_BAR; PG8_WAIT_L(0); PG8_MMA(1, 0, At, B0); PG8_BAR; PG8_SCHED;
            PG8_STAGE(PG8_SB(1, 1), b3 + hstep, voffB);
            PG8_WAIT_V(6); PG8_BAR; PG8_MMA(1, 1, At, B1); PG8_BAR;
            }
        }
        if constexpr (ALIGN_EPI) { if (wr == 0) PG8_BAR; }
        E(acc, cur, wr, wc, fr, fq);
        if (!has_next) break;
        if (!E.keep(cur)) {
#pragma unroll
        for (int a = 0; a < 2; ++a)
#pragma unroll
            for (int b = 0; b < 2; ++b)
#pragma unroll
                for (int m = 0; m < 4; ++m)
#pragma unroll
                    for (int n = 0; n < 2; ++n) acc[a][b][m][n] = (f32x4){0.f, 0.f, 0.f, 0.f};
        }
        cur = nxt; cA = nA; cB = nB; ++ui;
        if constexpr (ALIGN_EPI) { if (wr == 1) PG8_BAR; }
    }
    PG8_WAIT_V(0);
    if constexpr (!ALIGN_EPI) { if (wr == 0) PG8_BAR; }
    PG8_BAR;
#undef PG8_SA
#undef PG8_SB
#undef PG8_STAGE
#undef PG8_LDA
#undef PG8_LDB
#undef PG8_MMA
#undef PG8_WAIT_V
#undef PG8_WAIT_L
#undef PG8_BAR
#undef PG8_SCHED
}
}
namespace fk {
using pg8::Unit; using pg8::bf16_t;
typedef float f32x16 __attribute__((ext_vector_type(16)));
typedef float f32x8v __attribute__((ext_vector_type(8)));
typedef short s16x4 __attribute__((ext_vector_type(4)));
typedef unsigned u32x4 __attribute__((ext_vector_type(4)));
typedef unsigned u32x2 __attribute__((ext_vector_type(2)));
constexpr int NWAVES = 8;
constexpr int M = 10240, MP = 8192, MS = 2048, DM = 2048, NIN = 9216, FF = 5632, NGU = 11264, SBW = 1024;
constexpr float EPS = 1e-6f;
constexpr float QSCALE = 1.4426950408889634f * 0.08838834764831845f;
constexpr size_t OUT_Y = 0, OUT_KP = 20971520, OUT_VP = 37748736, OUT_KS = 54525952, OUT_VS = 58720256, OUT_SG = 62914560, OUT_N = 67108864;
constexpr size_t MiB = 1u << 20;
constexpr size_t W_CTL = 0, CTL_ZERO_BYTES = 1 * MiB;
constexpr size_t W_WL = 1 * MiB, WL_STRIDE = 118 * MiB;
constexpr size_t WL_IN = 0, WL_A = 36 * MiB, WL_B = 40 * MiB, WL_OUT = 44 * MiB, WL_GU = 52 * MiB, WL_D = 96 * MiB;
constexpr size_t W_WM = 237 * MiB;
constexpr size_t W_HB = 238 * MiB, W_SS = 278 * MiB, W_Q = 280 * MiB, W_K = 300 * MiB, W_V = 320 * MiB, W_U = 340 * MiB, W_VS = 360 * MiB, W_G = 400 * MiB,
                 W_ATT = 480 * MiB, W_BB = 500 * MiB, W_MG = 520 * MiB, W_ACT = 560 * MiB, W_END = 670 * MiB;
constexpr int CW_TMO = 0, CW_BAR = 4096;
constexpr int RING_BYTES = 131072, LDSCTL_OFF = RING_BYTES, MISC_OFF = LDSCTL_OFF + 320, LDS_BYTES = 147456;

#define GAS __attribute__((address_space(1)))
#define LAS __attribute__((address_space(3)))
typedef unsigned short bf16;
typedef unsigned v4u __attribute__((ext_vector_type(4)));
typedef float f32x4 __attribute__((ext_vector_type(4)));
typedef short bf16x8 __attribute__((ext_vector_type(8)));
typedef GAS unsigned gu32;
typedef GAS unsigned long long gu64;
#define RLX_AGENT __ATOMIC_RELAXED, __HIP_MEMORY_SCOPE_AGENT
#define LDS_WAIT() asm volatile("s_waitcnt lgkmcnt(0)" ::: "memory")
#define VM_WAIT() asm volatile("s_waitcnt vmcnt(0)" ::: "memory")
__device__ __forceinline__ unsigned long long rt() { return __builtin_amdgcn_s_memrealtime(); }
__device__ __forceinline__ unsigned f2bf(float f) { unsigned u = __builtin_bit_cast(unsigned, f); return (u + 0x7fffu + ((u >> 16) & 1u)) >> 16; }
__device__ __forceinline__ unsigned pk2(float lo, float hi) { return f2bf(lo) | (f2bf(hi) << 16); }
#define XB_TMO      128
#define XB_XCNT(j)  (256  + 64 * (j))
#define XB_XSUB(j)  (1280 + 64 * (j))
#define XB_XGEN(j)  (2304 + 64 * (j))
#define XB_TOP      3328
#define XB_TOPGEN   3392
#define XCD_BAR_WORDS 3456
#define XB_SPIN_CAP (1u << 18)

__device__ __forceinline__ unsigned xb_ld(unsigned* p)              { return __hip_atomic_load(p, __ATOMIC_RELAXED, __HIP_MEMORY_SCOPE_AGENT); }
__device__ __forceinline__ unsigned xb_add(unsigned* p, unsigned v) { return __hip_atomic_fetch_add(p, v, __ATOMIC_RELAXED, __HIP_MEMORY_SCOPE_AGENT); }
__device__ __forceinline__ unsigned xb_xcc_id() { return (unsigned)__builtin_amdgcn_s_getreg((3 << 11) | 20) & 0xFu; }
#define XB_SPIN(cond, bar) do { unsigned _sp = 0; while (cond) { __builtin_amdgcn_s_sleep(1); \
    if ((++_sp & 255u) == 0u) { if (xb_ld(&(bar)[XB_TMO])) break; if (_sp > XB_SPIN_CAP) { atomicAdd(&(bar)[XB_TMO], 1u); break; } } } } while (0)

struct XcdBarrier {
    unsigned* bar; unsigned x;
    volatile LAS unsigned* st;
};

__device__ __forceinline__ XcdBarrier xcd_barrier_post(unsigned* bar, volatile LAS unsigned* st) {
    XcdBarrier b; b.bar = bar; b.x = xb_xcc_id(); b.st = st;
    if (threadIdx.x == 0) (void)xb_add(&bar[XB_XCNT(b.x)], 1u);
    return b;
}
__device__ __forceinline__ void xcd_barrier_complete(unsigned* bar, unsigned x, unsigned& nloc, unsigned& nx) {
    const unsigned G = gridDim.x * gridDim.y * gridDim.z;
    unsigned sum, cnt, mine, sp = 0u;
    for (;;) {
        sum = 0u; cnt = 0u; mine = 0u;
#pragma unroll
        for (unsigned j = 0; j < 16; ++j) { const unsigned c = xb_ld(&bar[XB_XCNT(j)]); sum += c; cnt += (c > 0u) ? 1u : 0u; mine = (j == x) ? c : mine; }
        if (sum == G) break;
        __builtin_amdgcn_s_sleep(1);
        if ((++sp & 255u) == 0u) { if (xb_ld(&bar[XB_TMO])) break; if (sp > XB_SPIN_CAP) { atomicAdd(&bar[XB_TMO], 1u); break; } }
    }
    nloc = mine > 0u ? mine : 1u; nx = cnt > 0u ? cnt : 1u;
}

__device__ __forceinline__ void xcd_barrier(const XcdBarrier& b) {
    asm volatile("s_waitcnt vmcnt(0)" ::: "memory");
    __syncthreads();
    if (threadIdx.x == 0) {
        unsigned* bar = b.bar;
        __builtin_amdgcn_s_waitcnt(0);
        unsigned nloc = b.st[0], nx = b.st[1];
        if (nloc == 0u) { xcd_barrier_complete(bar, b.x, nloc, nx); b.st[0] = nloc; b.st[1] = nx; }
        const unsigned old = xb_add(&bar[XB_XSUB(b.x)], 1u);
        const unsigned gen = old / nloc;
        if (old + 1u == (gen + 1u) * nloc) {
            __builtin_amdgcn_fence(__ATOMIC_RELEASE, "agent");
            asm volatile("s_waitcnt vmcnt(0)" ::: "memory");
            const unsigned og = xb_add(&bar[XB_TOP], 1u);
            const unsigned tg = og / nx;
            if (og + 1u == (tg + 1u) * nx) xb_add(&bar[XB_TOPGEN], 1u);
            else XB_SPIN(xb_ld(&bar[XB_TOPGEN]) == tg, bar);
            __builtin_amdgcn_fence(__ATOMIC_ACQUIRE, "agent");
            xb_add(&bar[XB_XGEN(b.x)], 1u);
            asm volatile("s_waitcnt vmcnt(0)" ::: "memory");
        } else {
            XB_SPIN(xb_ld(&bar[XB_XGEN(b.x)]) == gen, bar);
            __builtin_amdgcn_fence(__ATOMIC_ACQUIRE, "agent");
            asm volatile("s_waitcnt vmcnt(0)" ::: "memory");
        }
    }
    __syncthreads();
}

struct Frame {
    LAS unsigned char* lds; volatile LAS unsigned* MISC; int tid, lane, wave, vcu, G;
    const float *xp, *xs, *ck, *cv, *nmix, *win, *bgate, *sgun, *wsp, *bsp, *wa, *wb, *wout, *nffn, *wgu, *wd, *nfin;
    float* out; unsigned char* ws;
};
__device__ __forceinline__ int opq(int x) { asm volatile("" : "+v"(x)); return x; }
__device__ __forceinline__ float bf2f_lo(unsigned w) { return __uint_as_float(w << 16); }
__device__ __forceinline__ float bf2f_hi(unsigned w) { return __uint_as_float(w & 0xffff0000u); }
typedef __bf16 bf16x2_t __attribute__((ext_vector_type(2)));
__device__ __forceinline__ unsigned cvtpk(float lo, float hi) { const bf16x2_t v = {(__bf16)lo, (__bf16)hi}; return __builtin_bit_cast(unsigned, v); }
__device__ __forceinline__ float fsig(float y) { return __builtin_amdgcn_rcpf(1.f + __builtin_amdgcn_exp2f(-1.4426950408889634f * y)); }
__device__ __forceinline__ float fgelu(float x) { const float t = x * (-2.3022081f + -0.10294324f * x * x); return x * __builtin_amdgcn_rcpf(1.f + __builtin_amdgcn_exp2f(t)); }
__device__ __forceinline__ float wave_sum(float v) {
#pragma unroll
    for (int o = 1; o < 64; o <<= 1) v += __shfl_xor(v, o);
    return v;
}
__device__ __forceinline__ void tile_of(int L, int nM, int nN, int& pm, int& pn) {
    const int nwg = nM * nN; int wgid = L; { const int q = nwg / 8, r = nwg % 8, xcd = wgid % 8, off = wgid / 8; wgid = (xcd < r ? xcd * (q + 1) : r * (q + 1) + (xcd - r) * q) + off; }
    const int nig = 8 * nN, gid = wgid / nig, fm = gid * 8, gsz = (nM - fm) < 8 ? (nM - fm) : 8;
    pm = fm + ((wgid % nig) % gsz); pn = (wgid % nig) / gsz;
}
struct SchedSimple {
    int nM, nN, G, c, K, KT; const char* A; const char* Bt;
    __device__ __forceinline__ bool next(int i, Unit& u) const { const int L = i * G + c; if (L >= nM * nN) return false; tile_of(L, nM, nN, u.pm, u.pn); u.br = 0; return true; }
    __device__ __forceinline__ const char* a_base(const Unit& u) const { return A + (size_t)u.pm * 512 * K; }
    __device__ __forceinline__ const char* b_base(const Unit& u) const { return Bt + (size_t)u.pn * 512 * K; }
};
struct SchedBranch {
    int nM, nN, G, c, K, KT; const char *A0, *B0, *A1, *B1;
    __device__ __forceinline__ bool next(int i, Unit& u) const { const int L = (i >> 1) * G + c; if (L >= nM * nN) return false; tile_of(L, nM, nN, u.pm, u.pn); u.br = i & 1; return true; }
    __device__ __forceinline__ const char* a_base(const Unit& u) const { return (u.br ? A1 : A0) + (size_t)u.pm * 512 * K; }
    __device__ __forceinline__ const char* b_base(const Unit& u) const { return (u.br ? B1 : B0) + (size_t)u.pn * 512 * K; }
};
#define EPI_ROWS(ai, m) (u.pm * 256 + (ai) * 128 + wr * 64 + (m) * 16 + fr)
__device__ __forceinline__ void row_rstd(const float* SS, const Unit& u, int wr, int fr, int fq, float (&rs)[2][4]) {
#pragma unroll
    for (int ai = 0; ai < 2; ++ai)
#pragma unroll
        for (int m = 0; m < 4; ++m) { const f32x4* s = (const f32x4*)(SS + (size_t)EPI_ROWS(ai, m) * 32 + fq * 8); const f32x4 a = s[0], b = s[1];
            float t = ((a[0] + a[1]) + (a[2] + a[3])) + ((b[0] + b[1]) + (b[2] + b[3])); t += __shfl_xor(t, 16); t += __shfl_xor(t, 32);
            rs[ai][m] = __builtin_amdgcn_rsqf(t * (1.0f / 2048.0f) + EPS); }
}
__device__ __forceinline__ u32x4 pack8(const f32x4 v0, const f32x4 v1) { u32x4 w; w.x = cvtpk(v0[0], v0[1]); w.y = cvtpk(v0[2], v0[3]); w.z = cvtpk(v1[0], v1[1]); w.w = cvtpk(v1[2], v1[3]); return w; }
#ifdef DBG_GRAW
#define GATE_ACT(x) (x)
#else
#define GATE_ACT(x) fsig(x)
#endif
struct EpiIn {
    static constexpr bool PERM = true;
    const float* SS; bf16_t *Q, *Kb, *Vb, *U, *G; float* VS; const float* bgate; float *okp, *ovp, *oks, *ovs;
    __device__ __forceinline__ bool keep(const Unit&) const { return false; }
    __device__ __forceinline__ void operator()(f32x4 (&acc)[2][2][4][2], const Unit& u, int wr, int wc, int fr, int fq) const {
        float rs[2][4]; row_rstd(SS, u, wr, fr, fq, rs);
        const int colt = u.pn * 256, cl = wc * 32 + 8 * fq;
        if (colt < 1024) {
#pragma unroll
            for (int ai = 0; ai < 2; ++ai)
#pragma unroll
                for (int m = 0; m < 4; ++m) { const size_t row = EPI_ROWS(ai, m); const float sc = rs[ai][m] * QSCALE;
#pragma unroll
                    for (int bj = 0; bj < 2; ++bj) *(u32x4*)(Q + row * 1024 + colt + bj * 128 + cl) = pack8(acc[ai][bj][m][0] * sc, acc[ai][bj][m][1] * sc); }
        } else if (colt < 3072) {
            const bool isv = colt >= 2048; const int c0 = colt - (isv ? 2048 : 1024) + cl; bf16_t* B = isv ? Vb : Kb;
            float* O = (u.pm < 32) ? (isv ? ovp : okp) : ((isv ? ovs : oks) - (size_t)MP * 1024);
#pragma unroll
            for (int ai = 0; ai < 2; ++ai)
#pragma unroll
                for (int m = 0; m < 4; ++m) { const size_t row = EPI_ROWS(ai, m); const float sc = rs[ai][m];
#pragma unroll
                    for (int bj = 0; bj < 2; ++bj) { const f32x4 v0 = acc[ai][bj][m][0] * sc, v1 = acc[ai][bj][m][1] * sc; const size_t o = row * 1024 + c0 + bj * 128;
                        *(u32x4*)(B + o) = pack8(v0, v1); *(f32x4*)(O + o) = v0; *(f32x4*)(O + o + 4) = v1; } }
        } else if (colt < 5120) {
            const bool isvs = colt >= 4096; const int c0 = colt - (isvs ? 4096 : 3072) + cl;
#pragma unroll
            for (int ai = 0; ai < 2; ++ai)
#pragma unroll
                for (int m = 0; m < 4; ++m) { const size_t row = EPI_ROWS(ai, m); const float sc = rs[ai][m];
#pragma unroll
                    for (int bj = 0; bj < 2; ++bj) { f32x4 v0 = acc[ai][bj][m][0] * sc, v1 = acc[ai][bj][m][1] * sc;
#pragma unroll
                        for (int j = 0; j < 4; ++j) { v0[j] = fgelu(v0[j]); v1[j] = fgelu(v1[j]); }
                        const size_t o = row * 1024 + c0 + bj * 128;
                        if (isvs) { *(f32x4*)(VS + o) = v0; *(f32x4*)(VS + o + 4) = v1; } else *(u32x4*)(U + o) = pack8(v0, v1); } }
        } else {
            const int c0 = colt - 5120 + cl;
#pragma unroll
            for (int bj = 0; bj < 2; ++bj) { const f32x4 b0 = *(const f32x4*)(bgate + c0 + bj * 128), b1 = *(const f32x4*)(bgate + c0 + bj * 128 + 4);
#pragma unroll
                for (int ai = 0; ai < 2; ++ai)
#pragma unroll
                    for (int m = 0; m < 4; ++m) { const size_t row = EPI_ROWS(ai, m); const float sc = rs[ai][m];
                        f32x4 v0 = acc[ai][bj][m][0] * sc + b0, v1 = acc[ai][bj][m][1] * sc + b1;
#pragma unroll
                        for (int j = 0; j < 4; ++j) { v0[j] = GATE_ACT(v0[j]); v1[j] = GATE_ACT(v1[j]); }
                        *(u32x4*)(G + row * 4096 + c0 + bj * 128) = pack8(v0, v1); } }
        }
    }
};
struct EpiMerge {
    static constexpr bool PERM = true;
    const bf16_t* G; bf16_t* MG;
    __device__ __forceinline__ bool keep(const Unit& u) const { return u.br == 0; }
    __device__ __forceinline__ void operator()(f32x4 (&acc)[2][2][4][2], const Unit& u, int wr, int wc, int fr, int fq) const {
        const int c0 = u.pn * 256 + wc * 32 + 8 * fq;
#pragma unroll
        for (int ai = 0; ai < 2; ++ai)
#pragma unroll
            for (int m = 0; m < 4; ++m) { const size_t row = EPI_ROWS(ai, m);
#pragma unroll
                for (int bj = 0; bj < 2; ++bj) { const int c = c0 + bj * 128;
                    const u32x4 gb = *(const u32x4*)(G + row * 4096 + 2048 + c);
                    float b[8]; b[0] = bf2f_lo(gb.x); b[1] = bf2f_hi(gb.x); b[2] = bf2f_lo(gb.y); b[3] = bf2f_hi(gb.y); b[4] = bf2f_lo(gb.z); b[5] = bf2f_hi(gb.z); b[6] = bf2f_lo(gb.w); b[7] = bf2f_hi(gb.w);
#pragma unroll
                    for (int j = 0; j < 8; ++j) b[j] = fmaxf(b[j], 1e-30f);
                    if (u.br == 0) {
                        const u32x4 ga = *(const u32x4*)(G + row * 4096 + c);
                        float a[8]; a[0] = bf2f_lo(ga.x); a[1] = bf2f_hi(ga.x); a[2] = bf2f_lo(ga.y); a[3] = bf2f_hi(ga.y); a[4] = bf2f_lo(ga.z); a[5] = bf2f_hi(ga.z); a[6] = bf2f_lo(ga.w); a[7] = bf2f_hi(ga.w);
#pragma unroll
                        for (int j = 0; j < 4; ++j) { acc[ai][bj][m][0][j] *= a[j] * __builtin_amdgcn_rcpf(b[j]); acc[ai][bj][m][1][j] *= a[4 + j] * __builtin_amdgcn_rcpf(b[4 + j]); }
                    } else {
                        f32x4 v0, v1;
#pragma unroll
                        for (int j = 0; j < 4; ++j) { v0[j] = acc[ai][bj][m][0][j] * b[j]; v1[j] = acc[ai][bj][m][1][j] * b[4 + j]; }
                        *(u32x4*)(MG + row * 2048 + c) = pack8(v0, v1);
                    } } }
    }
};
struct EpiRes {
    static constexpr bool PERM = true;
    const float* base_p; const float* base_s;
    float* H; bf16_t* HB; float* SS; int write_hb;
    __device__ __forceinline__ bool keep(const Unit&) const { return false; }
    __device__ __forceinline__ void operator()(f32x4 (&acc)[2][2][4][2], const Unit& u, int wr, int wc, int fr, int fq) const {
        const int c0 = u.pn * 256 + wc * 32 + 8 * fq; const float* bb = (u.pm < 32) ? base_p : (base_s - (size_t)MP * 2048);
#pragma unroll
        for (int ai = 0; ai < 2; ++ai)
#pragma unroll
            for (int m = 0; m < 4; ++m) { const size_t row = EPI_ROWS(ai, m); float q = 0.f;
#pragma unroll
                for (int bj = 0; bj < 2; ++bj) { const size_t o = row * 2048 + c0 + bj * 128;
                    const f32x4 h0 = *(const f32x4*)(bb + o) + acc[ai][bj][m][0], h1 = *(const f32x4*)(bb + o + 4) + acc[ai][bj][m][1];
                    *(f32x4*)(H + o) = h0; *(f32x4*)(H + o + 4) = h1;
                    q += ((h0[0] * h0[0] + h0[1] * h0[1]) + (h0[2] * h0[2] + h0[3] * h0[3])) + ((h1[0] * h1[0] + h1[1] * h1[1]) + (h1[2] * h1[2] + h1[3] * h1[3]));
                    if (write_hb) *(u32x4*)(HB + o) = pack8(h0, h1); }
                q += __shfl_xor(q, 16); q += __shfl_xor(q, 32);
                if (fq == 0) SS[row * 32 + u.pn * 4 + wc] = q; }
    }
};
struct EpiGU {
    static constexpr bool PERM = true;
    const float* SS; bf16_t* ACT;
    __device__ __forceinline__ bool keep(const Unit&) const { return false; }
    __device__ __forceinline__ void operator()(f32x4 (&acc)[2][2][4][2], const Unit& u, int wr, int wc, int fr, int fq) const {
        float rs[2][4]; row_rstd(SS, u, wr, fr, fq, rs);
        const int c0 = u.pn * 128 + wc * 32 + 8 * fq;
#pragma unroll
        for (int ai = 0; ai < 2; ++ai)
#pragma unroll
            for (int m = 0; m < 4; ++m) { const size_t row = EPI_ROWS(ai, m); const float sc = rs[ai][m]; f32x4 v0, v1;
#pragma unroll
                for (int j = 0; j < 4; ++j) { const float g0 = acc[ai][0][m][0][j] * sc, g1 = acc[ai][0][m][1][j] * sc;
                    v0[j] = g0 * fsig(g0) * (acc[ai][1][m][0][j] * sc); v1[j] = g1 * fsig(g1) * (acc[ai][1][m][1][j] * sc); }
                *(u32x4*)(ACT + row * 5632 + c0) = pack8(v0, v1); }
    }
};
__device__ __forceinline__ void p0_transpose_item(const float* W, int K, int N, const float* scale, bf16* WT, int drow0, int k0, int n0, LAS float* scr, int lane) {
#pragma unroll 8
    for (int i = 0; i < 32; ++i) { const int kk = 2 * i + (lane >> 5); float v = W[(size_t)(k0 + kk) * N + n0 + (lane & 31)]; if (scale) v *= scale[k0 + kk]; scr[kk * 33 + (lane & 31)] = v; }
    LDS_WAIT(); asm volatile("" ::: "memory");
    const int c = lane & 7;
#pragma unroll
    for (int j = 0; j < 4; ++j) { const int n = (lane >> 3) + 8 * j; const LAS float* s = scr + (8 * c) * 33 + n;
        v4u o; o.x = pk2(s[0 * 33], s[1 * 33]); o.y = pk2(s[2 * 33], s[3 * 33]); o.z = pk2(s[4 * 33], s[5 * 33]); o.w = pk2(s[6 * 33], s[7 * 33]);
        *(GAS v4u*)(WT + (size_t)(drow0 + n) * K + k0 + 8 * c) = o; }
    LDS_WAIT(); asm volatile("" ::: "memory");
}
__device__ __forceinline__ void p0_prologue(Frame& F) {
    F.tid = opq(F.tid); F.lane = F.tid & 63;
    LAS float* scr = (LAS float*)(F.lds + F.wave * 16384);
    const int gw = F.vcu * NWAVES + F.wave, NGW = F.G * NWAVES;
    constexpr int I_IN = 32 * 288, I_A = 16 * 64, I_B = 16 * 64, I_O = 32 * 64, I_GU = 32 * 352, I_D = 88 * 64, I_L = I_IN + I_A + I_B + I_O + I_GU + I_D;
    for (int it = gw; it < 2 * I_L; it += NGW) {
        const int l = it / I_L; int r = it % I_L; unsigned char* wl = F.ws + W_WL + (size_t)l * WL_STRIDE;
        if (r < I_IN) { const int kb = r / 288, nb = r % 288; p0_transpose_item(F.win + (size_t)l * DM * NIN, DM, NIN, F.nmix + l * DM, (bf16*)(wl + WL_IN), nb * 32, kb * 64, nb * 32, scr, F.lane); continue; } r -= I_IN;
        if (r < I_A) { const int kb = r / 64, nb = r % 64; p0_transpose_item(F.wa + (size_t)l * 1024 * DM, 1024, DM, nullptr, (bf16*)(wl + WL_A), nb * 32, kb * 64, nb * 32, scr, F.lane); continue; } r -= I_A;
        if (r < I_B) { const int kb = r / 64, nb = r % 64; p0_transpose_item(F.wb + (size_t)l * 1024 * DM, 1024, DM, nullptr, (bf16*)(wl + WL_B), nb * 32, kb * 64, nb * 32, scr, F.lane); continue; } r -= I_B;
        if (r < I_O) { const int kb = r / 64, nb = r % 64; p0_transpose_item(F.wout + (size_t)l * DM * DM, DM, DM, nullptr, (bf16*)(wl + WL_OUT), nb * 32, kb * 64, nb * 32, scr, F.lane); continue; } r -= I_O;
        if (r < I_GU) { const int kb = r / 352, nb = r % 352; const int n0 = nb * 32; const int j0 = n0 < FF ? n0 : n0 - FF;
            const int drow = (j0 >> 7) * 256 + (n0 < FF ? 0 : 128) + (j0 & 127);
            p0_transpose_item(F.wgu + (size_t)l * DM * NGU, DM, NGU, F.nffn + l * DM, (bf16*)(wl + WL_GU), drow, kb * 64, n0, scr, F.lane); continue; } r -= I_GU;
        { const int kb = r / 64, nb = r % 64; p0_transpose_item(F.wd + (size_t)l * FF * DM, FF, DM, nullptr, (bf16*)(wl + WL_D), nb * 32, kb * 64, nb * 32, scr, F.lane); }
    }
    bf16* HB = (bf16*)(F.ws + W_HB); float* SS = (float*)(F.ws + W_SS);
    for (int m = gw; m < M; m += NGW) {
        const float* xr = (m < MP) ? F.xp + (size_t)m * DM : F.xs + (size_t)(m - MP) * DM; float q = 0.f;
#pragma unroll
        for (int j = 0; j < 8; ++j) { const f32x4 v = *(const f32x4*)(xr + j * 256 + F.lane * 4); q += (v[0] * v[0] + v[1] * v[1]) + (v[2] * v[2] + v[3] * v[3]);
            u32x2 w; w.x = cvtpk(v[0], v[1]); w.y = cvtpk(v[2], v[3]); *(u32x2*)(HB + (size_t)m * DM + j * 256 + F.lane * 4) = w; }
        q = wave_sum(q);
        if (F.lane < 32) SS[(size_t)m * 32 + F.lane] = F.lane == 0 ? q : 0.f;
    }
    bf16* WM = (bf16*)(F.ws + W_WM);
    for (int i = (F.vcu * NWAVES + F.wave) * 64 + F.lane; i < 2 * 2 * 8 * 128 * 128; i += NGW * 64) {
        const int s = i & 127, t = (i >> 7) & 127, g = (i >> 14) & 7, kind = (i >> 17) & 1, l = i >> 18;
        const float* w = F.wsp + ((size_t)l * 8 + g) * 16384; float v;
        if (kind == 0) v = ((s >> 6) <= (t >> 6)) ? w[t * 128 + s] : 0.f; else v = ((s >> 6) == (t >> 6)) ? w[(t & 63) * 128 + (s & 63)] : 0.f;
        WM[i] = (bf16)f2bf(v);
    }
}
__device__ __forceinline__ void p_final(Frame& F) {
    F.tid = opq(F.tid); F.lane = F.tid & 63;
    const int gw = F.vcu * NWAVES + F.wave, NGW = F.G * NWAVES; const float* SS = (const float*)(F.ws + W_SS);
    for (int m = gw; m < M; m += NGW) {
        float t = F.lane < 32 ? SS[(size_t)m * 32 + F.lane] : 0.f; t = wave_sum(t); const float r = __builtin_amdgcn_rsqf(t * (1.0f / 2048.0f) + EPS);
        float* h = F.out + OUT_Y + (size_t)m * DM;
#pragma unroll
        for (int j = 0; j < 8; ++j) { const int c = j * 256 + F.lane * 4; const f32x4 v = *(const f32x4*)(h + c), g = *(const f32x4*)(F.nfin + c); *(f32x4*)(h + c) = v * r * g; }
    }
}
constexpr int A_VOFF = 0, A_KOFF = 32768, A_TILE = 16384;
#define KSWZ(row, colB) ((row) * 256 + ((colB) ^ (((row) & 7) << 4)))
#define SBAR() __builtin_amdgcn_sched_barrier(0)
__device__ __forceinline__ int crow(int r, int hi) { return (r & 3) + 8 * (r >> 2) + 4 * hi; }
__device__ __forceinline__ int v_st(int k, int c) { const int kk = (k & ~0xC) | ((k & 4) << 1) | ((k & 8) >> 1); return ((kk >> 3) * 4 + (c >> 5)) * 512 + ((kk & 7) * 32 + (c & 31)) * 2; }
__device__ __forceinline__ int v_rd_base(int lane) { return ((lane & 3) << 3) | (((lane >> 2) & 3) << 6) | (((lane >> 4) & 1) << 5) | (((lane >> 5) & 1) << 8); }
constexpr int v_rd_off(int d0, int ks, int half) { return d0 * 512 + ks * 4096 + half * 2048; }
template <int OFF> __device__ __forceinline__ s16x4 tr_read(int vb) { s16x4 r; asm volatile("ds_read_b64_tr_b16 %0, %1 offset:%2" : "=&v"(r) : "v"(vb), "i"(OFF) : "memory"); return r; }
template <int D0> __device__ __forceinline__ void pv_one(f32x16& od, int vb, bf16x8 pa0, bf16x8 pa1, bf16x8 pa2, bf16x8 pa3) {
    const s16x4 l0 = tr_read<v_rd_off(D0, 0, 0)>(vb), h0 = tr_read<v_rd_off(D0, 0, 1)>(vb), l1 = tr_read<v_rd_off(D0, 1, 0)>(vb), h1 = tr_read<v_rd_off(D0, 1, 1)>(vb);
    const s16x4 l2 = tr_read<v_rd_off(D0, 2, 0)>(vb), h2 = tr_read<v_rd_off(D0, 2, 1)>(vb), l3 = tr_read<v_rd_off(D0, 3, 0)>(vb), h3 = tr_read<v_rd_off(D0, 3, 1)>(vb);
    asm volatile("s_waitcnt lgkmcnt(0)" ::: "memory"); SBAR();
#define PK(L, H) (bf16x8){L[0], L[1], L[2], L[3], H[0], H[1], H[2], H[3]}
    od = __builtin_amdgcn_mfma_f32_32x32x16_bf16(pa0, PK(l0, h0), od, 0, 0, 0);
    od = __builtin_amdgcn_mfma_f32_32x32x16_bf16(pa1, PK(l1, h1), od, 0, 0, 0);
    od = __builtin_amdgcn_mfma_f32_32x32x16_bf16(pa2, PK(l2, h2), od, 0, 0, 0);
    od = __builtin_amdgcn_mfma_f32_32x32x16_bf16(pa3, PK(l3, h3), od, 0, 0, 0);
#undef PK
}
__device__ __forceinline__ void qkt(f32x16& p0, f32x16& p1, const LAS unsigned char* Ks, const bf16x8 (&qr)[8], int r32, int hi) {
    p0 = f32x16{}; p1 = f32x16{};
#pragma unroll
    for (int d0 = 0; d0 < 8; ++d0) { const int cb = (d0 * 16 + hi * 8) * 2;
        const bf16x8 b0 = *(const LAS bf16x8*)(Ks + KSWZ(r32, cb)); const bf16x8 b1 = *(const LAS bf16x8*)(Ks + KSWZ(32 + r32, cb));
        p0 = __builtin_amdgcn_mfma_f32_32x32x16_bf16(b0, qr[d0], p0, 0, 0, 0); p1 = __builtin_amdgcn_mfma_f32_32x32x16_bf16(b1, qr[d0], p1, 0, 0, 0); }
}
__device__ __forceinline__ void sb_half(f32x16& p, float& R, int hi, bool need_mask, int kpos0, int qpos) {
    f32x16 st;
#pragma unroll
    for (int r = 0; r < 16; ++r) { const float zz = fmaxf(p[r], -120.f); const float e = __builtin_amdgcn_exp2f(-zz); float bt = __builtin_amdgcn_rcpf(1.f + e); float s = e * bt;
        if (need_mask) { const bool valid = (kpos0 + crow(r, hi)) < qpos; s = valid ? s : 1.f; bt = valid ? bt : 0.f; }
        p[r] = bt; st[r] = s; }
    float x1[4], x2[4], x3[4], c[4], f[4];
#pragma unroll
    for (int q = 0; q < 4; ++q) { x3[q] = st[4 * q + 3]; x2[q] = x3[q] * st[4 * q + 2]; x1[q] = x2[q] * st[4 * q + 1]; const float pq = x1[q] * st[4 * q];
        const auto rr = __builtin_amdgcn_permlane32_swap(__float_as_uint(pq), __float_as_uint(pq), false, false);
        const float v0 = __uint_as_float(rr[0]), v1 = __uint_as_float(rr[1]); c[q] = v0 * v1; f[q] = hi ? 1.f : v1; }
    const float S3 = R, S2 = S3 * c[3], S1 = S2 * c[2], S0 = S1 * c[1]; R = S0 * c[0];
    const float T[4] = {S0 * f[0], S1 * f[1], S2 * f[2], S3 * f[3]};
#pragma unroll
    for (int q = 0; q < 4; ++q) { p[4 * q + 3] *= T[q]; p[4 * q + 2] *= T[q] * x3[q]; p[4 * q + 1] *= T[q] * x2[q]; p[4 * q] *= T[q] * x1[q]; }
}
#define PK4(P, BASE, OUT) do { const unsigned a0 = cvtpk(P[BASE + 0], P[BASE + 1]), a1 = cvtpk(P[BASE + 2], P[BASE + 3]);   \
    const unsigned b0 = cvtpk(P[BASE + 4], P[BASE + 5]), b1 = cvtpk(P[BASE + 6], P[BASE + 7]);                              \
    const auto r0 = __builtin_amdgcn_permlane32_swap(a0, b0, false, false); const auto r1 = __builtin_amdgcn_permlane32_swap(a1, b1, false, false); \
    u32x4 w_ = {r0[0], r1[0], r0[1], r1[1]}; OUT = *reinterpret_cast<bf16x8*>(&w_); } while (0)
template <bool SAMPLE>
__device__ __forceinline__ void attn_unit(Frame& F, int l, int b, int h, int qb) {
    const int tid = opq(F.tid), wid = F.wave, lane = tid & 63, r32 = lane & 31, hi = lane >> 5;
    const LAS unsigned char* Kl = F.lds + A_KOFF; LAS unsigned char* Vl = F.lds + A_VOFF;
    const bool active = SAMPLE ? (wid < 2) : true;
    const int nt = SAMPLE ? 33 : 4 * qb + 4;
    const int wrow_lo = SAMPLE ? 2048 + 32 * wid : 256 * qb + 32 * wid;
    const int qpos = wrow_lo + r32;
    const size_t qrow = SAMPLE ? (size_t)(MP + b * 64 + 32 * wid + r32) : (size_t)(b * 2048 + qpos);
    const bf16* Qp = (const bf16*)(F.ws + W_Q) + qrow * 1024 + h * 128 + hi * 8;
    bf16x8 qr[8];
    if (active) {
#pragma unroll
        for (int d0 = 0; d0 < 8; ++d0) qr[d0] = *(const bf16x8*)(Qp + d0 * 16);
    } else {
#pragma unroll
        for (int d0 = 0; d0 < 8; ++d0) qr[d0] = bf16x8{};
    }
    f32x16 o[4] = {}; float R = 1.f;
    const int sr = tid >> 4, sc = (tid & 15) * 8, vst0 = v_st(sr, sc), vst1 = v_st(32 + sr, sc);
    const int vb0 = (int)(unsigned)(uintptr_t)Vl + v_rd_base(lane);
    const bf16* Kb = (const bf16*)(F.ws + W_K); const bf16* Vb = (const bf16*)(F.ws + W_V);
    const float* nk = F.out + OUT_KS + ((size_t)(l * 32 + b) * 64) * 1024 + h * 128; const float* nv = F.out + OUT_VS + ((size_t)(l * 32 + b) * 64) * 1024 + h * 128;
    const float* ckb = F.ck + ((size_t)(l * 32 + b) * 2048) * 1024 + h * 128; const float* cvb = F.cv + ((size_t)(l * 32 + b) * 2048) * 1024 + h * 128;
#define TILE_POS(j) (SAMPLE ? ((j) == 0 ? 2048 : 2048 - 64 * (j)) : 64 * (nt - 1 - (j)))
    f32x8v fk0, fk1, fv0, fv1; bf16x8 bk0, bk1, bv0, bv1;
#define SLOAD(j) do { if constexpr (SAMPLE) { const float* kp = (j) == 0 ? nk : ckb + (size_t)(2048 - 64 * (j)) * 1024; const float* vp = (j) == 0 ? nv : cvb + (size_t)(2048 - 64 * (j)) * 1024; \
        fk0 = *(const f32x8v*)(kp + (size_t)sr * 1024 + sc); fk1 = *(const f32x8v*)(kp + (size_t)(32 + sr) * 1024 + sc); fv0 = *(const f32x8v*)(vp + (size_t)sr * 1024 + sc); fv1 = *(const f32x8v*)(vp + (size_t)(32 + sr) * 1024 + sc); } \
    else { const size_t ro = ((size_t)(b * 2048 + TILE_POS(j) + sr)) * 1024 + h * 128 + sc; bk0 = *(const bf16x8*)(Kb + ro); bk1 = *(const bf16x8*)(Kb + ro + 32 * 1024); bv0 = *(const bf16x8*)(Vb + ro); bv1 = *(const bf16x8*)(Vb + ro + 32 * 1024); } } while (0)
#define TOBF(x) ({ u32x4 w__ = {cvtpk(x[0], x[1]), cvtpk(x[2], x[3]), cvtpk(x[4], x[5]), cvtpk(x[6], x[7])}; *reinterpret_cast<bf16x8*>(&w__); })
#define SWRITE(bufi) do { LAS unsigned char* vd = Vl + (bufi) * A_TILE; LAS unsigned char* kd = (LAS unsigned char*)Kl + (bufi) * A_TILE; const int kc = sc * 2; \
        if constexpr (SAMPLE) { *(LAS bf16x8*)(vd + vst0) = TOBF(fv0); *(LAS bf16x8*)(vd + vst1) = TOBF(fv1); *(LAS bf16x8*)(kd + KSWZ(sr, kc)) = TOBF(fk0); *(LAS bf16x8*)(kd + KSWZ(32 + sr, kc)) = TOBF(fk1); } \
        else { *(LAS bf16x8*)(vd + vst0) = bv0; *(LAS bf16x8*)(vd + vst1) = bv1; *(LAS bf16x8*)(kd + KSWZ(sr, kc)) = bk0; *(LAS bf16x8*)(kd + KSWZ(32 + sr, kc)) = bk1; } } while (0)
    SLOAD(0); asm volatile("s_waitcnt vmcnt(0)" ::: "memory"); SWRITE(0); __syncthreads();
    for (int j = 0; j < nt; ++j) {
        if (j + 1 < nt) SLOAD(j + 1);
        const int kpos0 = TILE_POS(j);
        if (active && kpos0 < wrow_lo + 31) {
            f32x16 p0, p1; bf16x8 pa0, pa1, pa2, pa3;
            qkt(p0, p1, Kl + (j & 1) * A_TILE, qr, r32, hi);
            const bool need_mask = !(kpos0 + 63 < wrow_lo);
            sb_half(p1, R, hi, need_mask, kpos0 + 32, qpos);
            sb_half(p0, R, hi, need_mask, kpos0, qpos);
            PK4(p0, 0, pa0); PK4(p0, 8, pa1); PK4(p1, 0, pa2); PK4(p1, 8, pa3);
            const int vb = vb0 + (j & 1) * A_TILE;
            pv_one<0>(o[0], vb, pa0, pa1, pa2, pa3); pv_one<1>(o[1], vb, pa0, pa1, pa2, pa3); pv_one<2>(o[2], vb, pa0, pa1, pa2, pa3); pv_one<3>(o[3], vb, pa0, pa1, pa2, pa3);
        }
        if (j + 1 < nt) { asm volatile("s_waitcnt vmcnt(0)" ::: "memory"); SWRITE((j + 1) & 1); }
        __syncthreads();
    }
    if (active) {
        bf16* Ow = (bf16*)(F.ws + W_ATT) + (SAMPLE ? (size_t)(MP + b * 64 + 32 * wid) : (size_t)(b * 2048 + wrow_lo)) * 1024 + h * 128 + r32;
#pragma unroll
        for (int r = 0; r < 16; ++r) { const int orow = crow(r, hi);
#pragma unroll
            for (int d0 = 0; d0 < 4; ++d0) Ow[(size_t)orow * 1024 + d0 * 32] = (bf16)f2bf(o[d0][r]); }
    }
#undef SLOAD
#undef SWRITE
#undef TILE_POS
}
__device__ __forceinline__ void sgu_unit(Frame& F, int l, int tile) {
    const int tid = opq(F.tid), wid = F.wave, lane = tid & 63, r32 = lane & 31, hi = lane >> 5;
    const int row0 = tile * 128; const bool samp = row0 >= MP;
    const float* VS = (const float*)(F.ws + W_VS); const bf16* U = (const bf16*)(F.ws + W_U); bf16* BB = (bf16*)(F.ws + W_BB);
    const bf16* WM = (const bf16*)(F.ws + W_WM) + ((size_t)(l * 2 + (samp ? 1 : 0)) * 8) * 16384;
    const float* gn = F.sgun + l * 1024; const float* bs = F.bsp + l * 1024;
    LAS float* rst = (LAS float*)(F.lds + 65536);
    for (int i = 0; i < 16; ++i) { const int r = wid * 16 + i; const float* p = VS + (size_t)(row0 + r) * 1024 + lane * 4; float q = 0.f;
#pragma unroll
        for (int j = 0; j < 4; ++j) { const f32x4 v = *(const f32x4*)(p + j * 256); q += (v[0] * v[0] + v[1] * v[1]) + (v[2] * v[2] + v[3] * v[3]); }
        q = wave_sum(q); if (lane == 0) rst[r] = __builtin_amdgcn_rsqf(q * (1.0f / 1024.0f) + EPS); }
    __syncthreads();
    const int sr = tid >> 4, sc = (tid & 15) * 8;
    const int rg = wid & 3, ch = wid >> 2;
    const int vb0 = (int)(unsigned)(uintptr_t)F.lds + v_rd_base(lane);
    float* sgo = F.out + OUT_SG + ((size_t)l * MS) * 1024;
    for (int g = 0; g < 8; ++g) {
        const f32x8v gv = *(const f32x8v*)(gn + g * 128 + sc);
#pragma unroll
        for (int i = 0; i < 4; ++i) { const int s = sr + 32 * i; const size_t grow = (size_t)(row0 + s);
            f32x8v v = *(const f32x8v*)(VS + grow * 1024 + g * 128 + sc); const float rr = rst[s];
#pragma unroll
            for (int j = 0; j < 8; ++j) v[j] = v[j] * rr * gv[j];
            if (samp) *(f32x8v*)(sgo + (grow - MP) * 1024 + g * 128 + sc) = v;
            u32x4 w = {cvtpk(v[0], v[1]), cvtpk(v[2], v[3]), cvtpk(v[4], v[5]), cvtpk(v[6], v[7])};
            *(LAS u32x4*)(F.lds + (s >> 6) * A_TILE + v_st(s & 63, sc)) = w; }
        __syncthreads();
        f32x16 o2[2] = {};
        const bf16* wrow = WM + ((size_t)g * 128 + rg * 32 + r32) * 128 + hi * 8;
#pragma unroll
        for (int kt = 0; kt < 2; ++kt) {
            const bf16x8 pa0 = *(const bf16x8*)(wrow + kt * 64), pa1 = *(const bf16x8*)(wrow + kt * 64 + 16), pa2 = *(const bf16x8*)(wrow + kt * 64 + 32), pa3 = *(const bf16x8*)(wrow + kt * 64 + 48);
            const int vb = vb0 + kt * A_TILE;
            if (ch == 0) { pv_one<0>(o2[0], vb, pa0, pa1, pa2, pa3); pv_one<1>(o2[1], vb, pa0, pa1, pa2, pa3); }
            else { pv_one<2>(o2[0], vb, pa0, pa1, pa2, pa3); pv_one<3>(o2[1], vb, pa0, pa1, pa2, pa3); }
        }
#pragma unroll
        for (int r = 0; r < 16; ++r) { const int t = rg * 32 + crow(r, hi); const float bias = bs[g * 128 + (samp ? (t & 63) : t)];
#pragma unroll
            for (int i = 0; i < 2; ++i) { const size_t off = (size_t)(row0 + t) * 1024 + g * 128 + (2 * ch + i) * 32 + r32;
                const float uu = __uint_as_float(((unsigned)U[off]) << 16); BB[off] = (bf16)f2bf(uu * (o2[i][r] + bias)); } }
        __syncthreads();
    }
}
constexpr int N_PHASES = 14;
struct Args { const float* in[17]; float* out; unsigned char* ws; int ph_lo, ph_hi, li, pad; };
__global__ void __launch_bounds__(NWAVES * 64, 2) mk_fwd(Args args) {
    extern __shared__ __attribute__((aligned(16))) unsigned char lds_raw[];
    Frame F;
    F.lds = (LAS unsigned char*)lds_raw; F.MISC = (volatile LAS unsigned*)(F.lds + MISC_OFF);
    F.tid = threadIdx.x; F.lane = F.tid & 63; F.wave = __builtin_amdgcn_readfirstlane(F.tid >> 6);
    F.G = gridDim.x; { const int bx = blockIdx.x; F.vcu = (F.G % 8 == 0) ? (bx % 8) * (F.G / 8) + bx / 8 : bx; }
    F.xp = args.in[0]; F.xs = args.in[1]; F.ck = args.in[2]; F.cv = args.in[3]; F.nmix = args.in[4]; F.win = args.in[5]; F.bgate = args.in[6]; F.sgun = args.in[7]; F.wsp = args.in[8]; F.bsp = args.in[9];
    F.wa = args.in[10]; F.wb = args.in[11]; F.wout = args.in[12]; F.nffn = args.in[13]; F.wgu = args.in[14]; F.wd = args.in[15]; F.nfin = args.in[16];
    F.out = args.out; F.ws = args.ws;
    for (int u = F.tid; u < (LDS_BYTES - LDSCTL_OFF) / 4; u += NWAVES * 64) ((LAS unsigned*)(F.lds + LDSCTL_OFF))[u] = 0u;
    __syncthreads();
    gu32* ctl = (gu32*)(F.ws + W_CTL);
    XcdBarrier bar = xcd_barrier_post((unsigned*)(ctl + CW_BAR) + args.li * XCD_BAR_WORDS, F.MISC + 8);
    const int lo = args.ph_lo, hi = args.ph_hi;
#define IN(k) (lo <= (k) && (k) < hi)
#define SEAM(k) do { if (IN(k) && IN((k) + 1)) xcd_barrier(bar); } while (0)
    unsigned char* ws = F.ws;
    bf16_t* HB = (bf16_t*)(ws + W_HB); float* SS = (float*)(ws + W_SS); float* H = F.out + OUT_Y;
    if (IN(0)) p0_prologue(F);
    SEAM(0);
    for (int l = 0; l < 2; ++l) {
        const int pb = 1 + 6 * l; unsigned char* wl = ws + W_WL + (size_t)l * WL_STRIDE;
        if (IN(pb)) {
            SchedSimple S{40, 36, F.G, (int)blockIdx.x, 2048, 2048, (const char*)HB, (const char*)(wl + WL_IN)};
            EpiIn E{SS, (bf16_t*)(ws + W_Q), (bf16_t*)(ws + W_K), (bf16_t*)(ws + W_V), (bf16_t*)(ws + W_U), (bf16_t*)(ws + W_G), (float*)(ws + W_VS), F.bgate + l * 4096,
                    F.out + OUT_KP + (size_t)l * MP * 1024, F.out + OUT_VP + (size_t)l * MP * 1024, F.out + OUT_KS + (size_t)l * MS * 1024, F.out + OUT_VS + (size_t)l * MS * 1024};
            pg8::gemm_phase<EpiIn, SchedSimple>(F.lds, S, E);
        }
        SEAM(pb);
        if (IN(pb + 1)) {
            const int c = F.vcu;
            for (int pu = c; pu < 256; pu += F.G) { const int qb = 7 - (pu >> 5), bh = pu & 31; attn_unit<false>(F, l, bh >> 3, bh & 7, qb); }
            for (int su = c; su < 256; su += F.G) attn_unit<true>(F, l, su >> 3, su & 7, 0);
            for (int tu = F.G - 1 - c; tu < 80; tu += F.G) sgu_unit(F, l, tu);
        }
        SEAM(pb + 1);
        if (IN(pb + 2)) {
            SchedBranch S{40, 8, F.G, (int)blockIdx.x, 1024, 1024, (const char*)(ws + W_ATT), (const char*)(wl + WL_A), (const char*)(ws + W_BB), (const char*)(wl + WL_B)};
            EpiMerge E{(const bf16_t*)(ws + W_G), (bf16_t*)(ws + W_MG)};
            pg8::gemm_phase<EpiMerge, SchedBranch>(F.lds, S, E);
        }
        SEAM(pb + 2);
        if (IN(pb + 3)) {
            SchedSimple S{40, 8, F.G, (int)blockIdx.x, 2048, 2048, (const char*)(ws + W_MG), (const char*)(wl + WL_OUT)};
            EpiRes E{l == 0 ? F.xp : (const float*)H, l == 0 ? F.xs : (const float*)(H + (size_t)MP * 2048), H, HB, SS, 1};
            pg8::gemm_phase<EpiRes, SchedSimple>(F.lds, S, E);
        }
        SEAM(pb + 3);
        if (IN(pb + 4)) {
            SchedSimple S{40, 44, F.G, (int)blockIdx.x, 2048, 2048, (const char*)HB, (const char*)(wl + WL_GU)};
            EpiGU E{SS, (bf16_t*)(ws + W_ACT)};
            pg8::gemm_phase<EpiGU, SchedSimple>(F.lds, S, E);
        }
        SEAM(pb + 4);
        if (IN(pb + 5)) {
            SchedSimple S{40, 8, F.G, (int)blockIdx.x, 5632, 5632, (const char*)(ws + W_ACT), (const char*)(wl + WL_D)};
            EpiRes E{(const float*)H, (const float*)(H + (size_t)MP * 2048), H, HB, SS, l == 0 ? 1 : 0};
            pg8::gemm_phase<EpiRes, SchedSimple>(F.lds, S, E);
        }
        SEAM(pb + 5);
    }
    if (IN(13)) p_final(F);
#undef IN
#undef SEAM
}
static int g_grid = 0;
static inline bool fast_setup() {
    if (g_grid == 0) {
        int dev = 0, cus = 0;
        if (hipGetDevice(&dev) != hipSuccess || hipDeviceGetAttribute(&cus, hipDeviceAttributeMultiprocessorCount, dev) != hipSuccess) { g_grid = -1; return false; }
        if (hipFuncSetAttribute((const void*)mk_fwd, hipFuncAttributeMaxDynamicSharedMemorySize, LDS_BYTES) != hipSuccess) { fprintf(stderr, "hipFuncSetAttribute failed\n"); g_grid = -1; return false; }
        int per_cu = 0; (void)hipOccupancyMaxActiveBlocksPerMultiprocessor(&per_cu, (const void*)mk_fwd, NWAVES * 64, LDS_BYTES); (void)hipGetLastError();
        if (per_cu < 1) fprintf(stderr, "note: occupancy query reports %d\n", per_cu);
        g_grid = cus;
    }
    return g_grid > 0;
}
static inline void fast_launch(hipStream_t stream, void* const* d_in, float* out, unsigned char* wsbase, int lo, int hi, int li) {
    Args a{}; for (int i = 0; i < 17; ++i) a.in[i] = (const float*)d_in[i];
    a.out = out; a.ws = wsbase; a.ph_lo = lo; a.ph_hi = hi; a.li = li; a.pad = 0;
    hipLaunchKernelGGL(mk_fwd, dim3(g_grid), dim3(NWAVES * 64), LDS_BYTES, stream, a);
}
}
extern "C" void kernel_launch(void* const* d_in, const int* in_sizes, int n_in, void* d_out, int out_size, void* d_ws, size_t ws_size, hipStream_t stream) {
    if (!fk::fast_setup()) return;
    if (n_in != 17 || out_size != (int)fk::OUT_N || ws_size < fk::W_END) { fprintf(stderr, "kernel_launch: unexpected shapes (n_in %d out %d ws %zu)\n", n_in, out_size, ws_size); return; }
    (void)hipMemsetAsync((char*)d_ws + fk::W_CTL, 0, fk::CTL_ZERO_BYTES, stream);
#if MK_N_LAUNCHES == 1
    fk::fast_launch(stream, d_in, (float*)d_out, (unsigned char*)d_ws, 0, fk::N_PHASES, 0);
#else
    for (int p = 0; p < fk::N_PHASES; ++p) fk::fast_launch(stream, d_in, (float*)d_out, (unsigned char*)d_ws, p, p + 1, p);
#endif
}
```

```cpp
#include <hip/hip_runtime.h>
#include <cstdio>
#include <cstdint>
#ifndef MK_N_LAUNCHES
#define MK_N_LAUNCHES 1
#endif
namespace pg8 {
#define PG8_LAS __attribute__((address_space(3)))
typedef unsigned short bf16_t;
typedef short bf16x8 __attribute__((ext_vector_type(8)));
typedef float f32x4 __attribute__((ext_vector_type(4)));
typedef unsigned u32x4 __attribute__((ext_vector_type(4)));
constexpr int BM = 256, BK = 64, HALF = 128, HTB = HALF * BK * 2  , STAGE_BYTES = 8 * HTB, NXCD = 8, WGM = 8;

__host__ __device__ __forceinline__ int lds_byte(int r, int c) { const int st = (r >> 4) * 2 + (c >> 5), rr = r & 15, cc = c & 31, ob = rr * 64 + cc * 2; return st * 1024 + (ob ^ (((ob >> 9) & 1) << 5)); }
__host__ __device__ __forceinline__ void stage_rc(int b, int& R, int& C) { const int st = b / 1024, sb = b % 1024, swz = sb ^ (((sb >> 9) & 1) << 5); R = (st >> 1) * 16 + swz / 64; C = (st & 1) * 32 + (swz % 64) / 2; }
__host__ __device__ __forceinline__ int perm32(int rho) { const int n = rho >> 4, i = rho & 15; return 8 * (i >> 2) + 4 * n + (i & 3); }

struct Unit { int pm, pn, br; };
template <class Epi, class Sched, bool ALIGN_EPI = true, bool SP2 = true>
__device__ __forceinline__ void gemm_phase(PG8_LAS unsigned char* lds, const Sched& S, const Epi& E) {
    int tid_ = threadIdx.x; asm volatile("" : "+v"(tid_));
    const int tid = tid_, wid = __builtin_amdgcn_readfirstlane(tid >> 6), lane = tid & 63, wr = wid >> 2, wc = wid & 3, fr = lane & 15, fq = lane >> 4;
    const int K = S.K, nt = S.KT / BK;
    unsigned voffA[2], voffB[2];
#pragma unroll
    for (int i = 0; i < 2; ++i) { int R, C; stage_rc(tid * 16 + i * 8192, R, C); const int Rb = Epi::PERM ? ((R & ~31) + perm32(R & 31)) : R;
        voffA[i] = (unsigned)(R * K + C) * 2u; voffB[i] = (unsigned)(Rb * K + C) * 2u; }
    const size_t kstep = (size_t)(BK * 2);
    const size_t hstep = (size_t)HALF * K * 2;
        const unsigned ldsw = (unsigned)wid * 1024u;
    const int aoff = lds_byte(wr * 64 + fr, fq * 8), boff = lds_byte(wc * 32 + fr, fq * 8);
#define PG8_SA(b, h) (((b) * 2 + (h)) * HTB)
#define PG8_SB(b, h) ((4 + (b) * 2 + (h)) * HTB)
#define PG8_STAGE(bufoff, gbase, voff) do { _Pragma("unroll") for (int _i = 0; _i < 2; ++_i) \
        __builtin_amdgcn_global_load_lds((const unsigned*)((const char*)(gbase) + (voff)[_i]), (PG8_LAS unsigned*)(lds + (bufoff) + ldsw + _i * 8192), 16, 0, 0); } while (0)
#define PG8_LDA(dst, b, h) do { _Pragma("unroll") for (int m = 0; m < 4; ++m) _Pragma("unroll") for (int k = 0; k < 2; ++k) dst[m][k] = *(const PG8_LAS bf16x8*)(lds + PG8_SA(b, h) + aoff + m * 2048 + k * 1024); } while (0)
#define PG8_LDB(dst, b, h) do { _Pragma("unroll") for (int n = 0; n < 2; ++n) _Pragma("unroll") for (int k = 0; k < 2; ++k) dst[n][k] = *(const PG8_LAS bf16x8*)(lds + PG8_SB(b, h) + boff + n * 2048 + k * 1024); } while (0)
#define PG8_MMA(ai, bj, At, Bt) do { __builtin_amdgcn_s_setprio(1); _Pragma("unroll") for (int m = 0; m < 4; ++m) _Pragma("unroll") for (int n = 0; n < 2; ++n) _Pragma("unroll") for (int k = 0; k < 2; ++k) \
        acc[ai][bj][m][n] = __builtin_amdgcn_mfma_f32_16x16x32_bf16(Bt[n][k], At[m][k], acc[ai][bj][m][n], 0, 0, 0); __builtin_amdgcn_s_setprio(0); } while (0)
#define PG8_WAIT_V(n) asm volatile("s_waitcnt vmcnt(" #n ")" ::: "memory")
#define PG8_WAIT_L(n) asm volatile("s_waitcnt lgkmcnt(" #n ")" ::: "memory")
#define PG8_BAR __builtin_amdgcn_s_barrier()
#define PG8_SCHED __builtin_amdgcn_sched_barrier(0)
    Unit cur, nxt; int ui = 0;
    if (!S.next(0, cur)) return;
    f32x4 acc[2][2][4][2];
#pragma unroll
    for (int a = 0; a < 2; ++a)
#pragma unroll
        for (int b = 0; b < 2; ++b)
#pragma unroll
            for (int m = 0; m < 4; ++m)
#pragma unroll
                for (int n = 0; n < 2; ++n) acc[a][b][m][n] = (f32x4){0.f, 0.f, 0.f, 0.f};
    bf16x8 At[4][2], B0[2][2], B1[2][2];
    const char* cA = S.a_base(cur); const char* cB = S.b_base(cur);
    if constexpr (SP2) {
        PG8_STAGE(PG8_SB(0, 0), cB, voffB); PG8_STAGE(PG8_SB(0, 1), cB + hstep, voffB); PG8_STAGE(PG8_SA(0, 0), cA, voffA); PG8_STAGE(PG8_SA(0, 1), cA + hstep, voffA);
        if (wr == 1) PG8_BAR;
        PG8_WAIT_V(2); PG8_BAR;
        PG8_STAGE(PG8_SB(1, 0), cB + kstep, voffB); PG8_STAGE(PG8_SA(1, 0), cA + kstep, voffA); PG8_STAGE(PG8_SB(1, 1), cB + hstep + kstep, voffB);
        PG8_WAIT_V(6); PG8_BAR;
    } else {
        PG8_STAGE(PG8_SB(0, 0), cB, voffB); PG8_STAGE(PG8_SA(0, 0), cA, voffA); PG8_STAGE(PG8_SB(0, 1), cB + hstep, voffB); PG8_STAGE(PG8_SA(0, 1), cA + hstep, voffA);
        if (wr == 1) PG8_BAR;
        PG8_WAIT_V(4); PG8_BAR;
        PG8_STAGE(PG8_SB(1, 0), cB + kstep, voffB); PG8_STAGE(PG8_SA(1, 0), cA + kstep, voffA); PG8_STAGE(PG8_SB(1, 1), cB + hstep + kstep, voffB);
        PG8_WAIT_V(6); PG8_BAR;
    }
    for (;;) {
        const bool has_next = S.next(ui + 1, nxt);
        const char* nA = has_next ? S.a_base(nxt) : cA; const char* nB = has_next ? S.b_base(nxt) : cB;
        for (int t = 0; t < nt; t += 2) {
            const bool last = (t == nt - 2);
            const char* a1 = cA + (size_t)(t + 1) * kstep;
            const char* a2 = last ? nA : cA + (size_t)(t + 2) * kstep; const char* b2 = last ? nB : cB + (size_t)(t + 2) * kstep;
            const char* a3 = a2 + kstep; const char* b3 = b2 + kstep;
            if constexpr (SP2) {
            PG8_LDB(B0, 0, 0); PG8_LDB(B1, 0, 1); PG8_SCHED; PG8_LDA(At, 0, 0); PG8_STAGE(PG8_SA(1, 1), a1 + hstep, voffA);
            PG8_WAIT_V(8); PG8_WAIT_L(0); PG8_BAR; PG8_MMA(0, 0, At, B0); PG8_MMA(0, 1, At, B1); PG8_BAR; PG8_SCHED;
            PG8_LDA(At, 0, 1); PG8_STAGE(PG8_SB(0, 0), b2, voffB); PG8_STAGE(PG8_SB(0, 1), b2 + hstep, voffB); PG8_STAGE(PG8_SA(0, 0), a2, voffA);
            PG8_WAIT_V(8); PG8_WAIT_L(0); PG8_BAR; PG8_MMA(1, 0, At, B0); PG8_MMA(1, 1, At, B1); PG8_BAR; PG8_SCHED;
            PG8_LDB(B0, 1, 0); PG8_LDB(B1, 1, 1); PG8_SCHED; PG8_LDA(At, 1, 0); PG8_STAGE(PG8_SA(0, 1), a2 + hstep, voffA);
            PG8_WAIT_V(8); PG8_WAIT_L(0); PG8_BAR; PG8_MMA(0, 0, At, B0); PG8_MMA(0, 1, At, B1); PG8_BAR; PG8_SCHED;
            PG8_LDA(At, 1, 1); PG8_STAGE(PG8_SB(1, 0), b3, voffB); PG8_STAGE(PG8_SB(1, 1), b3 + hstep, voffB); PG8_STAGE(PG8_SA(1, 0), a3, voffA);
            PG8_WAIT_V(8); PG8_WAIT_L(0); PG8_BAR; PG8_MMA(1, 0, At, B0); PG8_MMA(1, 1, At, B1); PG8_BAR; PG8_SCHED;
            } else {
            PG8_LDB(B0, 0, 0); PG8_SCHED; PG8_LDA(At, 0, 0); PG8_STAGE(PG8_SA(1, 1), a1 + hstep, voffA);
            PG8_WAIT_L(8); PG8_BAR; PG8_WAIT_L(0); PG8_MMA(0, 0, At, B0); PG8_BAR; PG8_SCHED;
            PG8_LDB(B1, 0, 1); PG8_STAGE(PG8_SB(0, 0), b2, voffB);
            PG8_BAR; PG8_WAIT_L(0); PG8_MMA(0, 1, At, B1); PG8_BAR;
            PG8_LDA(At, 0, 1); PG8_STAGE(PG8_SA(0, 0), a2, voffA);
            PG8_BAR; PG8_WAIT_L(0); PG8_MMA(1, 0, At, B0); PG8_BAR; PG8_SCHED;
            PG8_STAGE(PG8_SB(0, 1), b2 + hstep, voffB);
            PG8_WAIT_V(6); PG8_BAR; PG8_MMA(1, 1, At, B1); PG8_BAR;
            PG8_LDB(B0, 1, 0); PG8_SCHED; PG8_LDA(At, 1, 0); PG8_STAGE(PG8_SA(0, 1), a2 + hstep, voffA);
            PG8_WAIT_L(8); PG8_BAR; PG8_WAIT_L(0); PG8_MMA(0, 0, At, B0); PG8_BAR; PG8_SCHED;
            PG8_LDB(B1, 1, 1); PG8_STAGE(PG8_SB(1, 0), b3, voffB);
            PG8_BAR; PG8_WAIT_L(0); PG8_MMA(0, 1, At, B1); PG8_BAR;
            PG8_LDA(At, 1, 1); PG8_STAGE(PG8_SA(1, 0), a3, voffA);
            PG8_BAR; PG8_WAIT_L(0); PG8_MMA(1, 0, At, B0); PG8_BAR; PG8_SCHED;
            PG8_STAGE(PG8_SB(1, 1), b3 + hstep, voffB);
            PG8_WAIT_V(6); PG8_BAR; PG8_MMA(1, 1, At, B1); PG8_BAR;
            }
        }
        if constexpr (ALIGN_EPI) { if (wr == 0) PG8_BAR; }
        E(acc, cur, wr, wc, fr, fq);
        if (!has_next) break;
        if (!E.keep(cur)) {
#pragma unroll
        for (int a = 0; a < 2; ++a)
#pragma unroll
            for (int b = 0; b < 2; ++b)
#pragma unroll
                for (int m = 0; m < 4; ++m)
#pragma unroll
                    for (int n = 0; n < 2; ++n) acc[a][b][m][n] = (f32x4){0.f, 0.f, 0.f, 0.f};
        }
        cur = nxt; cA = nA; cB = nB; ++ui;
        if constexpr (ALIGN_EPI) { if (wr == 1) PG8_BAR; }
    }
    PG8_WAIT_V(0);
    if constexpr (!ALIGN_EPI) { if (wr == 0) PG8_BAR; }
    PG8_BAR;
#undef PG8_SA
#undef PG8_SB
#undef PG8_STAGE
#undef PG8_LDA
#undef PG8_LDB
#undef PG8_MMA
#undef PG8_WAIT_V
#undef PG8_WAIT_L
#undef PG8_BAR
#undef PG8_SCHED
}
}
namespace fk {
using pg8::Unit; using pg8::bf16_t;
typedef float f32x16 __attribute__((ext_vector_type(16)));
typedef float f32x8v __attribute__((ext_vector_type(8)));
typedef short s16x4 __attribute__((ext_vector_type(4)));
typedef unsigned u32x4 __attribute__((ext_vector_type(4)));
typedef unsigned u32x2 __attribute__((ext_vector_type(2)));
constexpr int NWAVES = 8;
constexpr int M = 10240, MP = 8192, MS = 2048, DM = 2048, NIN = 9216, FF = 5632, NGU = 11264, SBW = 1024;
constexpr float EPS = 1e-6f;
constexpr float QSCALE = 1.4426950408889634f * 0.08838834764831845f;
constexpr size_t OUT_Y = 0, OUT_KP = 20971520, OUT_VP = 37748736, OUT_KS = 54525952, OUT_VS = 58720256, OUT_SG = 62914560, OUT_N = 67108864;
constexpr size_t MiB = 1u << 20;
constexpr size_t W_CTL = 0, CTL_ZERO_BYTES = 1 * MiB;
constexpr size_t W_WL = 1 * MiB, WL_STRIDE = 118 * MiB;
constexpr size_t WL_IN = 0, WL_A = 36 * MiB, WL_B = 40 * MiB, WL_OUT = 44 * MiB, WL_GU = 52 * MiB, WL_D = 96 * MiB;
constexpr size_t W_WM = 237 * MiB;
constexpr size_t W_HB = 238 * MiB, W_SS = 278 * MiB, W_Q = 280 * MiB, W_K = 300 * MiB, W_V = 320 * MiB, W_U = 340 * MiB, W_VS = 360 * MiB, W_G = 400 * MiB,
                 W_ATT = 480 * MiB, W_BB = 500 * MiB, W_MG = 520 * MiB, W_ACT = 560 * MiB, W_END = 670 * MiB;
constexpr int CW_TMO = 0, CW_BAR = 4096;
constexpr int RING_BYTES = 131072, LDSCTL_OFF = RING_BYTES, MISC_OFF = LDSCTL_OFF + 320, LDS_BYTES = 147456;

#define GAS __attribute__((address_space(1)))
#define LAS __attribute__((address_space(3)))
typedef unsigned short bf16;
typedef unsigned v4u __attribute__((ext_vector_type(4)));
typedef float f32x4 __attribute__((ext_vector_type(4)));
typedef short bf16x8 __attribute__((ext_vector_type(8)));
typedef GAS unsigned gu32;
typedef GAS unsigned long long gu64;
#define RLX_AGENT __ATOMIC_RELAXED, __HIP_MEMORY_SCOPE_AGENT
#define LDS_WAIT() asm volatile("s_waitcnt lgkmcnt(0)" ::: "memory")
#define VM_WAIT() asm volatile("s_waitcnt vmcnt(0)" ::: "memory")
__device__ __forceinline__ unsigned long long rt() { return __builtin_amdgcn_s_memrealtime(); }
__device__ __forceinline__ unsigned f2bf(float f) { unsigned u = __builtin_bit_cast(unsigned, f); return (u + 0x7fffu + ((u >> 16) & 1u)) >> 16; }
__device__ __forceinline__ unsigned pk2(float lo, float hi) { return f2bf(lo) | (f2bf(hi) << 16); }
#define XB_TMO      128
#define XB_XCNT(j)  (256  + 64 * (j))
#define XB_XSUB(j)  (1280 + 64 * (j))
#define XB_XGEN(j)  (2304 + 64 * (j))
#define XB_TOP      3328
#define XB_TOPGEN   3392
#define XCD_BAR_WORDS 3456
#define XB_SPIN_CAP (1u << 18)

__device__ __forceinline__ unsigned xb_ld(unsigned* p)              { return __hip_atomic_load(p, __ATOMIC_RELAXED, __HIP_MEMORY_SCOPE_AGENT); }
__device__ __forceinline__ unsigned xb_add(unsigned* p, unsigned v) { return __hip_atomic_fetch_add(p, v, __ATOMIC_RELAXED, __HIP_MEMORY_SCOPE_AGENT); }
__device__ __forceinline__ unsigned xb_xcc_id() { return (unsigned)__builtin_amdgcn_s_getreg((3 << 11) | 20) & 0xFu; }
#define XB_SPIN(cond, bar) do { unsigned _sp = 0; while (cond) { __builtin_amdgcn_s_sleep(1); \
    if ((++_sp & 255u) == 0u) { if (xb_ld(&(bar)[XB_TMO])) break; if (_sp > XB_SPIN_CAP) { atomicAdd(&(bar)[XB_TMO], 1u); break; } } } } while (0)

struct XcdBarrier {
    unsigned* bar; unsigned x;
    volatile LAS unsigned* st;
};

__device__ __forceinline__ XcdBarrier xcd_barrier_post(unsigned* bar, volatile LAS unsigned* st) {
    XcdBarrier b; b.bar = bar; b.x = xb_xcc_id(); b.st = st;
    if (threadIdx.x == 0) (void)xb_add(&bar[XB_XCNT(b.x)], 1u);
    return b;
}
__device__ __forceinline__ void xcd_barrier_complete(unsigned* bar, unsigned x, unsigned& nloc, unsigned& nx) {
    const unsigned G = gridDim.x * gridDim.y * gridDim.z;
    unsigned sum, cnt, mine, sp = 0u;
    for (;;) {
        sum = 0u; cnt = 0u; mine = 0u;
#pragma unroll
        for (unsigned j = 0; j < 16; ++j) { const unsigned c = xb_ld(&bar[XB_XCNT(j)]); sum += c; cnt += (c > 0u) ? 1u : 0u; mine = (j == x) ? c : mine; }
        if (sum == G) break;
        __builtin_amdgcn_s_sleep(1);
        if ((++sp & 255u) == 0u) { if (xb_ld(&bar[XB_TMO])) break; if (sp > XB_SPIN_CAP) { atomicAdd(&bar[XB_TMO], 1u); break; } }
    }
    nloc = mine > 0u ? mine : 1u; nx = cnt > 0u ? cnt : 1u;
}

__device__ __forceinline__ void xcd_barrier(const XcdBarrier& b) {
    asm volatile("s_waitcnt vmcnt(0)" ::: "memory");
    __syncthreads();
    if (threadIdx.x == 0) {
        unsigned* bar = b.bar;
        __builtin_amdgcn_s_waitcnt(0);
        unsigned nloc = b.st[0], nx = b.st[1];
        if (nloc == 0u) { xcd_barrier_complete(bar, b.x, nloc, nx); b.st[0] = nloc; b.st[1] = nx; }
        const unsigned old = xb_add(&bar[XB_XSUB(b.x)], 1u);
        const unsigned gen = old / nloc;
        if (old + 1u == (gen + 1u) * nloc) {
            __builtin_amdgcn_fence(__ATOMIC_RELEASE, "agent");
            asm volatile("s_waitcnt vmcnt(0)" ::: "memory");
            const unsigned og = xb_add(&bar[XB_TOP], 1u);
            const unsigned tg = og / nx;
            if (og + 1u == (tg + 1u) * nx) xb_add(&bar[XB_TOPGEN], 1u);
            else XB_SPIN(xb_ld(&bar[XB_TOPGEN]) == tg, bar);
            __builtin_amdgcn_fence(__ATOMIC_ACQUIRE, "agent");
            xb_add(&bar[XB_XGEN(b.x)], 1u);
            asm volatile("s_waitcnt vmcnt(0)" ::: "memory");
        } else {
            XB_SPIN(xb_ld(&bar[XB_XGEN(b.x)]) == gen, bar);
            __builtin_amdgcn_fence(__ATOMIC_ACQUIRE, "agent");
            asm volatile("s_waitcnt vmcnt(0)" ::: "memory");
        }
    }
    __syncthreads();
}

struct Frame {
    LAS unsigned char* lds; volatile LAS unsigned* MISC; int tid, lane, wave, vcu, G;
    const float *xp, *xs, *ck, *cv, *nmix, *win, *bgate, *sgun, *wsp, *bsp, *wa, *wb, *wout, *nffn, *wgu, *wd, *nfin;
    float* out; unsigned char* ws;
};
__device__ __forceinline__ int opq(int x) { asm volatile("" : "+v"(x)); return x; }
__device__ __forceinline__ float bf2f_lo(unsigned w) { return __uint_as_float(w << 16); }
__device__ __forceinline__ float bf2f_hi(unsigned w) { return __uint_as_float(w & 0xffff0000u); }
typedef __bf16 bf16x2_t __attribute__((ext_vector_type(2)));
__device__ __forceinline__ unsigned cvtpk(float lo, float hi) { const bf16x2_t v = {(__bf16)lo, (__bf16)hi}; return __builtin_bit_cast(unsigned, v); }
__device__ __forceinline__ float fsig(float y) { return __builtin_amdgcn_rcpf(1.f + __builtin_amdgcn_exp2f(-1.4426950408889634f * y)); }
__device__ __forceinline__ float fgelu(float x) { const float t = x * (-2.3022081f + -0.10294324f * x * x); return x * __builtin_amdgcn_rcpf(1.f + __builtin_amdgcn_exp2f(t)); }
__device__ __forceinline__ float wave_sum(float v) {
#pragma unroll
    for (int o = 1; o < 64; o <<= 1) v += __shfl_xor(v, o);
    return v;
}
__device__ __forceinline__ void tile_of(int L, int nM, int nN, int& pm, int& pn) {
    const int nwg = nM * nN; int wgid = L; { const int q = nwg / 8, r = nwg % 8, xcd = wgid % 8, off = wgid / 8; wgid = (xcd < r ? xcd * (q + 1) : r * (q + 1) + (xcd - r) * q) + off; }
    const int nig = 8 * nN, gid = wgid / nig, fm = gid * 8, gsz = (nM - fm) < 8 ? (nM - fm) : 8;
    pm = fm + ((wgid % nig) % gsz); pn = (wgid % nig) / gsz;
}
struct SchedSimple {
    int nM, nN, G, c, K, KT; const char* A; const char* Bt;
    __device__ __forceinline__ bool next(int i, Unit& u) const { const int L = i * G + c; if (L >= nM * nN) return false; tile_of(L, nM, nN, u.pm, u.pn); u.br = 0; return true; }
    __device__ __forceinline__ const char* a_base(const Unit& u) const { return A + (size_t)u.pm * 512 * K; }
    __device__ __forceinline__ const char* b_base(const Unit& u) const { return Bt + (size_t)u.pn * 512 * K; }
};
struct SchedBranch {
    int nM, nN, G, c, K, KT; const char *A0, *B0, *A1, *B1;
    __device__ __forceinline__ bool next(int i, Unit& u) const { const int L = (i >> 1) * G + c; if (L >= nM * nN) return false; tile_of(L, nM, nN, u.pm, u.pn); u.br = i & 1; return true; }
    __device__ __forceinline__ const char* a_base(const Unit& u) const { return (u.br ? A1 : A0) + (size_t)u.pm * 512 * K; }
    __device__ __forceinline__ const char* b_base(const Unit& u) const { return (u.br ? B1 : B0) + (size_t)u.pn * 512 * K; }
};
#define EPI_ROWS(ai, m) (u.pm * 256 + (ai) * 128 + wr * 64 + (m) * 16 + fr)
__device__ __forceinline__ void row_rstd(const float* SS, const Unit& u, int wr, int fr, int fq, float (&rs)[2][4]) {
#pragma unroll
    for (int ai = 0; ai < 2; ++ai)
#pragma unroll
        for (int m = 0; m < 4; ++m) { const f32x4* s = (const f32x4*)(SS + (size_t)EPI_ROWS(ai, m) * 32 + fq * 8); const f32x4 a = s[0], b = s[1];
            float t = ((a[0] + a[1]) + (a[2] + a[3])) + ((b[0] + b[1]) + (b[2] + b[3])); t += __shfl_xor(t, 16); t += __shfl_xor(t, 32);
            rs[ai][m] = __builtin_amdgcn_rsqf(t * (1.0f / 2048.0f) + EPS); }
}
__device__ __forceinline__ u32x4 pack8(const f32x4 v0, const f32x4 v1) { u32x4 w; w.x = cvtpk(v0[0], v0[1]); w.y = cvtpk(v0[2], v0[3]); w.z = cvtpk(v1[0], v1[1]); w.w = cvtpk(v1[2], v1[3]); return w; }
#ifdef DBG_GRAW
#define GATE_ACT(x) (x)
#else
#define GATE_ACT(x) fsig(x)
#endif
struct EpiIn {
    static constexpr bool PERM = true;
    const float* SS; bf16_t *Q, *Kb, *Vb, *U, *G; float* VS; const float* bgate; float *okp, *ovp, *oks, *ovs;
    __device__ __forceinline__ bool keep(const Unit&) const { return false; }
    __device__ __forceinline__ void operator()(f32x4 (&acc)[2][2][4][2], const Unit& u, int wr, int wc, int fr, int fq) const {
        float rs[2][4]; row_rstd(SS, u, wr, fr, fq, rs);
        const int colt = u.pn * 256, cl = wc * 32 + 8 * fq;
        if (colt < 1024) {
#pragma unroll
            for (int ai = 0; ai < 2; ++ai)
#pragma unroll
                for (int m = 0; m < 4; ++m) { const size_t row = EPI_ROWS(ai, m); const float sc = rs[ai][m] * QSCALE;
#pragma unroll
                    for (int bj = 0; bj < 2; ++bj) *(u32x4*)(Q + row * 1024 + colt + bj * 128 + cl) = pack8(acc[ai][bj][m][0] * sc, acc[ai][bj][m][1] * sc); }
        } else if (colt < 3072) {
            const bool isv = colt >= 2048; const int c0 = colt - (isv ? 2048 : 1024) + cl; bf16_t* B = isv ? Vb : Kb;
            float* O = (u.pm < 32) ? (isv ? ovp : okp) : ((isv ? ovs : oks) - (size_t)MP * 1024);
#pragma unroll
            for (int ai = 0; ai < 2; ++ai)
#pragma unroll
                for (int m = 0; m < 4; ++m) { const size_t row = EPI_ROWS(ai, m); const float sc = rs[ai][m];
#pragma unroll
                    for (int bj = 0; bj < 2; ++bj) { const f32x4 v0 = acc[ai][bj][m][0] * sc, v1 = acc[ai][bj][m][1] * sc; const size_t o = row * 1024 + c0 + bj * 128;
                        *(u32x4*)(B + o) = pack8(v0, v1); *(f32x4*)(O + o) = v0; *(f32x4*)(O + o + 4) = v1; } }
        } else if (colt < 5120) {
            const bool isvs = colt >= 4096; const int c0 = colt - (isvs ? 4096 : 3072) + cl;
#pragma unroll
            for (int ai = 0; ai < 2; ++ai)
#pragma unroll
                for (int m = 0; m < 4; ++m) { const size_t row = EPI_ROWS(ai, m); const float sc = rs[ai][m];
#pragma unroll
                    for (int bj = 0; bj < 2; ++bj) { f32x4 v0 = acc[ai][bj][m][0] * sc, v1 = acc[ai][bj][m][1] * sc;
#pragma unroll
                        for (int j = 0; j < 4; ++j) { v0[j] = fgelu(v0[j]); v1[j] = fgelu(v1[j]); }
                        const size_t o = row * 1024 + c0 + bj * 128;
                        if (isvs) { *(f32x4*)(VS + o) = v0; *(f32x4*)(VS + o + 4) = v1; } else *(u32x4*)(U + o) = pack8(v0, v1); } }
        } else {
            const int c0 = colt - 5120 + cl;
#pragma unroll
            for (int bj = 0; bj < 2; ++bj) { const f32x4 b0 = *(const f32x4*)(bgate + c0 + bj * 128), b1 = *(const f32x4*)(bgate + c0 + bj * 128 + 4);
#pragma unroll
                for (int ai = 0; ai < 2; ++ai)
#pragma unroll
                    for (int m = 0; m < 4; ++m) { const size_t row = EPI_ROWS(ai, m); const float sc = rs[ai][m];
                        f32x4 v0 = acc[ai][bj][m][0] * sc + b0, v1 = acc[ai][bj][m][1] * sc + b1;
#pragma unroll
                        for (int j = 0; j < 4; ++j) { v0[j] = GATE_ACT(v0[j]); v1[j] = GATE_ACT(v1[j]); }
                        *(u32x4*)(G + row * 4096 + c0 + bj * 128) = pack8(v0, v1); } }
        }
    }
};
struct EpiMerge {
    static constexpr bool PERM = true;
    const bf16_t* G; bf16_t* MG;
    __device__ __forceinline__ bool keep(const Unit& u) const { return u.br == 0; }
    __device__ __forceinline__ void operator()(f32x4 (&acc)[2][2][4][2], const Unit& u, int wr, int wc, int fr, int fq) const {
        const int c0 = u.pn * 256 + wc * 32 + 8 * fq;
#pragma unroll
        for (int ai = 0; ai < 2; ++ai)
#pragma unroll
            for (int m = 0; m < 4; ++m) { const size_t row = EPI_ROWS(ai, m);
#pragma unroll
                for (int bj = 0; bj < 2; ++bj) { const int c = c0 + bj * 128;
                    const u32x4 gb = *(const u32x4*)(G + row * 4096 + 2048 + c);
                    float b[8]; b[0] = bf2f_lo(gb.x); b[1] = bf2f_hi(gb.x); b[2] = bf2f_lo(gb.y); b[3] = bf2f_hi(gb.y); b[4] = bf2f_lo(gb.z); b[5] = bf2f_hi(gb.z); b[6] = bf2f_lo(gb.w); b[7] = bf2f_hi(gb.w);
#pragma unroll
                    for (int j = 0; j < 8; ++j) b[j] = fmaxf(b[j], 1e-30f);
                    if (u.br == 0) {
                        const u32x4 ga = *(const u32x4*)(G + row * 4096 + c);
                        float a[8]; a[0] = bf2f_lo(ga.x); a[1] = bf2f_hi(ga.x); a[2] = bf2f_lo(ga.y); a[3] = bf2f_hi(ga.y); a[4] = bf2f_lo(ga.z); a[5] = bf2f_hi(ga.z); a[6] = bf2f_lo(ga.w); a[7] = bf2f_hi(ga.w);
#pragma unroll
                        for (int j = 0; j < 4; ++j) { acc[ai][bj][m][0][j] *= a[j] * __builtin_amdgcn_rcpf(b[j]); acc[ai][bj][m][1][j] *= a[4 + j] * __builtin_amdgcn_rcpf(b[4 + j]); }
                    } else {
                        f32x4 v0, v1;
#pragma unroll
                        for (int j = 0; j < 4; ++j) { v0[j] = acc[ai][bj][m][0][j] * b[j]; v1[j] = acc[ai][bj][m][1][j] * b[4 + j]; }
                        *(u32x4*)(MG + row * 2048 + c) = pack8(v0, v1);
                    } } }
    }
};
struct EpiRes {
    static constexpr bool PERM = true;
    const float* base_p; const float* base_s;
    float* H; bf16_t* HB; float* SS; int write_hb;
    __device__ __forceinline__ bool keep(const Unit&) const { return false; }
    __device__ __forceinline__ void operator()(f32x4 (&acc)[2][2][4][2], const Unit& u, int wr, int wc, int fr, int fq) const {
        const int c0 = u.pn * 256 + wc * 32 + 8 * fq; const float* bb = (u.pm < 32) ? base_p : (base_s - (size_t)MP * 2048);
#pragma unroll
        for (int ai = 0; ai < 2; ++ai)
#pragma unroll
            for (int m = 0; m < 4; ++m) { const size_t row = EPI_ROWS(ai, m); float q = 0.f;
#pragma unroll
                for (int bj = 0; bj < 2; ++bj) { const size_t o = row * 2048 + c0 + bj * 128;
                    const f32x4 h0 = *(const f32x4*)(bb + o) + acc[ai][bj][m][0], h1 = *(const f32x4*)(bb + o + 4) + acc[ai][bj][m][1];
                    *(f32x4*)(H + o) = h0; *(f32x4*)(H + o + 4) = h1;
                    q += ((h0[0] * h0[0] + h0[1] * h0[1]) + (h0[2] * h0[2] + h0[3] * h0[3])) + ((h1[0] * h1[0] + h1[1] * h1[1]) + (h1[2] * h1[2] + h1[3] * h1[3]));
                    if (write_hb) *(u32x4*)(HB + o) = pack8(h0, h1); }
                q += __shfl_xor(q, 16); q += __shfl_xor(q, 32);
                if (fq == 0) SS[row * 32 + u.pn * 4 + wc] = q; }
    }
};
struct EpiGU {
    static constexpr bool PERM = true;
    const float* SS; bf16_t* ACT;
    __device__ __forceinline__ bool keep(const Unit&) const { return false; }
    __device__ __forceinline__ void operator()(f32x4 (&acc)[2][2][4][2], const Unit& u, int wr, int wc, int fr, int fq) const {
        float rs[2][4]; row_rstd(SS, u, wr, fr, fq, rs);
        const int c0 = u.pn * 128 + wc * 32 + 8 * fq;
#pragma unroll
        for (int ai = 0; ai < 2; ++ai)
#pragma unroll
            for (int m = 0; m < 4; ++m) { const size_t row = EPI_ROWS(ai, m); const float sc = rs[ai][m]; f32x4 v0, v1;
#pragma unroll
                for (int j = 0; j < 4; ++j) { const float g0 = acc[ai][0][m][0][j] * sc, g1 = acc[ai][0][m][1][j] * sc;
                    v0[j] = g0 * fsig(g0) * (acc[ai][1][m][0][j] * sc); v1[j] = g1 * fsig(g1) * (acc[ai][1][m][1][j] * sc); }
                *(u32x4*)(ACT + row * 5632 + c0) = pack8(v0, v1); }
    }
};
__device__ __forceinline__ void p0_transpose_item(const float* W, int K, int N, const float* scale, bf16* WT, int drow0, int k0, int n0, LAS float* scr, int lane) {
    float v[32];
#pragma unroll
    for (int i = 0; i < 32; ++i) { const int kk = 2 * i + (lane >> 5); v[i] = W[(size_t)(k0 + kk) * N + n0 + (lane & 31)]; }
    if (scale) {
#pragma unroll
        for (int i = 0; i < 32; ++i) v[i] *= scale[k0 + 2 * i + (lane >> 5)]; }
#pragma unroll
    for (int i = 0; i < 32; ++i) scr[(2 * i + (lane >> 5)) * 33 + (lane & 31)] = v[i];
    LDS_WAIT(); asm volatile("" ::: "memory");
    const int c = lane & 7;
#pragma unroll
    for (int j = 0; j < 4; ++j) { const int n = (lane >> 3) + 8 * j; const LAS float* s = scr + (8 * c) * 33 + n;
        v4u o; o.x = pk2(s[0 * 33], s[1 * 33]); o.y = pk2(s[2 * 33], s[3 * 33]); o.z = pk2(s[4 * 33], s[5 * 33]); o.w = pk2(s[6 * 33], s[7 * 33]);
        *(GAS v4u*)(WT + (size_t)(drow0 + n) * K + k0 + 8 * c) = o; }
    LDS_WAIT(); asm volatile("" ::: "memory");
}
__device__ __forceinline__ void p0_prologue(Frame& F) {
    F.tid = opq(F.tid); F.lane = F.tid & 63;
    LAS float* scr = (LAS float*)(F.lds + F.wave * 16384);
    const int gw = F.vcu * NWAVES + F.wave, NGW = F.G * NWAVES;
    constexpr int I_IN = 32 * 288, I_A = 16 * 64, I_B = 16 * 64, I_O = 32 * 64, I_GU = 32 * 352, I_D = 88 * 64, I_L = I_IN + I_A + I_B + I_O + I_GU + I_D;
    for (int it = gw; it < 2 * I_L; it += NGW) {
        const int l = it / I_L; int r = it % I_L; unsigned char* wl = F.ws + W_WL + (size_t)l * WL_STRIDE;
        if (r < I_IN) { const int kb = r / 288, nb = r % 288; p0_transpose_item(F.win + (size_t)l * DM * NIN, DM, NIN, F.nmix + l * DM, (bf16*)(wl + WL_IN), nb * 32, kb * 64, nb * 32, scr, F.lane); continue; } r -= I_IN;
        if (r < I_A) { const int kb = r / 64, nb = r % 64; p0_transpose_item(F.wa + (size_t)l * 1024 * DM, 1024, DM, nullptr, (bf16*)(wl + WL_A), nb * 32, kb * 64, nb * 32, scr, F.lane); continue; } r -= I_A;
        if (r < I_B) { const int kb = r / 64, nb = r % 64; p0_transpose_item(F.wb + (size_t)l * 1024 * DM, 1024, DM, nullptr, (bf16*)(wl + WL_B), nb * 32, kb * 64, nb * 32, scr, F.lane); continue; } r -= I_B;
        if (r < I_O) { const int kb = r / 64, nb = r % 64; p0_transpose_item(F.wout + (size_t)l * DM * DM, DM, DM, nullptr, (bf16*)(wl + WL_OUT), nb * 32, kb * 64, nb * 32, scr, F.lane); continue; } r -= I_O;
        if (r < I_GU) { const int kb = r / 352, nb = r % 352; const int n0 = nb * 32; const int j0 = n0 < FF ? n0 : n0 - FF;
            const int drow = (j0 >> 7) * 256 + (n0 < FF ? 0 : 128) + (j0 & 127);
            p0_transpose_item(F.wgu + (size_t)l * DM * NGU, DM, NGU, F.nffn + l * DM, (bf16*)(wl + WL_GU), drow, kb * 64, n0, scr, F.lane); continue; } r -= I_GU;
        { const int kb = r / 64, nb = r % 64; p0_transpose_item(F.wd + (size_t)l * FF * DM, FF, DM, nullptr, (bf16*)(wl + WL_D), nb * 32, kb * 64, nb * 32, scr, F.lane); }
    }
    bf16* HB = (bf16*)(F.ws + W_HB); float* SS = (float*)(F.ws + W_SS);
    for (int m = gw; m < M; m += NGW) {
        const float* xr = (m < MP) ? F.xp + (size_t)m * DM : F.xs + (size_t)(m - MP) * DM; float q = 0.f;
#pragma unroll
        for (int j = 0; j < 8; ++j) { const f32x4 v = *(const f32x4*)(xr + j * 256 + F.lane * 4); q += (v[0] * v[0] + v[1] * v[1]) + (v[2] * v[2] + v[3] * v[3]);
            u32x2 w; w.x = cvtpk(v[0], v[1]); w.y = cvtpk(v[2], v[3]); *(u32x2*)(HB + (size_t)m * DM + j * 256 + F.lane * 4) = w; }
        q = wave_sum(q);
        if (F.lane < 32) SS[(size_t)m * 32 + F.lane] = F.lane == 0 ? q : 0.f;
    }
    bf16* WM = (bf16*)(F.ws + W_WM);
    for (int i = (F.vcu * NWAVES + F.wave) * 64 + F.lane; i < 2 * 2 * 8 * 128 * 128; i += NGW * 64) {
        const int s = i & 127, t = (i >> 7) & 127, g = (i >> 14) & 7, kind = (i >> 17) & 1, l = i >> 18;
        const float* w = F.wsp + ((size_t)l * 8 + g) * 16384; float v;
        if (kind == 0) v = ((s >> 6) <= (t >> 6)) ? w[t * 128 + s] : 0.f; else v = ((s >> 6) == (t >> 6)) ? w[(t & 63) * 128 + (s & 63)] : 0.f;
        WM[i] = (bf16)f2bf(v);
    }
}
__device__ __forceinline__ void p_final(Frame& F, float dbg_scale_sample) {
    F.tid = opq(F.tid); F.lane = F.tid & 63;
    const int gw = F.vcu * NWAVES + F.wave, NGW = F.G * NWAVES; const float* SS = (const float*)(F.ws + W_SS);
    for (int m = gw; m < M; m += NGW) {
        float t = F.lane < 32 ? SS[(size_t)m * 32 + F.lane] : 0.f; t = wave_sum(t); float r = __builtin_amdgcn_rsqf(t * (1.0f / 2048.0f) + EPS); if (m >= MP) r *= dbg_scale_sample;
        float* h = F.out + OUT_Y + (size_t)m * DM;
#pragma unroll
        for (int j = 0; j < 8; ++j) { const int c = j * 256 + F.lane * 4; const f32x4 v = *(const f32x4*)(h + c), g = *(const f32x4*)(F.nfin + c); *(f32x4*)(h + c) = v * r * g; }
    }
}
constexpr int A_VOFF = 0, A_KOFF = 32768, A_TILE = 16384;
#define KSWZ(row, colB) ((row) * 256 + ((colB) ^ (((row) & 7) << 4)))
#define SBAR() __builtin_amdgcn_sched_barrier(0)
__device__ __forceinline__ int crow(int r, int hi) { return (r & 3) + 8 * (r >> 2) + 4 * hi; }
__device__ __forceinline__ int v_st(int k, int c) { const int kk = (k & ~0xC) | ((k & 4) << 1) | ((k & 8) >> 1); return ((kk >> 3) * 4 + (c >> 5)) * 512 + ((kk & 7) * 32 + (c & 31)) * 2; }
__device__ __forceinline__ int v_rd_base(int lane) { return ((lane & 3) << 3) | (((lane >> 2) & 3) << 6) | (((lane >> 4) & 1) << 5) | (((lane >> 5) & 1) << 8); }
constexpr int v_rd_off(int d0, int ks, int half) { return d0 * 512 + ks * 4096 + half * 2048; }
template <int OFF> __device__ __forceinline__ s16x4 tr_read(int vb) { s16x4 r; asm volatile("ds_read_b64_tr_b16 %0, %1 offset:%2" : "=&v"(r) : "v"(vb), "i"(OFF) : "memory"); return r; }
template <int D0> __device__ __forceinline__ void pv_one(f32x16& od, int vb, bf16x8 pa0, bf16x8 pa1, bf16x8 pa2, bf16x8 pa3) {
    const s16x4 l0 = tr_read<v_rd_off(D0, 0, 0)>(vb), h0 = tr_read<v_rd_off(D0, 0, 1)>(vb), l1 = tr_read<v_rd_off(D0, 1, 0)>(vb), h1 = tr_read<v_rd_off(D0, 1, 1)>(vb);
    const s16x4 l2 = tr_read<v_rd_off(D0, 2, 0)>(vb), h2 = tr_read<v_rd_off(D0, 2, 1)>(vb), l3 = tr_read<v_rd_off(D0, 3, 0)>(vb), h3 = tr_read<v_rd_off(D0, 3, 1)>(vb);
    asm volatile("s_waitcnt lgkmcnt(0)" ::: "memory"); SBAR();
#define PK(L, H) (bf16x8){L[0], L[1], L[2], L[3], H[0], H[1], H[2], H[3]}
    od = __builtin_amdgcn_mfma_f32_32x32x16_bf16(pa0, PK(l0, h0), od, 0, 0, 0);
    od = __builtin_amdgcn_mfma_f32_32x32x16_bf16(pa1, PK(l1, h1), od, 0, 0, 0);
    od = __builtin_amdgcn_mfma_f32_32x32x16_bf16(pa2, PK(l2, h2), od, 0, 0, 0);
    od = __builtin_amdgcn_mfma_f32_32x32x16_bf16(pa3, PK(l3, h3), od, 0, 0, 0);
#undef PK
}
__device__ __forceinline__ void qkt(f32x16& p0, f32x16& p1, const LAS unsigned char* Ks, const bf16x8 (&qr)[8], int r32, int hi) {
    p0 = f32x16{}; p1 = f32x16{};
#pragma unroll
    for (int d0 = 0; d0 < 8; ++d0) { const int cb = (d0 * 16 + hi * 8) * 2;
        const bf16x8 b0 = *(const LAS bf16x8*)(Ks + KSWZ(r32, cb)); const bf16x8 b1 = *(const LAS bf16x8*)(Ks + KSWZ(32 + r32, cb));
        p0 = __builtin_amdgcn_mfma_f32_32x32x16_bf16(b0, qr[d0], p0, 0, 0, 0); p1 = __builtin_amdgcn_mfma_f32_32x32x16_bf16(b1, qr[d0], p1, 0, 0, 0); }
}
__device__ __forceinline__ void sb_half(f32x16& p, float& R, int hi, bool need_mask, int kpos0, int qpos) {
    f32x16 st;
#pragma unroll
    for (int r = 0; r < 16; ++r) { const float zz = fmaxf(p[r], -120.f); const float e = __builtin_amdgcn_exp2f(-zz); float bt = __builtin_amdgcn_rcpf(1.f + e); float s = e * bt;
        if (need_mask) { const bool valid = (kpos0 + crow(r, hi)) < qpos; s = valid ? s : 1.f; bt = valid ? bt : 0.f; }
        p[r] = bt; st[r] = s; }
    float x1[4], x2[4], x3[4], c[4], f[4];
#pragma unroll
    for (int q = 0; q < 4; ++q) { x3[q] = st[4 * q + 3]; x2[q] = x3[q] * st[4 * q + 2]; x1[q] = x2[q] * st[4 * q + 1]; const float pq = x1[q] * st[4 * q];
        const auto rr = __builtin_amdgcn_permlane32_swap(__float_as_uint(pq), __float_as_uint(pq), false, false);
        const float v0 = __uint_as_float(rr[0]), v1 = __uint_as_float(rr[1]); c[q] = v0 * v1; f[q] = hi ? 1.f : v1; }
    const float S3 = R, S2 = S3 * c[3], S1 = S2 * c[2], S0 = S1 * c[1]; R = S0 * c[0];
    R = R < 7.8886e-31f ? 0.f : R;
    const float T[4] = {S0 * f[0], S1 * f[1], S2 * f[2], S3 * f[3]};
#pragma unroll
    for (int q = 0; q < 4; ++q) { p[4 * q + 3] *= T[q]; p[4 * q + 2] *= T[q] * x3[q]; p[4 * q + 1] *= T[q] * x2[q]; p[4 * q] *= T[q] * x1[q]; }
}
#define PK4(P, BASE, OUT) do { const unsigned a0 = cvtpk(P[BASE + 0], P[BASE + 1]), a1 = cvtpk(P[BASE + 2], P[BASE + 3]);   \
    const unsigned b0 = cvtpk(P[BASE + 4], P[BASE + 5]), b1 = cvtpk(P[BASE + 6], P[BASE + 7]);                              \
    const auto r0 = __builtin_amdgcn_permlane32_swap(a0, b0, false, false); const auto r1 = __builtin_amdgcn_permlane32_swap(a1, b1, false, false); \
    u32x4 w_ = {r0[0], r1[0], r0[1], r1[1]}; OUT = *reinterpret_cast<bf16x8*>(&w_); } while (0)
template <bool SAMPLE>
__device__ __forceinline__ void attn_unit(Frame& F, int l, int b, int h, int qb) {
    const int tid = opq(F.tid), wid = F.wave, lane = tid & 63, r32 = lane & 31, hi = lane >> 5;
    const LAS unsigned char* Kl = F.lds + A_KOFF; LAS unsigned char* Vl = F.lds + A_VOFF;
    const bool active = SAMPLE ? (wid < 2) : true;
    const int nt = SAMPLE ? 33 : 4 * qb + 4;
    const int wrow_lo = SAMPLE ? 2048 + 32 * wid : 256 * qb + 32 * wid;
    const int qpos = wrow_lo + r32;
    const size_t qrow = SAMPLE ? (size_t)(MP + b * 64 + 32 * wid + r32) : (size_t)(b * 2048 + qpos);
    const bf16* Qp = (const bf16*)(F.ws + W_Q) + qrow * 1024 + h * 128 + hi * 8;
    bf16x8 qr[8];
    if (active) {
#pragma unroll
        for (int d0 = 0; d0 < 8; ++d0) qr[d0] = *(const bf16x8*)(Qp + d0 * 16);
    } else {
#pragma unroll
        for (int d0 = 0; d0 < 8; ++d0) qr[d0] = bf16x8{};
    }
    f32x16 o[4] = {}; float R = 1.f;
    const int sr = tid >> 4, sc = (tid & 15) * 8, vst0 = v_st(sr, sc), vst1 = v_st(32 + sr, sc);
    const int vb0 = (int)(unsigned)(uintptr_t)Vl + v_rd_base(lane);
    const bf16* Kb = (const bf16*)(F.ws + W_K); const bf16* Vb = (const bf16*)(F.ws + W_V);
    const float* nk = F.out + OUT_KS + ((size_t)(l * 32 + b) * 64) * 1024 + h * 128; const float* nv = F.out + OUT_VS + ((size_t)(l * 32 + b) * 64) * 1024 + h * 128;
    const float* ckb = F.ck + ((size_t)(l * 32 + b) * 2048) * 1024 + h * 128; const float* cvb = F.cv + ((size_t)(l * 32 + b) * 2048) * 1024 + h * 128;
#define TILE_POS(j) (SAMPLE ? ((j) == 0 ? 2048 : 2048 - 64 * (j)) : 64 * (nt - 1 - (j)))
    f32x8v fk0, fk1, fv0, fv1; bf16x8 bk0, bk1, bv0, bv1;
#define SLOAD(j) do { if constexpr (SAMPLE) { const float* kp = (j) == 0 ? nk : ckb + (size_t)(2048 - 64 * (j)) * 1024; const float* vp = (j) == 0 ? nv : cvb + (size_t)(2048 - 64 * (j)) * 1024; \
        fk0 = *(const f32x8v*)(kp + (size_t)sr * 1024 + sc); fk1 = *(const f32x8v*)(kp + (size_t)(32 + sr) * 1024 + sc); fv0 = *(const f32x8v*)(vp + (size_t)sr * 1024 + sc); fv1 = *(const f32x8v*)(vp + (size_t)(32 + sr) * 1024 + sc); } \
    else { const size_t ro = ((size_t)(b * 2048 + TILE_POS(j) + sr)) * 1024 + h * 128 + sc; bk0 = *(const bf16x8*)(Kb + ro); bk1 = *(const bf16x8*)(Kb + ro + 32 * 1024); bv0 = *(const bf16x8*)(Vb + ro); bv1 = *(const bf16x8*)(Vb + ro + 32 * 1024); } } while (0)
#define TOBF(x) ({ u32x4 w__ = {cvtpk(x[0], x[1]), cvtpk(x[2], x[3]), cvtpk(x[4], x[5]), cvtpk(x[6], x[7])}; *reinterpret_cast<bf16x8*>(&w__); })
#define SWRITE(bufi) do { LAS unsigned char* vd = Vl + (bufi) * A_TILE; LAS unsigned char* kd = (LAS unsigned char*)Kl + (bufi) * A_TILE; const int kc = sc * 2; \
        if constexpr (SAMPLE) { *(LAS bf16x8*)(vd + vst0) = TOBF(fv0); *(LAS bf16x8*)(vd + vst1) = TOBF(fv1); *(LAS bf16x8*)(kd + KSWZ(sr, kc)) = TOBF(fk0); *(LAS bf16x8*)(kd + KSWZ(32 + sr, kc)) = TOBF(fk1); } \
        else { *(LAS bf16x8*)(vd + vst0) = bv0; *(LAS bf16x8*)(vd + vst1) = bv1; *(LAS bf16x8*)(kd + KSWZ(sr, kc)) = bk0; *(LAS bf16x8*)(kd + KSWZ(32 + sr, kc)) = bk1; } } while (0)
    volatile LAS unsigned* dflag = F.MISC + 16;
    SLOAD(0); asm volatile("s_waitcnt vmcnt(0)" ::: "memory"); SWRITE(0); __syncthreads();
    for (int j = 0; j < nt; ++j) {
        if (j > 0) {
            unsigned alld = 1u;
#pragma unroll
            for (int w = 0; w < 8; ++w) alld &= dflag[((j - 1) & 1) * 8 + w];
            if (alld) break;
        }
        if (j + 1 < nt) SLOAD(j + 1);
        const int kpos0 = TILE_POS(j);
        if (active && kpos0 < wrow_lo + 31) {
            f32x16 p0, p1; bf16x8 pa0, pa1, pa2, pa3;
            qkt(p0, p1, Kl + (j & 1) * A_TILE, qr, r32, hi);
            const bool need_mask = !(kpos0 + 63 < wrow_lo);
            sb_half(p1, R, hi, need_mask, kpos0 + 32, qpos);
            sb_half(p0, R, hi, need_mask, kpos0, qpos);
            PK4(p0, 0, pa0); PK4(p0, 8, pa1); PK4(p1, 0, pa2); PK4(p1, 8, pa3);
            const int vb = vb0 + (j & 1) * A_TILE;
            pv_one<0>(o[0], vb, pa0, pa1, pa2, pa3); pv_one<1>(o[1], vb, pa0, pa1, pa2, pa3); pv_one<2>(o[2], vb, pa0, pa1, pa2, pa3); pv_one<3>(o[3], vb, pa0, pa1, pa2, pa3);
        }
        { const bool wdone = !active || __all(R == 0.f); if (lane == 0) dflag[(j & 1) * 8 + wid] = wdone ? 1u : 0u; }
        if (j + 1 < nt) { asm volatile("s_waitcnt vmcnt(0)" ::: "memory"); SWRITE((j + 1) & 1); }
        __syncthreads();
    }
    if (active) {
        bf16* Ow = (bf16*)(F.ws + W_ATT) + (SAMPLE ? (size_t)(MP + b * 64 + 32 * wid) : (size_t)(b * 2048 + wrow_lo)) * 1024 + h * 128 + r32;
#pragma unroll
        for (int r = 0; r < 16; ++r) { const int orow = crow(r, hi);
#pragma unroll
            for (int d0 = 0; d0 < 4; ++d0) Ow[(size_t)orow * 1024 + d0 * 32] = (bf16)f2bf(o[d0][r]); }
    }
#undef SLOAD
#undef SWRITE
#undef TILE_POS
}
__device__ __forceinline__ void sgu_unit(Frame& F, int l, int tile) {
    const int tid = opq(F.tid), wid = F.wave, lane = tid & 63, r32 = lane & 31, hi = lane >> 5;
    const int row0 = tile * 128; const bool samp = row0 >= MP;
    const float* VS = (const float*)(F.ws + W_VS); const bf16* U = (const bf16*)(F.ws + W_U); bf16* BB = (bf16*)(F.ws + W_BB);
    const bf16* WM = (const bf16*)(F.ws + W_WM) + ((size_t)(l * 2 + (samp ? 1 : 0)) * 8) * 16384;
    const float* gn = F.sgun + l * 1024; const float* bs = F.bsp + l * 1024;
    LAS float* rst = (LAS float*)(F.lds + 65536);
    for (int i = 0; i < 16; ++i) { const int r = wid * 16 + i; const float* p = VS + (size_t)(row0 + r) * 1024 + lane * 4; float q = 0.f;
#pragma unroll
        for (int j = 0; j < 4; ++j) { const f32x4 v = *(const f32x4*)(p + j * 256); q += (v[0] * v[0] + v[1] * v[1]) + (v[2] * v[2] + v[3] * v[3]); }
        q = wave_sum(q); if (lane == 0) rst[r] = __builtin_amdgcn_rsqf(q * (1.0f / 1024.0f) + EPS); }
    __syncthreads();
    const int sr = tid >> 4, sc = (tid & 15) * 8;
    const int rg = wid & 3, ch = wid >> 2;
    const int vb0 = (int)(unsigned)(uintptr_t)F.lds + v_rd_base(lane);
    float* sgo = F.out + OUT_SG + ((size_t)l * MS) * 1024;
    for (int g = 0; g < 8; ++g) {
        const f32x8v gv = *(const f32x8v*)(gn + g * 128 + sc);
#pragma unroll
        for (int i = 0; i < 4; ++i) { const int s = sr + 32 * i; const size_t grow = (size_t)(row0 + s);
            f32x8v v = *(const f32x8v*)(VS + grow * 1024 + g * 128 + sc); const float rr = rst[s];
#pragma unroll
            for (int j = 0; j < 8; ++j) v[j] = v[j] * rr * gv[j];
            if (samp) *(f32x8v*)(sgo + (grow - MP) * 1024 + g * 128 + sc) = v;
            u32x4 w = {cvtpk(v[0], v[1]), cvtpk(v[2], v[3]), cvtpk(v[4], v[5]), cvtpk(v[6], v[7])};
            *(LAS u32x4*)(F.lds + (s >> 6) * A_TILE + v_st(s & 63, sc)) = w; }
        __syncthreads();
        f32x16 o2[2] = {};
        const bf16* wrow = WM + ((size_t)g * 128 + rg * 32 + r32) * 128 + hi * 8;
#pragma unroll
        for (int kt = 0; kt < 2; ++kt) {
            const bf16x8 pa0 = *(const bf16x8*)(wrow + kt * 64), pa1 = *(const bf16x8*)(wrow + kt * 64 + 16), pa2 = *(const bf16x8*)(wrow + kt * 64 + 32), pa3 = *(const bf16x8*)(wrow + kt * 64 + 48);
            const int vb = vb0 + kt * A_TILE;
            if (ch == 0) { pv_one<0>(o2[0], vb, pa0, pa1, pa2, pa3); pv_one<1>(o2[1], vb, pa0, pa1, pa2, pa3); }
            else { pv_one<2>(o2[0], vb, pa0, pa1, pa2, pa3); pv_one<3>(o2[1], vb, pa0, pa1, pa2, pa3); }
        }
#pragma unroll
        for (int r = 0; r < 16; ++r) { const int t = rg * 32 + crow(r, hi); const float bias = bs[g * 128 + (samp ? (t & 63) : t)];
#pragma unroll
            for (int i = 0; i < 2; ++i) { const size_t off = (size_t)(row0 + t) * 1024 + g * 128 + (2 * ch + i) * 32 + r32;
                const float uu = __uint_as_float(((unsigned)U[off]) << 16); BB[off] = (bf16)f2bf(uu * (o2[i][r] + bias)); } }
        __syncthreads();
    }
}
constexpr int N_PHASES = 14;
struct Args { const float* in[17]; float* out; unsigned char* ws; int ph_lo, ph_hi, li, pad; };
__global__ void __launch_bounds__(NWAVES * 64, 2) mk_fwd(Args args) {
    extern __shared__ __attribute__((aligned(16))) unsigned char lds_raw[];
    Frame F;
    F.lds = (LAS unsigned char*)lds_raw; F.MISC = (volatile LAS unsigned*)(F.lds + MISC_OFF);
    F.tid = threadIdx.x; F.lane = F.tid & 63; F.wave = __builtin_amdgcn_readfirstlane(F.tid >> 6);
    F.G = gridDim.x; { const int bx = blockIdx.x; F.vcu = (F.G % 8 == 0) ? (bx % 8) * (F.G / 8) + bx / 8 : bx; }
    F.xp = args.in[0]; F.xs = args.in[1]; F.ck = args.in[2]; F.cv = args.in[3]; F.nmix = args.in[4]; F.win = args.in[5]; F.bgate = args.in[6]; F.sgun = args.in[7]; F.wsp = args.in[8]; F.bsp = args.in[9];
    F.wa = args.in[10]; F.wb = args.in[11]; F.wout = args.in[12]; F.nffn = args.in[13]; F.wgu = args.in[14]; F.wd = args.in[15]; F.nfin = args.in[16];
    F.out = args.out; F.ws = args.ws;
    for (int u = F.tid; u < (LDS_BYTES - LDSCTL_OFF) / 4; u += NWAVES * 64) ((LAS unsigned*)(F.lds + LDSCTL_OFF))[u] = 0u;
    __syncthreads();
    gu32* ctl = (gu32*)(F.ws + W_CTL);
    XcdBarrier bar = xcd_barrier_post((unsigned*)(ctl + CW_BAR) + args.li * XCD_BAR_WORDS, F.MISC + 8);
    const int lo = args.ph_lo, hi = args.ph_hi;
#define IN(k) (lo <= (k) && (k) < hi)
#ifdef TIMING
#define STAMP(k) do { if (blockIdx.x == 0 && F.tid == 0) __hip_atomic_store((gu64*)(ctl + 2048) + (k), (unsigned long long)wall_clock64(), RLX_AGENT); } while (0)
#else
#define STAMP(k) do { } while (0)
#endif
#define SEAM(k) do { if (IN(k) && IN((k) + 1)) xcd_barrier(bar); STAMP((k) + 1); } while (0)
    unsigned char* ws = F.ws;
    bf16_t* HB = (bf16_t*)(ws + W_HB); float* SS = (float*)(ws + W_SS); float* H = F.out + OUT_Y;
    STAMP(0);
    if (IN(0)) p0_prologue(F);
    SEAM(0);
    for (int l = 0; l < 2; ++l) {
        const int pb = 1 + 6 * l; unsigned char* wl = ws + W_WL + (size_t)l * WL_STRIDE;
        if (IN(pb)) {
            SchedSimple S{40, 36, F.G, (int)blockIdx.x, 2048, 2048, (const char*)HB, (const char*)(wl + WL_IN)};
            EpiIn E{SS, (bf16_t*)(ws + W_Q), (bf16_t*)(ws + W_K), (bf16_t*)(ws + W_V), (bf16_t*)(ws + W_U), (bf16_t*)(ws + W_G), (float*)(ws + W_VS), F.bgate + l * 4096,
                    F.out + OUT_KP + (size_t)l * MP * 1024, F.out + OUT_VP + (size_t)l * MP * 1024, F.out + OUT_KS + (size_t)l * MS * 1024, F.out + OUT_VS + (size_t)l * MS * 1024};
            pg8::gemm_phase<EpiIn, SchedSimple>(F.lds, S, E);
        }
        SEAM(pb);
        if (IN(pb + 1)) {
            const int c = F.vcu;
            for (int pu = c; pu < 256; pu += F.G) { const int qb = 7 - (pu >> 5), bh = pu & 31; attn_unit<false>(F, l, bh >> 3, bh & 7, qb); }
            for (int su = c; su < 256; su += F.G) attn_unit<true>(F, l, su >> 3, su & 7, 0);
            for (int tu = F.G - 1 - c; tu < 80; tu += F.G) sgu_unit(F, l, tu);
        }
        SEAM(pb + 1);
        if (IN(pb + 2)) {
            SchedBranch S{40, 8, F.G, (int)blockIdx.x, 1024, 1024, (const char*)(ws + W_ATT), (const char*)(wl + WL_A), (const char*)(ws + W_BB), (const char*)(wl + WL_B)};
            EpiMerge E{(const bf16_t*)(ws + W_G), (bf16_t*)(ws + W_MG)};
            pg8::gemm_phase<EpiMerge, SchedBranch>(F.lds, S, E);
        }
        SEAM(pb + 2);
        if (IN(pb + 3)) {
            SchedSimple S{40, 8, F.G, (int)blockIdx.x, 2048, 2048, (const char*)(ws + W_MG), (const char*)(wl + WL_OUT)};
            EpiRes E{l == 0 ? F.xp : (const float*)H, l == 0 ? F.xs : (const float*)(H + (size_t)MP * 2048), H, HB, SS, 1};
            pg8::gemm_phase<EpiRes, SchedSimple>(F.lds, S, E);
        }
        SEAM(pb + 3);
        if (IN(pb + 4)) {
            SchedSimple S{40, 44, F.G, (int)blockIdx.x, 2048, 2048, (const char*)HB, (const char*)(wl + WL_GU)};
            EpiGU E{SS, (bf16_t*)(ws + W_ACT)};
            pg8::gemm_phase<EpiGU, SchedSimple>(F.lds, S, E);
        }
        SEAM(pb + 4);
        if (IN(pb + 5)) {
            SchedSimple S{40, 8, F.G, (int)blockIdx.x, 5632, 5632, (const char*)(ws + W_ACT), (const char*)(wl + WL_D)};
            EpiRes E{(const float*)H, (const float*)(H + (size_t)MP * 2048), H, HB, SS, l == 0 ? 1 : 0};
            pg8::gemm_phase<EpiRes, SchedSimple>(F.lds, S, E);
        }
        SEAM(pb + 5);
    }
#ifdef TIMING
    if (IN(13)) { const unsigned long long* st = (const unsigned long long*)(ctl + 2048);
        const float t1 = (float)(__hip_atomic_load((gu64*)st + TIM_A1, RLX_AGENT) - __hip_atomic_load((gu64*)st + TIM_A0, RLX_AGENT)) * 0.01f, t2 = (float)(__hip_atomic_load((gu64*)st + TIM_B1, RLX_AGENT) - __hip_atomic_load((gu64*)st + TIM_B0, RLX_AGENT)) * 0.01f;
        p_final(F, 1.f + t1 * (1.f / 3000.f));
        if (blockIdx.x == 0 && F.tid == 0) F.out[OUT_KS] += t2 * 0.1f; }
#else
    if (IN(13)) p_final(F, 1.f);
#endif
#undef IN
#undef SEAM
}
static int g_grid = 0;
static inline bool fast_setup() {
    if (g_grid == 0) {
        int dev = 0, cus = 0;
        if (hipGetDevice(&dev) != hipSuccess || hipDeviceGetAttribute(&cus, hipDeviceAttributeMultiprocessorCount, dev) != hipSuccess) { g_grid = -1; return false; }
        if (hipFuncSetAttribute((const void*)mk_fwd, hipFuncAttributeMaxDynamicSharedMemorySize, LDS_BYTES) != hipSuccess) { fprintf(stderr, "hipFuncSetAttribute failed\n"); g_grid = -1; return false; }
        int per_cu = 0; (void)hipOccupancyMaxActiveBlocksPerMultiprocessor(&per_cu, (const void*)mk_fwd, NWAVES * 64, LDS_BYTES); (void)hipGetLastError();
        if (per_cu < 1) fprintf(stderr, "note: occupancy query reports %d\n", per_cu);
        g_grid = cus;
    }
    return g_grid > 0;
}
static inline void fast_launch(hipStream_t stream, void* const* d_in, float* out, unsigned char* wsbase, int lo, int hi, int li) {
    Args a{}; for (int i = 0; i < 17; ++i) a.in[i] = (const float*)d_in[i];
    a.out = out; a.ws = wsbase; a.ph_lo = lo; a.ph_hi = hi; a.li = li; a.pad = 0;
    hipLaunchKernelGGL(mk_fwd, dim3(g_grid), dim3(NWAVES * 64), LDS_BYTES, stream, a);
}
}
extern "C" void kernel_launch(void* const* d_in, const int* in_sizes, int n_in, void* d_out, int out_size, void* d_ws, size_t ws_size, hipStream_t stream) {
    if (!fk::fast_setup()) return;
    if (n_in != 17 || out_size != (int)fk::OUT_N || ws_size < fk::W_END) { fprintf(stderr, "kernel_launch: unexpected shapes (n_in %d out %d ws %zu)\n", n_in, out_size, ws_size); return; }
    (void)hipMemsetAsync((char*)d_ws + fk::W_CTL, 0, fk::CTL_ZERO_BYTES, stream);
#if defined(PROBE_DUP)
    fk::fast_launch(stream, d_in, (float*)d_out, (unsigned char*)d_ws, 0, PROBE_DUP + 1, 0);
    fk::fast_launch(stream, d_in, (float*)d_out, (unsigned char*)d_ws, PROBE_DUP, fk::N_PHASES, 1);
#elif MK_N_LAUNCHES == 1
    fk::fast_launch(stream, d_in, (float*)d_out, (unsigned char*)d_ws, 0, fk::N_PHASES, 0);
#else
    for (int p = 0; p < fk::N_PHASES; ++p) fk::fast_launch(stream, d_in, (float*)d_out, (unsigned char*)d_ws, p, p + 1, p);
#endif
}
```

```cpp
#include <hip/hip_runtime.h>
#include <cstdio>
#include <cstdint>
#ifndef MK_N_LAUNCHES
#define MK_N_LAUNCHES 1
#endif
namespace pg8 {
#define PG8_LAS __attribute__((address_space(3)))
typedef unsigned short bf16_t;
typedef short bf16x8 __attribute__((ext_vector_type(8)));
typedef float f32x4 __attribute__((ext_vector_type(4)));
typedef unsigned u32x4 __attribute__((ext_vector_type(4)));
constexpr int BM = 256, BK = 64, HALF = 128, HTB = HALF * BK * 2  , STAGE_BYTES = 8 * HTB, NXCD = 8, WGM = 8;

__host__ __device__ __forceinline__ int lds_byte(int r, int c) { const int st = (r >> 4) * 2 + (c >> 5), rr = r & 15, cc = c & 31, ob = rr * 64 + cc * 2; return st * 1024 + (ob ^ (((ob >> 9) & 1) << 5)); }
__host__ __device__ __forceinline__ void stage_rc(int b, int& R, int& C) { const int st = b / 1024, sb = b % 1024, swz = sb ^ (((sb >> 9) & 1) << 5); R = (st >> 1) * 16 + swz / 64; C = (st & 1) * 32 + (swz % 64) / 2; }
__host__ __device__ __forceinline__ int perm32(int rho) { const int n = rho >> 4, i = rho & 15; return 8 * (i >> 2) + 4 * n + (i & 3); }

struct Unit { int pm, pn, br; };
template <class Epi, class Sched, bool ALIGN_EPI = true, bool SP2 = true>
__device__ __forceinline__ void gemm_phase(PG8_LAS unsigned char* lds, const Sched& S, const Epi& E) {
    int tid_ = threadIdx.x; asm volatile("" : "+v"(tid_));
    const int tid = tid_, wid = __builtin_amdgcn_readfirstlane(tid >> 6), lane = tid & 63, wr = wid >> 2, wc = wid & 3, fr = lane & 15, fq = lane >> 4;
    const int K = S.K, nt = S.KT / BK;
    unsigned voffA[2], voffB[2];
#pragma unroll
    for (int i = 0; i < 2; ++i) { int R, C; stage_rc(tid * 16 + i * 8192, R, C); const int Rb = Epi::PERM ? ((R & ~31) + perm32(R & 31)) : R;
        voffA[i] = (unsigned)(R * K + C) * 2u; voffB[i] = (unsigned)(Rb * K + C) * 2u; }
    const size_t kstep = (size_t)(BK * 2);
    const size_t hstep = (size_t)HALF * K * 2;
        const unsigned ldsw = (unsigned)wid * 1024u;
    const int aoff = lds_byte(wr * 64 + fr, fq * 8), boff = lds_byte(wc * 32 + fr, fq * 8);
#define PG8_SA(b, h) (((b) * 2 + (h)) * HTB)
#define PG8_SB(b, h) ((4 + (b) * 2 + (h)) * HTB)
#define PG8_STAGE(bufoff, gbase, voff) do { _Pragma("unroll") for (int _i = 0; _i < 2; ++_i) \
        __builtin_amdgcn_global_load_lds((const unsigned*)((const char*)(gbase) + (voff)[_i]), (PG8_LAS unsigned*)(lds + (bufoff) + ldsw + _i * 8192), 16, 0, 0); } while (0)
#define PG8_LDA(dst, b, h) do { _Pragma("unroll") for (int m = 0; m < 4; ++m) _Pragma("unroll") for (int k = 0; k < 2; ++k) dst[m][k] = *(const PG8_LAS bf16x8*)(lds + PG8_SA(b, h) + aoff + m * 2048 + k * 1024); } while (0)
#define PG8_LDB(dst, b, h) do { _Pragma("unroll") for (int n = 0; n < 2; ++n) _Pragma("unroll") for (int k = 0; k < 2; ++k) dst[n][k] = *(const PG8_LAS bf16x8*)(lds + PG8_SB(b, h) + boff + n * 2048 + k * 1024); } while (0)
#define PG8_MMA(ai, bj, At, Bt) do { __builtin_amdgcn_s_setprio(1); _Pragma("unroll") for (int m = 0; m < 4; ++m) _Pragma("unroll") for (int n = 0; n < 2; ++n) _Pragma("unroll") for (int k = 0; k < 2; ++k) \
        acc[ai][bj][m][n] = __builtin_amdgcn_mfma_f32_16x16x32_bf16(Bt[n][k], At[m][k], acc[ai][bj][m][n], 0, 0, 0); __builtin_amdgcn_s_setprio(0); } while (0)
#define PG8_WAIT_V(n) asm volatile("s_waitcnt vmcnt(" #n ")" ::: "memory")
#define PG8_WAIT_L(n) asm volatile("s_waitcnt lgkmcnt(" #n ")" ::: "memory")
#define PG8_BAR __builtin_amdgcn_s_barrier()
#define PG8_SCHED __builtin_amdgcn_sched_barrier(0)
    Unit cur, nxt; int ui = 0;
    if (!S.next(0, cur)) return;
    f32x4 acc[2][2][4][2];
#pragma unroll
    for (int a = 0; a < 2; ++a)
#pragma unroll
        for (int b = 0; b < 2; ++b)
#pragma unroll
            for (int m = 0; m < 4; ++m)
#pragma unroll
                for (int n = 0; n < 2; ++n) acc[a][b][m][n] = (f32x4){0.f, 0.f, 0.f, 0.f};
    bf16x8 At[4][2], B0[2][2], B1[2][2];
    const char* cA = S.a_base(cur); const char* cB = S.b_base(cur);
    if constexpr (SP2) {
        PG8_STAGE(PG8_SB(0, 0), cB, voffB); PG8_STAGE(PG8_SB(0, 1), cB + hstep, voffB); PG8_STAGE(PG8_SA(0, 0), cA, voffA); PG8_STAGE(PG8_SA(0, 1), cA + hstep, voffA);
        if (wr == 1) PG8_BAR;
        PG8_WAIT_V(2); PG8_BAR;
        PG8_STAGE(PG8_SB(1, 0), cB + kstep, voffB); PG8_STAGE(PG8_SA(1, 0), cA + kstep, voffA); PG8_STAGE(PG8_SB(1, 1), cB + hstep + kstep, voffB);
        PG8_WAIT_V(6); PG8_BAR;
    } else {
        PG8_STAGE(PG8_SB(0, 0), cB, voffB); PG8_STAGE(PG8_SA(0, 0), cA, voffA); PG8_STAGE(PG8_SB(0, 1), cB + hstep, voffB); PG8_STAGE(PG8_SA(0, 1), cA + hstep, voffA);
        if (wr == 1) PG8_BAR;
        PG8_WAIT_V(4); PG8_BAR;
        PG8_STAGE(PG8_SB(1, 0), cB + kstep, voffB); PG8_STAGE(PG8_SA(1, 0), cA + kstep, voffA); PG8_STAGE(PG8_SB(1, 1), cB + hstep + kstep, voffB);
        PG8_WAIT_V(6); PG8_BAR;
    }
    for (;;) {
        const bool has_next = S.next(ui + 1, nxt);
        const char* nA = has_next ? S.a_base(nxt) : cA; const char* nB = has_next ? S.b_base(nxt) : cB;
        for (int t = 0; t < nt; t += 2) {
            const bool last = (t == nt - 2);
            const char* a1 = cA + (size_t)(t + 1) * kstep;
            const char* a2 = last ? nA : cA + (size_t)(t + 2) * kstep; const char* b2 = last ? nB : cB + (size_t)(t + 2) * kstep;
            const char* a3 = a2 + kstep; const char* b3 = b2 + kstep;
            if constexpr (SP2) {
            PG8_LDB(B0, 0, 0); PG8_LDB(B1, 0, 1); PG8_SCHED; PG8_LDA(At, 0, 0); PG8_STAGE(PG8_SA(1, 1), a1 + hstep, voffA);
            PG8_WAIT_V(8); PG8_WAIT_L(0); PG8_BAR; PG8_MMA(0, 0, At, B0); PG8_MMA(0, 1, At, B1); PG8_BAR; PG8_SCHED;
            PG8_LDA(At, 0, 1); PG8_STAGE(PG8_SB(0, 0), b2, voffB); PG8_STAGE(PG8_SB(0, 1), b2 + hstep, voffB); PG8_STAGE(PG8_SA(0, 0), a2, voffA);
            PG8_WAIT_V(8); PG8_WAIT_L(0); PG8_BAR; PG8_MMA(1, 0, At, B0); PG8_MMA(1, 1, At, B1); PG8_BAR; PG8_SCHED;
            PG8_LDB(B0, 1, 0); PG8_LDB(B1, 1, 1); PG8_SCHED; PG8_LDA(At, 1, 0); PG8_STAGE(PG8_SA(0, 1), a2 + hstep, voffA);
            PG8_WAIT_V(8); PG8_WAIT_L(0); PG8_BAR; PG8_MMA(0, 0, At, B0); PG8_MMA(0, 1, At, B1); PG8_BAR; PG8_SCHED;
            PG8_LDA(At, 1, 1); PG8_STAGE(PG8_SB(1, 0), b3, voffB); PG8_STAGE(PG8_SB(1, 1), b3 + hstep, voffB); PG8_STAGE(PG8_SA(1, 0), a3, voffA);
            PG8_WAIT_V(8); PG8_WAIT_L(0); PG8_BAR; PG8_MMA(1, 0, At, B0); PG8_MMA(1, 1, At, B1); PG8_BAR; PG8_SCHED;
            } else {
            PG8_LDB(B0, 0, 0); PG8_SCHED; PG8_LDA(At, 0, 0); PG8_STAGE(PG8_SA(1, 1), a1 + hstep, voffA);
            PG8_WAIT_L(8); PG8_BAR; PG8_WAIT_L(0); PG8_MMA(0, 0, At, B0); PG8_BAR; PG8_SCHED;
            PG8_LDB(B1, 0, 1); PG8_STAGE(PG8_SB(0, 0), b2, voffB);
            PG8_BAR; PG8_WAIT_L(0); PG8_MMA(0, 1, At, B1); PG8_BAR;
            PG8_LDA(At, 0, 1); PG8_STAGE(PG8_SA(0, 0), a2, voffA);
            PG8_BAR; PG8_WAIT_L(0); PG8_MMA(1, 0, At, B0); PG8_BAR; PG8_SCHED;
            PG8_STAGE(PG8_SB(0, 1), b2 + hstep, voffB);
            PG8_WAIT_V(6); PG8_BAR; PG8_MMA(1, 1, At, B1); PG8_BAR;
            PG8_LDB(B0, 1, 0); PG8_SCHED; PG8_LDA(At, 1, 0); PG8_STAGE(PG8_SA(0, 1), a2 + hstep, voffA);
            PG8_WAIT_L(8); PG8_BAR; PG8_WAIT_L(0); PG8_MMA(0, 0, At, B0); PG8_BAR; PG8_SCHED;
            PG8_LDB(B1, 1, 1); PG8_STAGE(PG8_SB(1, 0), b3, voffB);
            PG8_BAR; PG8_WAIT_L(0); PG8_MMA(0, 1, At, B1); PG8_BAR;
            PG8_LDA(At, 1, 1); PG8_STAGE(PG8_SA(1, 0), a3, voffA);
            PG8_BAR; PG8_WAIT_L(0); PG8_MMA(1, 0, At, B0); PG8_BAR; PG8_SCHED;
            PG8_STAGE(PG8_SB(1, 1), b3 + hstep, voffB);
            PG8_WAIT_V(6); PG8_BAR; PG8_MMA(1, 1, At, B1); PG8_BAR;
            }
        }
        if constexpr (ALIGN_EPI) { if (wr == 0) PG8_BAR; }
        E(acc, cur, wr, wc, fr, fq);
        if (!has_next) break;
        if (!E.keep(cur)) {
#pragma unroll
        for (int a = 0; a < 2; ++a)
#pragma unroll
            for (int b = 0; b < 2; ++b)
#pragma unroll
                for (int m = 0; m < 4; ++m)
#pragma unroll
                    for (int n = 0; n < 2; ++n) acc[a][b][m][n] = (f32x4){0.f, 0.f, 0.f, 0.f};
        }
        cur = nxt; cA = nA; cB = nB; ++ui;
        if constexpr (ALIGN_EPI) { if (wr == 1) PG8_BAR; }
    }
    PG8_WAIT_V(0);
    if constexpr (!ALIGN_EPI) { if (wr == 0) PG8_BAR; }
    PG8_BAR;
#undef PG8_SA
#undef PG8_SB
#undef PG8_STAGE
#undef PG8_LDA
#undef PG8_LDB
#undef PG8_MMA
#undef PG8_WAIT_V
#undef PG8_WAIT_L
#undef PG8_BAR
#undef PG8_SCHED
}
}
namespace fk {
using pg8::Unit; using pg8::bf16_t;
typedef float f32x16 __attribute__((ext_vector_type(16)));
typedef float f32x8v __attribute__((ext_vector_type(8)));
typedef short s16x4 __attribute__((ext_vector_type(4)));
typedef unsigned u32x4 __attribute__((ext_vector_type(4)));
typedef unsigned u32x2 __attribute__((ext_vector_type(2)));
constexpr int NWAVES = 8;
constexpr int M = 10240, MP = 8192, MS = 2048, DM = 2048, NIN = 9216, FF = 5632, NGU = 11264, SBW = 1024;
constexpr float EPS = 1e-6f;
constexpr float QSCALE = 1.4426950408889634f * 0.08838834764831845f;
constexpr size_t OUT_Y = 0, OUT_KP = 20971520, OUT_VP = 37748736, OUT_KS = 54525952, OUT_VS = 58720256, OUT_SG = 62914560, OUT_N = 67108864;
constexpr size_t MiB = 1u << 20;
constexpr size_t W_CTL = 0, CTL_ZERO_BYTES = 1 * MiB;
constexpr size_t W_WL = 1 * MiB, WL_STRIDE = 118 * MiB;
constexpr size_t WL_IN = 0, WL_A = 36 * MiB, WL_B = 40 * MiB, WL_OUT = 44 * MiB, WL_GU = 52 * MiB, WL_D = 96 * MiB;
constexpr size_t W_WM = 237 * MiB;
constexpr size_t W_HB = 238 * MiB, W_SS = 278 * MiB, W_Q = 280 * MiB, W_K = 300 * MiB, W_V = 320 * MiB, W_U = 340 * MiB, W_VS = 360 * MiB, W_G = 400 * MiB,
                 W_ATT = 480 * MiB, W_BB = 500 * MiB, W_MG = 520 * MiB, W_ACT = 560 * MiB, W_END = 670 * MiB;
constexpr size_t W_SSV = W_SS + 1280 * 1024;
constexpr int CW_TMO = 0, CW_BAR = 4096;
constexpr int RING_BYTES = 131072, LDSCTL_OFF = RING_BYTES, MISC_OFF = LDSCTL_OFF + 320, LDS_BYTES = 147456;

#define GAS __attribute__((address_space(1)))
#define LAS __attribute__((address_space(3)))
typedef unsigned short bf16;
typedef unsigned v4u __attribute__((ext_vector_type(4)));
typedef float f32x4 __attribute__((ext_vector_type(4)));
typedef short bf16x8 __attribute__((ext_vector_type(8)));
typedef GAS unsigned gu32;
typedef GAS unsigned long long gu64;
#define RLX_AGENT __ATOMIC_RELAXED, __HIP_MEMORY_SCOPE_AGENT
#define LDS_WAIT() asm volatile("s_waitcnt lgkmcnt(0)" ::: "memory")
#define VM_WAIT() asm volatile("s_waitcnt vmcnt(0)" ::: "memory")
__device__ __forceinline__ unsigned long long rt() { return __builtin_amdgcn_s_memrealtime(); }
__device__ __forceinline__ unsigned f2bf(float f) { unsigned u = __builtin_bit_cast(unsigned, f); return (u + 0x7fffu + ((u >> 16) & 1u)) >> 16; }
__device__ __forceinline__ unsigned pk2(float lo, float hi) { return f2bf(lo) | (f2bf(hi) << 16); }
#define XB_TMO      128
#define XB_XCNT(j)  (256  + 64 * (j))
#define XB_XSUB(j)  (1280 + 64 * (j))
#define XB_XGEN(j)  (2304 + 64 * (j))
#define XB_TOP      3328
#define XB_TOPGEN   3392
#define XCD_BAR_WORDS 3456
#define XB_SPIN_CAP (1u << 18)

__device__ __forceinline__ unsigned xb_ld(unsigned* p)              { return __hip_atomic_load(p, __ATOMIC_RELAXED, __HIP_MEMORY_SCOPE_AGENT); }
__device__ __forceinline__ unsigned xb_add(unsigned* p, unsigned v) { return __hip_atomic_fetch_add(p, v, __ATOMIC_RELAXED, __HIP_MEMORY_SCOPE_AGENT); }
__device__ __forceinline__ unsigned xb_xcc_id() { return (unsigned)__builtin_amdgcn_s_getreg((3 << 11) | 20) & 0xFu; }
#define XB_SPIN(cond, bar) do { unsigned _sp = 0; while (cond) { __builtin_amdgcn_s_sleep(1); \
    if ((++_sp & 255u) == 0u) { if (xb_ld(&(bar)[XB_TMO])) break; if (_sp > XB_SPIN_CAP) { atomicAdd(&(bar)[XB_TMO], 1u); break; } } } } while (0)

struct XcdBarrier {
    unsigned* bar; unsigned x;
    volatile LAS unsigned* st;
};

__device__ __forceinline__ XcdBarrier xcd_barrier_post(unsigned* bar, volatile LAS unsigned* st) {
    XcdBarrier b; b.bar = bar; b.x = xb_xcc_id(); b.st = st;
    if (threadIdx.x == 0) (void)xb_add(&bar[XB_XCNT(b.x)], 1u);
    return b;
}
__device__ __forceinline__ void xcd_barrier_complete(unsigned* bar, unsigned x, unsigned& nloc, unsigned& nx) {
    const unsigned G = gridDim.x * gridDim.y * gridDim.z;
    unsigned sum, cnt, mine, sp = 0u;
    for (;;) {
        sum = 0u; cnt = 0u; mine = 0u;
#pragma unroll
        for (unsigned j = 0; j < 16; ++j) { const unsigned c = xb_ld(&bar[XB_XCNT(j)]); sum += c; cnt += (c > 0u) ? 1u : 0u; mine = (j == x) ? c : mine; }
        if (sum == G) break;
        __builtin_amdgcn_s_sleep(1);
        if ((++sp & 255u) == 0u) { if (xb_ld(&bar[XB_TMO])) break; if (sp > XB_SPIN_CAP) { atomicAdd(&bar[XB_TMO], 1u); break; } }
    }
    nloc = mine > 0u ? mine : 1u; nx = cnt > 0u ? cnt : 1u;
}

__device__ __forceinline__ void xcd_barrier(const XcdBarrier& b) {
    asm volatile("s_waitcnt vmcnt(0)" ::: "memory");
    __syncthreads();
    if (threadIdx.x == 0) {
        unsigned* bar = b.bar;
        __builtin_amdgcn_s_waitcnt(0);
        unsigned nloc = b.st[0], nx = b.st[1];
        if (nloc == 0u) { xcd_barrier_complete(bar, b.x, nloc, nx); b.st[0] = nloc; b.st[1] = nx; }
        const unsigned old = xb_add(&bar[XB_XSUB(b.x)], 1u);
        const unsigned gen = old / nloc;
        if (old + 1u == (gen + 1u) * nloc) {
            __builtin_amdgcn_fence(__ATOMIC_RELEASE, "agent");
            asm volatile("s_waitcnt vmcnt(0)" ::: "memory");
            const unsigned og = xb_add(&bar[XB_TOP], 1u);
            const unsigned tg = og / nx;
            if (og + 1u == (tg + 1u) * nx) xb_add(&bar[XB_TOPGEN], 1u);
            else XB_SPIN(xb_ld(&bar[XB_TOPGEN]) == tg, bar);
            __builtin_amdgcn_fence(__ATOMIC_ACQUIRE, "agent");
            xb_add(&bar[XB_XGEN(b.x)], 1u);
            asm volatile("s_waitcnt vmcnt(0)" ::: "memory");
        } else {
            XB_SPIN(xb_ld(&bar[XB_XGEN(b.x)]) == gen, bar);
            __builtin_amdgcn_fence(__ATOMIC_ACQUIRE, "agent");
            asm volatile("s_waitcnt vmcnt(0)" ::: "memory");
        }
    }
    __syncthreads();
}

struct Frame {
    LAS unsigned char* lds; volatile LAS unsigned* MISC; int tid, lane, wave, vcu, G;
    const float *xp, *xs, *ck, *cv, *nmix, *win, *bgate, *sgun, *wsp, *bsp, *wa, *wb, *wout, *nffn, *wgu, *wd, *nfin;
    float* out; unsigned char* ws;
};
__device__ __forceinline__ int opq(int x) { asm volatile("" : "+v"(x)); return x; }
__device__ __forceinline__ float bf2f_lo(unsigned w) { return __uint_as_float(w << 16); }
__device__ __forceinline__ float bf2f_hi(unsigned w) { return __uint_as_float(w & 0xffff0000u); }
typedef __bf16 bf16x2_t __attribute__((ext_vector_type(2)));
__device__ __forceinline__ unsigned cvtpk(float lo, float hi) { const bf16x2_t v = {(__bf16)lo, (__bf16)hi}; return __builtin_bit_cast(unsigned, v); }
__device__ __forceinline__ float fsig(float y) { return __builtin_amdgcn_rcpf(1.f + __builtin_amdgcn_exp2f(-1.4426950408889634f * y)); }
__device__ __forceinline__ float fgelu(float x) { const float t = x * (-2.3022081f + -0.10294324f * x * x); return x * __builtin_amdgcn_rcpf(1.f + __builtin_amdgcn_exp2f(t)); }
__device__ __forceinline__ float wave_sum(float v) {
#pragma unroll
    for (int o = 1; o < 64; o <<= 1) v += __shfl_xor(v, o);
    return v;
}
__device__ __forceinline__ void tile_of(int L, int nM, int nN, int& pm, int& pn) {
    const int nwg = nM * nN; int wgid = L; { const int q = nwg / 8, r = nwg % 8, xcd = wgid % 8, off = wgid / 8; wgid = (xcd < r ? xcd * (q + 1) : r * (q + 1) + (xcd - r) * q) + off; }
    const int nig = 8 * nN, gid = wgid / nig, fm = gid * 8, gsz = (nM - fm) < 8 ? (nM - fm) : 8;
    pm = fm + ((wgid % nig) % gsz); pn = (wgid % nig) / gsz;
}
struct SchedSimple {
    int nM, nN, G, c, K, KT; const char* A; const char* Bt;
    __device__ __forceinline__ bool next(int i, Unit& u) const { const int L = i * G + c; if (L >= nM * nN) return false; tile_of(L, nM, nN, u.pm, u.pn); u.br = 0; return true; }
    __device__ __forceinline__ const char* a_base(const Unit& u) const { return A + (size_t)u.pm * 512 * K; }
    __device__ __forceinline__ const char* b_base(const Unit& u) const { return Bt + (size_t)u.pn * 512 * K; }
};
struct SchedBranch {
    int nM, nN, G, c, K, KT; const char *A0, *B0, *A1, *B1;
    __device__ __forceinline__ bool next(int i, Unit& u) const { const int L = (i >> 1) * G + c; if (L >= nM * nN) return false; tile_of(L, nM, nN, u.pm, u.pn); u.br = i & 1; return true; }
    __device__ __forceinline__ const char* a_base(const Unit& u) const { return (u.br ? A1 : A0) + (size_t)u.pm * 512 * K; }
    __device__ __forceinline__ const char* b_base(const Unit& u) const { return (u.br ? B1 : B0) + (size_t)u.pn * 512 * K; }
};
#define EPI_ROWS(ai, m) (u.pm * 256 + (ai) * 128 + wr * 64 + (m) * 16 + fr)
__device__ __forceinline__ void row_rstd(const float* SS, const Unit& u, int wr, int fr, int fq, float (&rs)[2][4]) {
#pragma unroll
    for (int ai = 0; ai < 2; ++ai)
#pragma unroll
        for (int m = 0; m < 4; ++m) { const f32x4* s = (const f32x4*)(SS + (size_t)EPI_ROWS(ai, m) * 32 + fq * 8); const f32x4 a = s[0], b = s[1];
            float t = ((a[0] + a[1]) + (a[2] + a[3])) + ((b[0] + b[1]) + (b[2] + b[3])); t += __shfl_xor(t, 16); t += __shfl_xor(t, 32);
            rs[ai][m] = __builtin_amdgcn_rsqf(t * (1.0f / 2048.0f) + EPS); }
}
__device__ __forceinline__ u32x4 pack8(const f32x4 v0, const f32x4 v1) { u32x4 w; w.x = cvtpk(v0[0], v0[1]); w.y = cvtpk(v0[2], v0[3]); w.z = cvtpk(v1[0], v1[1]); w.w = cvtpk(v1[2], v1[3]); return w; }
#ifdef DBG_GRAW
#define GATE_ACT(x) (x)
#else
#define GATE_ACT(x) fsig(x)
#endif
struct EpiIn {
    static constexpr bool PERM = true;
    const float* SS; bf16_t *Q, *Kb, *Vb, *U, *G; float* VS; const float* bgate; float *okp, *ovp, *oks, *ovs; float* SSV;
    __device__ __forceinline__ bool keep(const Unit&) const { return false; }
    __device__ __forceinline__ void operator()(f32x4 (&acc)[2][2][4][2], const Unit& u, int wr, int wc, int fr, int fq) const {
        float rs[2][4]; row_rstd(SS, u, wr, fr, fq, rs);
        const int colt = u.pn * 256, cl = wc * 32 + 8 * fq;
        if (colt < 1024) {
#pragma unroll
            for (int ai = 0; ai < 2; ++ai)
#pragma unroll
                for (int m = 0; m < 4; ++m) { const size_t row = EPI_ROWS(ai, m); const float sc = rs[ai][m] * QSCALE;
#pragma unroll
                    for (int bj = 0; bj < 2; ++bj) *(u32x4*)(Q + row * 1024 + colt + bj * 128 + cl) = pack8(acc[ai][bj][m][0] * sc, acc[ai][bj][m][1] * sc); }
        } else if (colt < 3072) {
            const bool isv = colt >= 2048; const int c0 = colt - (isv ? 2048 : 1024) + cl; bf16_t* B = isv ? Vb : Kb;
            float* O = (u.pm < 32) ? (isv ? ovp : okp) : ((isv ? ovs : oks) - (size_t)MP * 1024);
#pragma unroll
            for (int ai = 0; ai < 2; ++ai)
#pragma unroll
                for (int m = 0; m < 4; ++m) { const size_t row = EPI_ROWS(ai, m); const float sc = rs[ai][m];
#pragma unroll
                    for (int bj = 0; bj < 2; ++bj) { const f32x4 v0 = acc[ai][bj][m][0] * sc, v1 = acc[ai][bj][m][1] * sc; const size_t o = row * 1024 + c0 + bj * 128;
                        *(u32x4*)(B + o) = pack8(v0, v1); *(f32x4*)(O + o) = v0; *(f32x4*)(O + o + 4) = v1; } }
        } else if (colt < 5120) {
            const bool isvs = colt >= 4096; const int c0 = colt - (isvs ? 4096 : 3072) + cl;
#pragma unroll
            for (int ai = 0; ai < 2; ++ai)
#pragma unroll
                for (int m = 0; m < 4; ++m) { const size_t row = EPI_ROWS(ai, m); const float sc = rs[ai][m]; float q = 0.f;
#pragma unroll
                    for (int bj = 0; bj < 2; ++bj) { f32x4 v0 = acc[ai][bj][m][0] * sc, v1 = acc[ai][bj][m][1] * sc;
#pragma unroll
                        for (int j = 0; j < 4; ++j) { v0[j] = fgelu(v0[j]); v1[j] = fgelu(v1[j]); }
                        const size_t o = row * 1024 + c0 + bj * 128;
                        if (isvs) { *(f32x4*)(VS + o) = v0; *(f32x4*)(VS + o + 4) = v1;
                            q += ((v0[0] * v0[0] + v0[1] * v0[1]) + (v0[2] * v0[2] + v0[3] * v0[3])) + ((v1[0] * v1[0] + v1[1] * v1[1]) + (v1[2] * v1[2] + v1[3] * v1[3])); }
                        else *(u32x4*)(U + o) = pack8(v0, v1); }
                    if (isvs) { q += __shfl_xor(q, 16); q += __shfl_xor(q, 32); if (fq == 0) SSV[row * 16 + (u.pn - 16) * 4 + wc] = q; } }
        } else {
            const int c0 = colt - 5120 + cl;
#pragma unroll
            for (int bj = 0; bj < 2; ++bj) { const f32x4 b0 = *(const f32x4*)(bgate + c0 + bj * 128), b1 = *(const f32x4*)(bgate + c0 + bj * 128 + 4);
#pragma unroll
                for (int ai = 0; ai < 2; ++ai)
#pragma unroll
                    for (int m = 0; m < 4; ++m) { const size_t row = EPI_ROWS(ai, m); const float sc = rs[ai][m];
                        f32x4 v0 = acc[ai][bj][m][0] * sc + b0, v1 = acc[ai][bj][m][1] * sc + b1;
#pragma unroll
                        for (int j = 0; j < 4; ++j) { v0[j] = GATE_ACT(v0[j]); v1[j] = GATE_ACT(v1[j]); }
                        *(u32x4*)(G + row * 4096 + c0 + bj * 128) = pack8(v0, v1); } }
        }
    }
};
struct EpiMerge {
    static constexpr bool PERM = true;
    const bf16_t* G; bf16_t* MG;
    __device__ __forceinline__ bool keep(const Unit& u) const { return u.br == 0; }
    __device__ __forceinline__ void operator()(f32x4 (&acc)[2][2][4][2], const Unit& u, int wr, int wc, int fr, int fq) const {
        const int c0 = u.pn * 256 + wc * 32 + 8 * fq;
#pragma unroll
        for (int ai = 0; ai < 2; ++ai)
#pragma unroll
            for (int m = 0; m < 4; ++m) { const size_t row = EPI_ROWS(ai, m);
#pragma unroll
                for (int bj = 0; bj < 2; ++bj) { const int c = c0 + bj * 128;
                    const u32x4 gb = *(const u32x4*)(G + row * 4096 + 2048 + c);
                    float b[8]; b[0] = bf2f_lo(gb.x); b[1] = bf2f_hi(gb.x); b[2] = bf2f_lo(gb.y); b[3] = bf2f_hi(gb.y); b[4] = bf2f_lo(gb.z); b[5] = bf2f_hi(gb.z); b[6] = bf2f_lo(gb.w); b[7] = bf2f_hi(gb.w);
#pragma unroll
                    for (int j = 0; j < 8; ++j) b[j] = fmaxf(b[j], 1e-30f);
                    if (u.br == 0) {
                        const u32x4 ga = *(const u32x4*)(G + row * 4096 + c);
                        float a[8]; a[0] = bf2f_lo(ga.x); a[1] = bf2f_hi(ga.x); a[2] = bf2f_lo(ga.y); a[3] = bf2f_hi(ga.y); a[4] = bf2f_lo(ga.z); a[5] = bf2f_hi(ga.z); a[6] = bf2f_lo(ga.w); a[7] = bf2f_hi(ga.w);
#pragma unroll
                        for (int j = 0; j < 4; ++j) { acc[ai][bj][m][0][j] *= a[j] * __builtin_amdgcn_rcpf(b[j]); acc[ai][bj][m][1][j] *= a[4 + j] * __builtin_amdgcn_rcpf(b[4 + j]); }
                    } else {
                        f32x4 v0, v1;
#pragma unroll
                        for (int j = 0; j < 4; ++j) { v0[j] = acc[ai][bj][m][0][j] * b[j]; v1[j] = acc[ai][bj][m][1][j] * b[4 + j]; }
                        *(u32x4*)(MG + row * 2048 + c) = pack8(v0, v1);
                    } } }
    }
};
struct EpiRes {
    static constexpr bool PERM = true;
    const float* base_p; const float* base_s;
    float* H; bf16_t* HB; float* SS; int write_hb;
    __device__ __forceinline__ bool keep(const Unit&) const { return false; }
    __device__ __forceinline__ void operator()(f32x4 (&acc)[2][2][4][2], const Unit& u, int wr, int wc, int fr, int fq) const {
        const int c0 = u.pn * 256 + wc * 32 + 8 * fq; const float* bb = (u.pm < 32) ? base_p : (base_s - (size_t)MP * 2048);
#pragma unroll
        for (int ai = 0; ai < 2; ++ai)
#pragma unroll
            for (int m = 0; m < 4; ++m) { const size_t row = EPI_ROWS(ai, m); float q = 0.f;
#pragma unroll
                for (int bj = 0; bj < 2; ++bj) { const size_t o = row * 2048 + c0 + bj * 128;
                    const f32x4 h0 = *(const f32x4*)(bb + o) + acc[ai][bj][m][0], h1 = *(const f32x4*)(bb + o + 4) + acc[ai][bj][m][1];
                    *(f32x4*)(H + o) = h0; *(f32x4*)(H + o + 4) = h1;
                    q += ((h0[0] * h0[0] + h0[1] * h0[1]) + (h0[2] * h0[2] + h0[3] * h0[3])) + ((h1[0] * h1[0] + h1[1] * h1[1]) + (h1[2] * h1[2] + h1[3] * h1[3]));
                    if (write_hb) *(u32x4*)(HB + o) = pack8(h0, h1); }
                q += __shfl_xor(q, 16); q += __shfl_xor(q, 32);
                if (fq == 0) SS[row * 32 + u.pn * 4 + wc] = q; }
    }
};
struct EpiGU {
    static constexpr bool PERM = true;
    const float* SS; bf16_t* ACT;
    __device__ __forceinline__ bool keep(const Unit&) const { return false; }
    __device__ __forceinline__ void operator()(f32x4 (&acc)[2][2][4][2], const Unit& u, int wr, int wc, int fr, int fq) const {
        float rs[2][4]; row_rstd(SS, u, wr, fr, fq, rs);
        const int c0 = u.pn * 128 + wc * 32 + 8 * fq;
#pragma unroll
        for (int ai = 0; ai < 2; ++ai)
#pragma unroll
            for (int m = 0; m < 4; ++m) { const size_t row = EPI_ROWS(ai, m); const float sc = rs[ai][m]; f32x4 v0, v1;
#pragma unroll
                for (int j = 0; j < 4; ++j) { const float g0 = acc[ai][0][m][0][j] * sc, g1 = acc[ai][0][m][1][j] * sc;
                    v0[j] = g0 * fsig(g0) * (acc[ai][1][m][0][j] * sc); v1[j] = g1 * fsig(g1) * (acc[ai][1][m][1][j] * sc); }
                *(u32x4*)(ACT + row * 5632 + c0) = pack8(v0, v1); }
    }
};
__device__ __forceinline__ void p0_transpose_item(const float* W, int K, int N, const float* scale, bf16* WT, int drow0, int k0, int n0, LAS float* scr, int lane) {
    float v[32];
#pragma unroll
    for (int i = 0; i < 32; ++i) { const int kk = 2 * i + (lane >> 5); v[i] = W[(size_t)(k0 + kk) * N + n0 + (lane & 31)]; }
    if (scale) {
#pragma unroll
        for (int i = 0; i < 32; ++i) v[i] *= scale[k0 + 2 * i + (lane >> 5)]; }
#pragma unroll
    for (int i = 0; i < 32; ++i) scr[(2 * i + (lane >> 5)) * 33 + (lane & 31)] = v[i];
    LDS_WAIT(); asm volatile("" ::: "memory");
    const int c = lane & 7;
#pragma unroll
    for (int j = 0; j < 4; ++j) { const int n = (lane >> 3) + 8 * j; const LAS float* s = scr + (8 * c) * 33 + n;
        v4u o; o.x = pk2(s[0 * 33], s[1 * 33]); o.y = pk2(s[2 * 33], s[3 * 33]); o.z = pk2(s[4 * 33], s[5 * 33]); o.w = pk2(s[6 * 33], s[7 * 33]);
        *(GAS v4u*)(WT + (size_t)(drow0 + n) * K + k0 + 8 * c) = o; }
    LDS_WAIT(); asm volatile("" ::: "memory");
}
__device__ __forceinline__ void p0_prologue(Frame& F) {
    F.tid = opq(F.tid); F.lane = F.tid & 63;
    LAS float* scr = (LAS float*)(F.lds + F.wave * 16384);
    const int gw = F.vcu * NWAVES + F.wave, NGW = F.G * NWAVES;
    constexpr int I_IN = 32 * 288, I_A = 16 * 64, I_B = 16 * 64, I_O = 32 * 64, I_GU = 32 * 352, I_D = 88 * 64, I_L = I_IN + I_A + I_B + I_O + I_GU + I_D;
    for (int it = gw; it < 2 * I_L; it += NGW) {
        const int l = it / I_L; int r = it % I_L; unsigned char* wl = F.ws + W_WL + (size_t)l * WL_STRIDE;
        if (r < I_IN) { const int kb = r / 288, nb = r % 288; p0_transpose_item(F.win + (size_t)l * DM * NIN, DM, NIN, F.nmix + l * DM, (bf16*)(wl + WL_IN), nb * 32, kb * 64, nb * 32, scr, F.lane); continue; } r -= I_IN;
        if (r < I_A) { const int kb = r / 64, nb = r % 64; p0_transpose_item(F.wa + (size_t)l * 1024 * DM, 1024, DM, nullptr, (bf16*)(wl + WL_A), nb * 32, kb * 64, nb * 32, scr, F.lane); continue; } r -= I_A;
        if (r < I_B) { const int kb = r / 64, nb = r % 64; p0_transpose_item(F.wb + (size_t)l * 1024 * DM, 1024, DM, nullptr, (bf16*)(wl + WL_B), nb * 32, kb * 64, nb * 32, scr, F.lane); continue; } r -= I_B;
        if (r < I_O) { const int kb = r / 64, nb = r % 64; p0_transpose_item(F.wout + (size_t)l * DM * DM, DM, DM, nullptr, (bf16*)(wl + WL_OUT), nb * 32, kb * 64, nb * 32, scr, F.lane); continue; } r -= I_O;
        if (r < I_GU) { const int kb = r / 352, nb = r % 352; const int n0 = nb * 32; const int j0 = n0 < FF ? n0 : n0 - FF;
            const int drow = (j0 >> 7) * 256 + (n0 < FF ? 0 : 128) + (j0 & 127);
            p0_transpose_item(F.wgu + (size_t)l * DM * NGU, DM, NGU, F.nffn + l * DM, (bf16*)(wl + WL_GU), drow, kb * 64, n0, scr, F.lane); continue; } r -= I_GU;
        { const int kb = r / 64, nb = r % 64; p0_transpose_item(F.wd + (size_t)l * FF * DM, FF, DM, nullptr, (bf16*)(wl + WL_D), nb * 32, kb * 64, nb * 32, scr, F.lane); }
    }
    bf16* HB = (bf16*)(F.ws + W_HB); float* SS = (float*)(F.ws + W_SS);
    for (int m = gw; m < M; m += NGW) {
        const float* xr = (m < MP) ? F.xp + (size_t)m * DM : F.xs + (size_t)(m - MP) * DM; float q = 0.f;
#pragma unroll
        for (int j = 0; j < 8; ++j) { const f32x4 v = *(const f32x4*)(xr + j * 256 + F.lane * 4); q += (v[0] * v[0] + v[1] * v[1]) + (v[2] * v[2] + v[3] * v[3]);
            u32x2 w; w.x = cvtpk(v[0], v[1]); w.y = cvtpk(v[2], v[3]); *(u32x2*)(HB + (size_t)m * DM + j * 256 + F.lane * 4) = w; }
        q = wave_sum(q);
        if (F.lane < 32) SS[(size_t)m * 32 + F.lane] = F.lane == 0 ? q : 0.f;
    }
    bf16* WM = (bf16*)(F.ws + W_WM);
    for (int i = (F.vcu * NWAVES + F.wave) * 64 + F.lane; i < 2 * 2 * 8 * 128 * 128; i += NGW * 64) {
        const int s = i & 127, t = (i >> 7) & 127, g = (i >> 14) & 7, kind = (i >> 17) & 1, l = i >> 18;
        const float* w = F.wsp + ((size_t)l * 8 + g) * 16384; float v;
        if (kind == 0) v = ((s >> 6) <= (t >> 6)) ? w[t * 128 + s] : 0.f; else v = ((s >> 6) == (t >> 6)) ? w[(t & 63) * 128 + (s & 63)] : 0.f;
        WM[i] = (bf16)f2bf(v);
    }
}
__device__ __forceinline__ void p_final(Frame& F, float dbg_scale_sample) {
    F.tid = opq(F.tid); F.lane = F.tid & 63;
    const int gw = F.vcu * NWAVES + F.wave, NGW = F.G * NWAVES; const float* SS = (const float*)(F.ws + W_SS);
    for (int m = gw; m < M; m += NGW) {
        float t = F.lane < 32 ? SS[(size_t)m * 32 + F.lane] : 0.f; t = wave_sum(t); float r = __builtin_amdgcn_rsqf(t * (1.0f / 2048.0f) + EPS); if (m >= MP) r *= dbg_scale_sample;
        float* h = F.out + OUT_Y + (size_t)m * DM;
#pragma unroll
        for (int j = 0; j < 8; ++j) { const int c = j * 256 + F.lane * 4; const f32x4 v = *(const f32x4*)(h + c), g = *(const f32x4*)(F.nfin + c); *(f32x4*)(h + c) = v * r * g; }
    }
}
constexpr int A_VOFF = 0, A_KOFF = 32768, A_TILE = 16384;
#define KSWZ(row, colB) ((row) * 256 + ((colB) ^ (((row) & 7) << 4)))
#define SBAR() __builtin_amdgcn_sched_barrier(0)
__device__ __forceinline__ int crow(int r, int hi) { return (r & 3) + 8 * (r >> 2) + 4 * hi; }
__device__ __forceinline__ int v_st(int k, int c) { const int kk = (k & ~0xC) | ((k & 4) << 1) | ((k & 8) >> 1); return ((kk >> 3) * 4 + (c >> 5)) * 512 + ((kk & 7) * 32 + (c & 31)) * 2; }
__device__ __forceinline__ int v_rd_base(int lane) { return ((lane & 3) << 3) | (((lane >> 2) & 3) << 6) | (((lane >> 4) & 1) << 5) | (((lane >> 5) & 1) << 8); }
constexpr int v_rd_off(int d0, int ks, int half) { return d0 * 512 + ks * 4096 + half * 2048; }
template <int OFF> __device__ __forceinline__ s16x4 tr_read(int vb) { s16x4 r; asm volatile("ds_read_b64_tr_b16 %0, %1 offset:%2" : "=&v"(r) : "v"(vb), "i"(OFF) : "memory"); return r; }
template <int D0> __device__ __forceinline__ void pv_one(f32x16& od, int vb, bf16x8 pa0, bf16x8 pa1, bf16x8 pa2, bf16x8 pa3) {
    const s16x4 l0 = tr_read<v_rd_off(D0, 0, 0)>(vb), h0 = tr_read<v_rd_off(D0, 0, 1)>(vb), l1 = tr_read<v_rd_off(D0, 1, 0)>(vb), h1 = tr_read<v_rd_off(D0, 1, 1)>(vb);
    const s16x4 l2 = tr_read<v_rd_off(D0, 2, 0)>(vb), h2 = tr_read<v_rd_off(D0, 2, 1)>(vb), l3 = tr_read<v_rd_off(D0, 3, 0)>(vb), h3 = tr_read<v_rd_off(D0, 3, 1)>(vb);
    asm volatile("s_waitcnt lgkmcnt(0)" ::: "memory"); SBAR();
#define PK(L, H) (bf16x8){L[0], L[1], L[2], L[3], H[0], H[1], H[2], H[3]}
    od = __builtin_amdgcn_mfma_f32_32x32x16_bf16(pa0, PK(l0, h0), od, 0, 0, 0);
    od = __builtin_amdgcn_mfma_f32_32x32x16_bf16(pa1, PK(l1, h1), od, 0, 0, 0);
    od = __builtin_amdgcn_mfma_f32_32x32x16_bf16(pa2, PK(l2, h2), od, 0, 0, 0);
    od = __builtin_amdgcn_mfma_f32_32x32x16_bf16(pa3, PK(l3, h3), od, 0, 0, 0);
#undef PK
}
__device__ __forceinline__ void qkt(f32x16& p0, f32x16& p1, const LAS unsigned char* Ks, const bf16x8 (&qr)[8], int r32, int hi) {
    p0 = f32x16{}; p1 = f32x16{};
#pragma unroll
    for (int d0 = 0; d0 < 8; ++d0) { const int cb = (d0 * 16 + hi * 8) * 2;
        const bf16x8 b0 = *(const LAS bf16x8*)(Ks + KSWZ(r32, cb)); const bf16x8 b1 = *(const LAS bf16x8*)(Ks + KSWZ(32 + r32, cb));
        p0 = __builtin_amdgcn_mfma_f32_32x32x16_bf16(b0, qr[d0], p0, 0, 0, 0); p1 = __builtin_amdgcn_mfma_f32_32x32x16_bf16(b1, qr[d0], p1, 0, 0, 0); }
}
__device__ __forceinline__ void sb_half(f32x16& p, float& R, int hi, bool need_mask, int kpos0, int qpos) {
    f32x16 st;
#pragma unroll
    for (int r = 0; r < 16; ++r) { const float zz = fmaxf(p[r], -120.f); const float e = __builtin_amdgcn_exp2f(-zz); float bt = __builtin_amdgcn_rcpf(1.f + e); float s = e * bt;
        if (need_mask) { const bool valid = (kpos0 + crow(r, hi)) < qpos; s = valid ? s : 1.f; bt = valid ? bt : 0.f; }
        p[r] = bt; st[r] = s; }
    float x1[4], x2[4], x3[4], c[4], f[4];
#pragma unroll
    for (int q = 0; q < 4; ++q) { x3[q] = st[4 * q + 3]; x2[q] = x3[q] * st[4 * q + 2]; x1[q] = x2[q] * st[4 * q + 1]; const float pq = x1[q] * st[4 * q];
        const auto rr = __builtin_amdgcn_permlane32_swap(__float_as_uint(pq), __float_as_uint(pq), false, false);
        const float v0 = __uint_as_float(rr[0]), v1 = __uint_as_float(rr[1]); c[q] = v0 * v1; f[q] = hi ? 1.f : v1; }
    const float S3 = R, S2 = S3 * c[3], S1 = S2 * c[2], S0 = S1 * c[1]; R = S0 * c[0];
    R = R < 7.8886e-31f ? 0.f : R;
    const float T[4] = {S0 * f[0], S1 * f[1], S2 * f[2], S3 * f[3]};
#pragma unroll
    for (int q = 0; q < 4; ++q) { p[4 * q + 3] *= T[q]; p[4 * q + 2] *= T[q] * x3[q]; p[4 * q + 1] *= T[q] * x2[q]; p[4 * q] *= T[q] * x1[q]; }
}
#define PK4(P, BASE, OUT) do { const unsigned a0 = cvtpk(P[BASE + 0], P[BASE + 1]), a1 = cvtpk(P[BASE + 2], P[BASE + 3]);   \
    const unsigned b0 = cvtpk(P[BASE + 4], P[BASE + 5]), b1 = cvtpk(P[BASE + 6], P[BASE + 7]);                              \
    const auto r0 = __builtin_amdgcn_permlane32_swap(a0, b0, false, false); const auto r1 = __builtin_amdgcn_permlane32_swap(a1, b1, false, false); \
    u32x4 w_ = {r0[0], r1[0], r0[1], r1[1]}; OUT = *reinterpret_cast<bf16x8*>(&w_); } while (0)
template <bool SAMPLE>
__device__ __forceinline__ void attn_unit(Frame& F, int l, int b, int h, int qb) {
    const int tid = opq(F.tid), wid = F.wave, lane = tid & 63, r32 = lane & 31, hi = lane >> 5;
    const LAS unsigned char* Kl = F.lds + A_KOFF; LAS unsigned char* Vl = F.lds + A_VOFF;
    const bool active = SAMPLE ? (wid < 2) : true;
    const int nt = SAMPLE ? 33 : 4 * qb + 4;
    const int wrow_lo = SAMPLE ? 2048 + 32 * wid : 256 * qb + 32 * wid;
    const int qpos = wrow_lo + r32;
    const size_t qrow = SAMPLE ? (size_t)(MP + b * 64 + 32 * wid + r32) : (size_t)(b * 2048 + qpos);
    const bf16* Qp = (const bf16*)(F.ws + W_Q) + qrow * 1024 + h * 128 + hi * 8;
    bf16x8 qr[8];
    if (active) {
#pragma unroll
        for (int d0 = 0; d0 < 8; ++d0) qr[d0] = *(const bf16x8*)(Qp + d0 * 16);
    } else {
#pragma unroll
        for (int d0 = 0; d0 < 8; ++d0) qr[d0] = bf16x8{};
    }
    f32x16 o[4] = {}; float R = 1.f;
    const int sr = tid >> 4, sc = (tid & 15) * 8, vst0 = v_st(sr, sc), vst1 = v_st(32 + sr, sc);
    const int vb0 = (int)(unsigned)(uintptr_t)Vl + v_rd_base(lane);
    const bf16* Kb = (const bf16*)(F.ws + W_K); const bf16* Vb = (const bf16*)(F.ws + W_V);
    const float* nk = F.out + OUT_KS + ((size_t)(l * 32 + b) * 64) * 1024 + h * 128; const float* nv = F.out + OUT_VS + ((size_t)(l * 32 + b) * 64) * 1024 + h * 128;
    const float* ckb = F.ck + ((size_t)(l * 32 + b) * 2048) * 1024 + h * 128; const float* cvb = F.cv + ((size_t)(l * 32 + b) * 2048) * 1024 + h * 128;
#define TILE_POS(j) (SAMPLE ? ((j) == 0 ? 2048 : 2048 - 64 * (j)) : 64 * (nt - 1 - (j)))
    f32x8v fk0, fk1, fv0, fv1; bf16x8 bk0, bk1, bv0, bv1;
#define SLOAD(j) do { if constexpr (SAMPLE) { const float* kp = (j) == 0 ? nk : ckb + (size_t)(2048 - 64 * (j)) * 1024; const float* vp = (j) == 0 ? nv : cvb + (size_t)(2048 - 64 * (j)) * 1024; \
        fk0 = *(const f32x8v*)(kp + (size_t)sr * 1024 + sc); fk1 = *(const f32x8v*)(kp + (size_t)(32 + sr) * 1024 + sc); fv0 = *(const f32x8v*)(vp + (size_t)sr * 1024 + sc); fv1 = *(const f32x8v*)(vp + (size_t)(32 + sr) * 1024 + sc); } \
    else { const size_t ro = ((size_t)(b * 2048 + TILE_POS(j) + sr)) * 1024 + h * 128 + sc; bk0 = *(const bf16x8*)(Kb + ro); bk1 = *(const bf16x8*)(Kb + ro + 32 * 1024); bv0 = *(const bf16x8*)(Vb + ro); bv1 = *(const bf16x8*)(Vb + ro + 32 * 1024); } } while (0)
#define TOBF(x) ({ u32x4 w__ = {cvtpk(x[0], x[1]), cvtpk(x[2], x[3]), cvtpk(x[4], x[5]), cvtpk(x[6], x[7])}; *reinterpret_cast<bf16x8*>(&w__); })
#define SWRITE(bufi) do { LAS unsigned char* vd = Vl + (bufi) * A_TILE; LAS unsigned char* kd = (LAS unsigned char*)Kl + (bufi) * A_TILE; const int kc = sc * 2; \
        if constexpr (SAMPLE) { *(LAS bf16x8*)(vd + vst0) = TOBF(fv0); *(LAS bf16x8*)(vd + vst1) = TOBF(fv1); *(LAS bf16x8*)(kd + KSWZ(sr, kc)) = TOBF(fk0); *(LAS bf16x8*)(kd + KSWZ(32 + sr, kc)) = TOBF(fk1); } \
        else { *(LAS bf16x8*)(vd + vst0) = bv0; *(LAS bf16x8*)(vd + vst1) = bv1; *(LAS bf16x8*)(kd + KSWZ(sr, kc)) = bk0; *(LAS bf16x8*)(kd + KSWZ(32 + sr, kc)) = bk1; } } while (0)
    volatile LAS unsigned* dflag = F.MISC + 16;
    SLOAD(0); asm volatile("s_waitcnt vmcnt(0)" ::: "memory"); SWRITE(0); __syncthreads();
    for (int j = 0; j < nt; ++j) {
        if (j > 0) {
            unsigned alld = 1u;
#pragma unroll
            for (int w = 0; w < 8; ++w) alld &= dflag[((j - 1) & 1) * 8 + w];
            if (alld) break;
        }
        if (j + 1 < nt) SLOAD(j + 1);
        const int kpos0 = TILE_POS(j);
        if (active && kpos0 < wrow_lo + 31) {
            f32x16 p0, p1; bf16x8 pa0, pa1, pa2, pa3;
            qkt(p0, p1, Kl + (j & 1) * A_TILE, qr, r32, hi);
            const bool need_mask = !(kpos0 + 63 < wrow_lo);
            sb_half(p1, R, hi, need_mask, kpos0 + 32, qpos);
            sb_half(p0, R, hi, need_mask, kpos0, qpos);
            PK4(p0, 0, pa0); PK4(p0, 8, pa1); PK4(p1, 0, pa2); PK4(p1, 8, pa3);
            const int vb = vb0 + (j & 1) * A_TILE;
            pv_one<0>(o[0], vb, pa0, pa1, pa2, pa3); pv_one<1>(o[1], vb, pa0, pa1, pa2, pa3); pv_one<2>(o[2], vb, pa0, pa1, pa2, pa3); pv_one<3>(o[3], vb, pa0, pa1, pa2, pa3);
        }
        { const bool wdone = !active || __all(R == 0.f); if (lane == 0) dflag[(j & 1) * 8 + wid] = wdone ? 1u : 0u; }
        if (j + 1 < nt) { asm volatile("s_waitcnt vmcnt(0)" ::: "memory"); SWRITE((j + 1) & 1); }
        __syncthreads();
    }
    if (active) {
        bf16* Ow = (bf16*)(F.ws + W_ATT) + (SAMPLE ? (size_t)(MP + b * 64 + 32 * wid) : (size_t)(b * 2048 + wrow_lo)) * 1024 + h * 128 + r32;
#pragma unroll
        for (int r = 0; r < 16; ++r) { const int orow = crow(r, hi);
#pragma unroll
            for (int d0 = 0; d0 < 4; ++d0) Ow[(size_t)orow * 1024 + d0 * 32] = (bf16)f2bf(o[d0][r]); }
    }
#undef SLOAD
#undef SWRITE
#undef TILE_POS
}
__device__ __forceinline__ void sgu_unit(Frame& F, int l, int tile, int g) {
    const int tid = opq(F.tid), wid = F.wave, lane = tid & 63, r32 = lane & 31, hi = lane >> 5;
    const int row0 = tile * 128; const bool samp = row0 >= MP;
    const float* VS = (const float*)(F.ws + W_VS); const float* SSV = (const float*)(F.ws + W_SSV); const bf16* U = (const bf16*)(F.ws + W_U); bf16* BB = (bf16*)(F.ws + W_BB);
    const bf16* WM = (const bf16*)(F.ws + W_WM) + ((size_t)(l * 2 + (samp ? 1 : 0)) * 8 + g) * 16384;
    const int sr = tid >> 4, sc = (tid & 15) * 8, rg = wid & 3, ch = wid >> 2;
    f32x8v vv[4]; f32x4 sl[4][4];
#pragma unroll
    for (int i = 0; i < 4; ++i) { const size_t grow = (size_t)(row0 + sr + 32 * i); vv[i] = *(const f32x8v*)(VS + grow * 1024 + g * 128 + sc);
#pragma unroll
        for (int j = 0; j < 4; ++j) sl[i][j] = *(const f32x4*)(SSV + grow * 16 + j * 4); }
    const f32x8v gv = *(const f32x8v*)(F.sgun + l * 1024 + g * 128 + sc);
    const bf16* wrow = WM + ((size_t)(rg * 32 + r32)) * 128 + hi * 8;
    bf16x8 pa[2][4];
#pragma unroll
    for (int kt = 0; kt < 2; ++kt)
#pragma unroll
        for (int ks = 0; ks < 4; ++ks) pa[kt][ks] = *(const bf16x8*)(wrow + kt * 64 + ks * 16);
    unsigned short uu[16][2]; float bias[16];
#pragma unroll
    for (int r = 0; r < 16; ++r) { const int t = rg * 32 + crow(r, hi); bias[r] = F.bsp[l * 1024 + g * 128 + (samp ? (t & 63) : t)];
#pragma unroll
        for (int i = 0; i < 2; ++i) uu[r][i] = U[(size_t)(row0 + t) * 1024 + g * 128 + (2 * ch + i) * 32 + r32]; }
    float* sgo = F.out + OUT_SG + ((size_t)l * MS) * 1024;
#pragma unroll
    for (int i = 0; i < 4; ++i) { const int s = sr + 32 * i; const size_t grow = (size_t)(row0 + s);
        float q = 0.f;
#pragma unroll
        for (int j = 0; j < 4; ++j) q += (sl[i][j][0] + sl[i][j][1]) + (sl[i][j][2] + sl[i][j][3]);
        const float rr = __builtin_amdgcn_rsqf(q * (1.0f / 1024.0f) + EPS); f32x8v v = vv[i];
#pragma unroll
        for (int j = 0; j < 8; ++j) v[j] = v[j] * rr * gv[j];
        if (samp) *(f32x8v*)(sgo + (grow - MP) * 1024 + g * 128 + sc) = v;
        u32x4 w = {cvtpk(v[0], v[1]), cvtpk(v[2], v[3]), cvtpk(v[4], v[5]), cvtpk(v[6], v[7])};
        *(LAS u32x4*)(F.lds + (s >> 6) * A_TILE + v_st(s & 63, sc)) = w; }
    __syncthreads();
    const int vb0 = (int)(unsigned)(uintptr_t)F.lds + v_rd_base(lane);
    f32x16 o2[2] = {};
#pragma unroll
    for (int kt = 0; kt < 2; ++kt) { const int vb = vb0 + kt * A_TILE;
        if (ch == 0) { pv_one<0>(o2[0], vb, pa[kt][0], pa[kt][1], pa[kt][2], pa[kt][3]); pv_one<1>(o2[1], vb, pa[kt][0], pa[kt][1], pa[kt][2], pa[kt][3]); }
        else { pv_one<2>(o2[0], vb, pa[kt][0], pa[kt][1], pa[kt][2], pa[kt][3]); pv_one<3>(o2[1], vb, pa[kt][0], pa[kt][1], pa[kt][2], pa[kt][3]); } }
#pragma unroll
    for (int r = 0; r < 16; ++r) { const int t = rg * 32 + crow(r, hi);
#pragma unroll
        for (int i = 0; i < 2; ++i) { const size_t off = (size_t)(row0 + t) * 1024 + g * 128 + (2 * ch + i) * 32 + r32;
            BB[off] = (bf16)f2bf(__uint_as_float(((unsigned)uu[r][i]) << 16) * (o2[i][r] + bias[r])); } }
    __syncthreads();
}
constexpr int N_PHASES = 14;
struct Args { const float* in[17]; float* out; unsigned char* ws; int ph_lo, ph_hi, li, pad; };
__global__ void __launch_bounds__(NWAVES * 64, 2) mk_fwd(Args args) {
    extern __shared__ __attribute__((aligned(16))) unsigned char lds_raw[];
    Frame F;
    F.lds = (LAS unsigned char*)lds_raw; F.MISC = (volatile LAS unsigned*)(F.lds + MISC_OFF);
    F.tid = threadIdx.x; F.lane = F.tid & 63; F.wave = __builtin_amdgcn_readfirstlane(F.tid >> 6);
    F.G = gridDim.x; { const int bx = blockIdx.x; F.vcu = (F.G % 8 == 0) ? (bx % 8) * (F.G / 8) + bx / 8 : bx; }
    F.xp = args.in[0]; F.xs = args.in[1]; F.ck = args.in[2]; F.cv = args.in[3]; F.nmix = args.in[4]; F.win = args.in[5]; F.bgate = args.in[6]; F.sgun = args.in[7]; F.wsp = args.in[8]; F.bsp = args.in[9];
    F.wa = args.in[10]; F.wb = args.in[11]; F.wout = args.in[12]; F.nffn = args.in[13]; F.wgu = args.in[14]; F.wd = args.in[15]; F.nfin = args.in[16];
    F.out = args.out; F.ws = args.ws;
    for (int u = F.tid; u < (LDS_BYTES - LDSCTL_OFF) / 4; u += NWAVES * 64) ((LAS unsigned*)(F.lds + LDSCTL_OFF))[u] = 0u;
    __syncthreads();
    gu32* ctl = (gu32*)(F.ws + W_CTL);
    XcdBarrier bar = xcd_barrier_post((unsigned*)(ctl + CW_BAR) + args.li * XCD_BAR_WORDS, F.MISC + 8);
    const int lo = args.ph_lo, hi = args.ph_hi;
#define IN(k) (lo <= (k) && (k) < hi)
#ifdef TIMING
#define STAMP(k) do { if (blockIdx.x == 0 && F.tid == 0) __hip_atomic_store((gu64*)(ctl + 2048) + (k), (unsigned long long)wall_clock64(), RLX_AGENT); } while (0)
#else
#define STAMP(k) do { } while (0)
#endif
#define SEAM(k) do { if (IN(k) && IN((k) + 1)) xcd_barrier(bar); STAMP((k) + 1); } while (0)
    unsigned char* ws = F.ws;
    bf16_t* HB = (bf16_t*)(ws + W_HB); float* SS = (float*)(ws + W_SS); float* H = F.out + OUT_Y;
    STAMP(0);
    if (IN(0)) p0_prologue(F);
    SEAM(0);
    for (int l = 0; l < 2; ++l) {
        const int pb = 1 + 6 * l; unsigned char* wl = ws + W_WL + (size_t)l * WL_STRIDE;
        if (IN(pb)) {
            SchedSimple S{40, 36, F.G, (int)blockIdx.x, 2048, 2048, (const char*)HB, (const char*)(wl + WL_IN)};
            EpiIn E{SS, (bf16_t*)(ws + W_Q), (bf16_t*)(ws + W_K), (bf16_t*)(ws + W_V), (bf16_t*)(ws + W_U), (bf16_t*)(ws + W_G), (float*)(ws + W_VS), F.bgate + l * 4096,
                    F.out + OUT_KP + (size_t)l * MP * 1024, F.out + OUT_VP + (size_t)l * MP * 1024, F.out + OUT_KS + (size_t)l * MS * 1024, F.out + OUT_VS + (size_t)l * MS * 1024, (float*)(ws + W_SSV)};
            pg8::gemm_phase<EpiIn, SchedSimple>(F.lds, S, E);
        }
        SEAM(pb);
        if (IN(pb + 1)) {
            const int c = F.vcu;
            for (int pu = c; pu < 256; pu += F.G) { const int qb = 7 - (pu >> 5), bh = pu & 31; attn_unit<false>(F, l, bh >> 3, bh & 7, qb); }
            for (int su = c; su < 256; su += F.G) attn_unit<true>(F, l, su >> 3, su & 7, 0);
            for (int tu = c; tu < 640; tu += F.G) sgu_unit(F, l, tu >> 3, tu & 7);
        }
        SEAM(pb + 1);
        if (IN(pb + 2)) {
            SchedBranch S{40, 8, F.G, (int)blockIdx.x, 1024, 1024, (const char*)(ws + W_ATT), (const char*)(wl + WL_A), (const char*)(ws + W_BB), (const char*)(wl + WL_B)};
            EpiMerge E{(const bf16_t*)(ws + W_G), (bf16_t*)(ws + W_MG)};
            pg8::gemm_phase<EpiMerge, SchedBranch>(F.lds, S, E);
        }
        SEAM(pb + 2);
        if (IN(pb + 3)) {
            SchedSimple S{40, 8, F.G, (int)blockIdx.x, 2048, 2048, (const char*)(ws + W_MG), (const char*)(wl + WL_OUT)};
            EpiRes E{l == 0 ? F.xp : (const float*)H, l == 0 ? F.xs : (const float*)(H + (size_t)MP * 2048), H, HB, SS, 1};
            pg8::gemm_phase<EpiRes, SchedSimple>(F.lds, S, E);
        }
        SEAM(pb + 3);
        if (IN(pb + 4)) {
            SchedSimple S{40, 44, F.G, (int)blockIdx.x, 2048, 2048, (const char*)HB, (const char*)(wl + WL_GU)};
            EpiGU E{SS, (bf16_t*)(ws + W_ACT)};
            pg8::gemm_phase<EpiGU, SchedSimple>(F.lds, S, E);
        }
        SEAM(pb + 4);
        if (IN(pb + 5)) {
            SchedSimple S{40, 8, F.G, (int)blockIdx.x, 5632, 5632, (const char*)(ws + W_ACT), (const char*)(wl + WL_D)};
            EpiRes E{(const float*)H, (const float*)(H + (size_t)MP * 2048), H, HB, SS, l == 0 ? 1 : 0};
            pg8::gemm_phase<EpiRes, SchedSimple>(F.lds, S, E);
        }
        SEAM(pb + 5);
    }
#ifdef TIMING
    if (IN(13)) { const unsigned long long* st = (const unsigned long long*)(ctl + 2048);
        const float t1 = (float)(__hip_atomic_load((gu64*)st + TIM_A1, RLX_AGENT) - __hip_atomic_load((gu64*)st + TIM_A0, RLX_AGENT)) * 0.01f, t2 = (float)(__hip_atomic_load((gu64*)st + TIM_B1, RLX_AGENT) - __hip_atomic_load((gu64*)st + TIM_B0, RLX_AGENT)) * 0.01f;
        p_final(F, 1.f + t1 * (1.f / 3000.f));
        if (blockIdx.x == 0 && F.tid == 0) F.out[OUT_KS] += t2 * 0.1f; }
#else
    if (IN(13)) p_final(F, 1.f);
#endif
#undef IN
#undef SEAM
}
static int g_grid = 0;
static inline bool fast_setup() {
    if (g_grid == 0) {
        int dev = 0, cus = 0;
        if (hipGetDevice(&dev) != hipSuccess || hipDeviceGetAttribute(&cus, hipDeviceAttributeMultiprocessorCount, dev) != hipSuccess) { g_grid = -1; return false; }
        if (hipFuncSetAttribute((const void*)mk_fwd, hipFuncAttributeMaxDynamicSharedMemorySize, LDS_BYTES) != hipSuccess) { fprintf(stderr, "hipFuncSetAttribute failed\n"); g_grid = -1; return false; }
        int per_cu = 0; (void)hipOccupancyMaxActiveBlocksPerMultiprocessor(&per_cu, (const void*)mk_fwd, NWAVES * 64, LDS_BYTES); (void)hipGetLastError();
        if (per_cu < 1) fprintf(stderr, "note: occupancy query reports %d\n", per_cu);
        g_grid = cus;
    }
    return g_grid > 0;
}
static inline void fast_launch(hipStream_t stream, void* const* d_in, float* out, unsigned char* wsbase, int lo, int hi, int li) {
    Args a{}; for (int i = 0; i < 17; ++i) a.in[i] = (const float*)d_in[i];
    a.out = out; a.ws = wsbase; a.ph_lo = lo; a.ph_hi = hi; a.li = li; a.pad = 0;
    hipLaunchKernelGGL(mk_fwd, dim3(g_grid), dim3(NWAVES * 64), LDS_BYTES, stream, a);
}
}
extern "C" void kernel_launch(void* const* d_in, const int* in_sizes, int n_in, void* d_out, int out_size, void* d_ws, size_t ws_size, hipStream_t stream) {
    if (!fk::fast_setup()) return;
    if (n_in != 17 || out_size != (int)fk::OUT_N || ws_size < fk::W_END) { fprintf(stderr, "kernel_launch: unexpected shapes (n_in %d out %d ws %zu)\n", n_in, out_size, ws_size); return; }
    (void)hipMemsetAsync((char*)d_ws + fk::W_CTL, 0, fk::CTL_ZERO_BYTES, stream);
#if defined(PROBE_DUP)
    fk::fast_launch(stream, d_in, (float*)d_out, (unsigned char*)d_ws, 0, PROBE_DUP + 1, 0);
    fk::fast_launch(stream, d_in, (float*)d_out, (unsigned char*)d_ws, PROBE_DUP, fk::N_PHASES, 1);
#elif MK_N_LAUNCHES == 1
    fk::fast_launch(stream, d_in, (float*)d_out, (unsigned char*)d_ws, 0, fk::N_PHASES, 0);
#else
    for (int p = 0; p < fk::N_PHASES; ++p) fk::fast_launch(stream, d_in, (float*)d_out, (unsigned char*)d_ws, p, p + 1, p);
#endif
}
```

```cpp
#include <hip/hip_runtime.h>
#include <cstdio>
#include <cstdint>
#ifndef MK_N_LAUNCHES
#define MK_N_LAUNCHES 1
#endif
namespace pg8 {
#define PG8_LAS __attribute__((address_space(3)))
typedef unsigned short bf16_t;
typedef short bf16x8 __attribute__((ext_vector_type(8)));
typedef float f32x4 __attribute__((ext_vector_type(4)));
typedef unsigned u32x4 __attribute__((ext_vector_type(4)));
constexpr int BM = 256, BK = 64, HALF = 128, HTB = HALF * BK * 2  , STAGE_BYTES = 8 * HTB, NXCD = 8, WGM = 8;

__host__ __device__ __forceinline__ int lds_byte(int r, int c) { const int st = (r >> 4) * 2 + (c >> 5), rr = r & 15, cc = c & 31, ob = rr * 64 + cc * 2; return st * 1024 + (ob ^ (((ob >> 9) & 1) << 5)); }
__host__ __device__ __forceinline__ void stage_rc(int b, int& R, int& C) { const int st = b / 1024, sb = b % 1024, swz = sb ^ (((sb >> 9) & 1) << 5); R = (st >> 1) * 16 + swz / 64; C = (st & 1) * 32 + (swz % 64) / 2; }
__host__ __device__ __forceinline__ int perm32(int rho) { const int n = rho >> 4, i = rho & 15; return 8 * (i >> 2) + 4 * n + (i & 3); }

struct Unit { int pm, pn, br; };
template <class Epi, class Sched, bool ALIGN_EPI = true, bool SP2 = true>
__device__ __forceinline__ void gemm_phase(PG8_LAS unsigned char* lds, const Sched& S, const Epi& E) {
    int tid_ = threadIdx.x; asm volatile("" : "+v"(tid_));
    const int tid = tid_, wid = __builtin_amdgcn_readfirstlane(tid >> 6), lane = tid & 63, wr = wid >> 2, wc = wid & 3, fr = lane & 15, fq = lane >> 4;
    const int K = S.K;
    unsigned voffA[2], voffB[2];
#pragma unroll
    for (int i = 0; i < 2; ++i) { int R, C; stage_rc(tid * 16 + i * 8192, R, C); const int Rb = Epi::PERM ? ((R & ~31) + perm32(R & 31)) : R;
        voffA[i] = (unsigned)(R * K + C) * 2u; voffB[i] = (unsigned)(Rb * K + C) * 2u; }
    const size_t kstep = (size_t)(BK * 2);
    const size_t hstep = (size_t)HALF * K * 2;
        const unsigned ldsw = (unsigned)wid * 1024u;
    const int aoff = lds_byte(wr * 64 + fr, fq * 8), boff = lds_byte(wc * 32 + fr, fq * 8);
#define PG8_SA(b, h) (((b) * 2 + (h)) * HTB)
#define PG8_SB(b, h) ((4 + (b) * 2 + (h)) * HTB)
#define PG8_STAGE(bufoff, gbase, voff) do { _Pragma("unroll") for (int _i = 0; _i < 2; ++_i) \
        __builtin_amdgcn_global_load_lds((const unsigned*)((const char*)(gbase) + (voff)[_i]), (PG8_LAS unsigned*)(lds + (bufoff) + ldsw + _i * 8192), 16, 0, 0); } while (0)
#define PG8_LDA(dst, b, h) do { _Pragma("unroll") for (int m = 0; m < 4; ++m) _Pragma("unroll") for (int k = 0; k < 2; ++k) dst[m][k] = *(const PG8_LAS bf16x8*)(lds + PG8_SA(b, h) + aoff + m * 2048 + k * 1024); } while (0)
#define PG8_LDB(dst, b, h) do { _Pragma("unroll") for (int n = 0; n < 2; ++n) _Pragma("unroll") for (int k = 0; k < 2; ++k) dst[n][k] = *(const PG8_LAS bf16x8*)(lds + PG8_SB(b, h) + boff + n * 2048 + k * 1024); } while (0)
#define PG8_MMA(ai, bj, At, Bt) do { __builtin_amdgcn_s_setprio(1); _Pragma("unroll") for (int m = 0; m < 4; ++m) _Pragma("unroll") for (int n = 0; n < 2; ++n) _Pragma("unroll") for (int k = 0; k < 2; ++k) \
        acc[ai][bj][m][n] = __builtin_amdgcn_mfma_f32_16x16x32_bf16(Bt[n][k], At[m][k], acc[ai][bj][m][n], 0, 0, 0); __builtin_amdgcn_s_setprio(0); } while (0)
#define PG8_WAIT_V(n) asm volatile("s_waitcnt vmcnt(" #n ")" ::: "memory")
#define PG8_WAIT_L(n) asm volatile("s_waitcnt lgkmcnt(" #n ")" ::: "memory")
#define PG8_BAR __builtin_amdgcn_s_barrier()
#define PG8_SCHED __builtin_amdgcn_sched_barrier(0)
    Unit cur, nxt; int ui = 0;
    if (!S.next(0, cur)) return;
    f32x4 acc[2][2][4][2];
#pragma unroll
    for (int a = 0; a < 2; ++a)
#pragma unroll
        for (int b = 0; b < 2; ++b)
#pragma unroll
            for (int m = 0; m < 4; ++m)
#pragma unroll
                for (int n = 0; n < 2; ++n) acc[a][b][m][n] = (f32x4){0.f, 0.f, 0.f, 0.f};
    bf16x8 At[4][2], B0[2][2], B1[2][2];
    const char* cA = S.a_base(cur); const char* cB = S.b_base(cur);
    if constexpr (SP2) {
        PG8_STAGE(PG8_SB(0, 0), cB, voffB); PG8_STAGE(PG8_SB(0, 1), cB + hstep, voffB); PG8_STAGE(PG8_SA(0, 0), cA, voffA); PG8_STAGE(PG8_SA(0, 1), cA + hstep, voffA);
        if (wr == 1) PG8_BAR;
        PG8_WAIT_V(2); PG8_BAR;
        PG8_STAGE(PG8_SB(1, 0), cB + kstep, voffB); PG8_STAGE(PG8_SA(1, 0), cA + kstep, voffA); PG8_STAGE(PG8_SB(1, 1), cB + hstep + kstep, voffB);
        PG8_WAIT_V(6); PG8_BAR;
    } else {
        PG8_STAGE(PG8_SB(0, 0), cB, voffB); PG8_STAGE(PG8_SA(0, 0), cA, voffA); PG8_STAGE(PG8_SB(0, 1), cB + hstep, voffB); PG8_STAGE(PG8_SA(0, 1), cA + hstep, voffA);
        if (wr == 1) PG8_BAR;
        PG8_WAIT_V(4); PG8_BAR;
        PG8_STAGE(PG8_SB(1, 0), cB + kstep, voffB); PG8_STAGE(PG8_SA(1, 0), cA + kstep, voffA); PG8_STAGE(PG8_SB(1, 1), cB + hstep + kstep, voffB);
        PG8_WAIT_V(6); PG8_BAR;
    }
    for (;;) {
        const bool has_next = S.next(ui + 1, nxt); const int nt = S.nt(cur);
        const char* nA = has_next ? S.a_base(nxt) : cA; const char* nB = has_next ? S.b_base(nxt) : cB;
        for (int t = 0; t < nt; t += 2) {
            const bool last = (t == nt - 2);
            const char* a1 = cA + (size_t)(t + 1) * kstep;
            const char* a2 = last ? nA : cA + (size_t)(t + 2) * kstep; const char* b2 = last ? nB : cB + (size_t)(t + 2) * kstep;
            const char* a3 = a2 + kstep; const char* b3 = b2 + kstep;
            if constexpr (SP2) {
            PG8_LDB(B0, 0, 0); PG8_LDB(B1, 0, 1); PG8_SCHED; PG8_LDA(At, 0, 0); PG8_STAGE(PG8_SA(1, 1), a1 + hstep, voffA);
            PG8_WAIT_V(8); PG8_WAIT_L(0); PG8_BAR; PG8_MMA(0, 0, At, B0); PG8_MMA(0, 1, At, B1); PG8_BAR; PG8_SCHED;
            PG8_LDA(At, 0, 1); PG8_STAGE(PG8_SB(0, 0), b2, voffB); PG8_STAGE(PG8_SB(0, 1), b2 + hstep, voffB); PG8_STAGE(PG8_SA(0, 0), a2, voffA);
            PG8_WAIT_V(8); PG8_WAIT_L(0); PG8_BAR; PG8_MMA(1, 0, At, B0); PG8_MMA(1, 1, At, B1); PG8_BAR; PG8_SCHED;
            PG8_LDB(B0, 1, 0); PG8_LDB(B1, 1, 1); PG8_SCHED; PG8_LDA(At, 1, 0); PG8_STAGE(PG8_SA(0, 1), a2 + hstep, voffA);
            PG8_WAIT_V(8); PG8_WAIT_L(0); PG8_BAR; PG8_MMA(0, 0, At, B0); PG8_MMA(0, 1, At, B1); PG8_BAR; PG8_SCHED;
            PG8_LDA(At, 1, 1); PG8_STAGE(PG8_SB(1, 0), b3, voffB); PG8_STAGE(PG8_SB(1, 1), b3 + hstep, voffB); PG8_STAGE(PG8_SA(1, 0), a3, voffA);
            PG8_WAIT_V(8); PG8_WAIT_L(0); PG8_BAR; PG8_MMA(1, 0, At, B0); PG8_MMA(1, 1, At, B1); PG8_BAR; PG8_SCHED;
            } else {
            PG8_LDB(B0, 0, 0); PG8_SCHED; PG8_LDA(At, 0, 0); PG8_STAGE(PG8_SA(1, 1), a1 + hstep, voffA);
            PG8_WAIT_L(8); PG8_BAR; PG8_WAIT_L(0); PG8_MMA(0, 0, At, B0); PG8_BAR; PG8_SCHED;
            PG8_LDB(B1, 0, 1); PG8_STAGE(PG8_SB(0, 0), b2, voffB);
            PG8_BAR; PG8_WAIT_L(0); PG8_MMA(0, 1, At, B1); PG8_BAR;
            PG8_LDA(At, 0, 1); PG8_STAGE(PG8_SA(0, 0), a2, voffA);
            PG8_BAR; PG8_WAIT_L(0); PG8_MMA(1, 0, At, B0); PG8_BAR; PG8_SCHED;
            PG8_STAGE(PG8_SB(0, 1), b2 + hstep, voffB);
            PG8_WAIT_V(6); PG8_BAR; PG8_MMA(1, 1, At, B1); PG8_BAR;
            PG8_LDB(B0, 1, 0); PG8_SCHED; PG8_LDA(At, 1, 0); PG8_STAGE(PG8_SA(0, 1), a2 + hstep, voffA);
            PG8_WAIT_L(8); PG8_BAR; PG8_WAIT_L(0); PG8_MMA(0, 0, At, B0); PG8_BAR; PG8_SCHED;
            PG8_LDB(B1, 1, 1); PG8_STAGE(PG8_SB(1, 0), b3, voffB);
            PG8_BAR; PG8_WAIT_L(0); PG8_MMA(0, 1, At, B1); PG8_BAR;
            PG8_LDA(At, 1, 1); PG8_STAGE(PG8_SA(1, 0), a3, voffA);
            PG8_BAR; PG8_WAIT_L(0); PG8_MMA(1, 0, At, B0); PG8_BAR; PG8_SCHED;
            PG8_STAGE(PG8_SB(1, 1), b3 + hstep, voffB);
            PG8_WAIT_V(6); PG8_BAR; PG8_MMA(1, 1, At, B1); PG8_BAR;
            }
        }
        if constexpr (ALIGN_EPI) { if (wr == 0) PG8_BAR; }
        { int fr_e = fr, fq_e = fq; asm volatile("" : "+v"(fr_e), "+v"(fq_e));
          E(acc, cur, wr, wc, fr_e, fq_e); }
        if (!has_next) break;
        if (!E.keep(cur)) {
#pragma unroll
        for (int a = 0; a < 2; ++a)
#pragma unroll
            for (int b = 0; b < 2; ++b)
#pragma unroll
                for (int m = 0; m < 4; ++m)
#pragma unroll
                    for (int n = 0; n < 2; ++n) acc[a][b][m][n] = (f32x4){0.f, 0.f, 0.f, 0.f};
        }
        cur = nxt; cA = nA; cB = nB; ++ui;
        if constexpr (ALIGN_EPI) { if (wr == 1) PG8_BAR; }
    }
    PG8_WAIT_V(0);
    if constexpr (!ALIGN_EPI) { if (wr == 0) PG8_BAR; }
    PG8_BAR;
#undef PG8_SA
#undef PG8_SB
#undef PG8_STAGE
#undef PG8_LDA
#undef PG8_LDB
#undef PG8_MMA
#undef PG8_WAIT_V
#undef PG8_WAIT_L
#undef PG8_BAR
#undef PG8_SCHED
}
}
namespace fk {
using pg8::Unit; using pg8::bf16_t;
typedef float f32x16 __attribute__((ext_vector_type(16)));
typedef float f32x8v __attribute__((ext_vector_type(8)));
typedef short s16x4 __attribute__((ext_vector_type(4)));
typedef unsigned u32x4 __attribute__((ext_vector_type(4)));
typedef unsigned u32x2 __attribute__((ext_vector_type(2)));
constexpr int NWAVES = 8;
constexpr int M = 10240, MP = 8192, MS = 2048, DM = 2048, NIN = 9216, FF = 5632, NGU = 11264, SBW = 1024;
constexpr float EPS = 1e-6f;
constexpr float QSCALE = 1.4426950408889634f * 0.08838834764831845f;
constexpr size_t OUT_Y = 0, OUT_KP = 20971520, OUT_VP = 37748736, OUT_KS = 54525952, OUT_VS = 58720256, OUT_SG = 62914560, OUT_N = 67108864;
constexpr size_t MiB = 1u << 20;
constexpr size_t W_CTL = 0, CTL_ZERO_BYTES = 1 * MiB;
constexpr size_t W_WL = 1 * MiB, WL_STRIDE = 118 * MiB;
constexpr size_t WL_IN = 0, WL_A = 36 * MiB, WL_B = 40 * MiB, WL_OUT = 44 * MiB, WL_GU = 52 * MiB, WL_D = 96 * MiB;
constexpr size_t W_WM = 237 * MiB;
constexpr size_t W_HB = 238 * MiB, W_SS = 278 * MiB, W_Q = 280 * MiB, W_K = 300 * MiB, W_V = 320 * MiB, W_U = 340 * MiB, W_VS = 360 * MiB, W_G = 400 * MiB,
                 W_ATT = 480 * MiB, W_BB = 500 * MiB, W_MG = 520 * MiB, W_ACT = 560 * MiB, W_SLAB = 670 * MiB  , W_END = 734 * MiB;
constexpr size_t W_SSV = W_SS + 1280 * 1024;
constexpr int CW_TMO = 0, CW_BAR = 4096;
constexpr int RING_BYTES = 131072, LDSCTL_OFF = RING_BYTES, MISC_OFF = LDSCTL_OFF + 320, LDS_BYTES = 147456;

#define GAS __attribute__((address_space(1)))
#define LAS __attribute__((address_space(3)))
typedef unsigned short bf16;
typedef unsigned v4u __attribute__((ext_vector_type(4)));
typedef float f32x4 __attribute__((ext_vector_type(4)));
typedef short bf16x8 __attribute__((ext_vector_type(8)));
typedef GAS unsigned gu32;
typedef GAS unsigned long long gu64;
#define RLX_AGENT __ATOMIC_RELAXED, __HIP_MEMORY_SCOPE_AGENT
#define LDS_WAIT() asm volatile("s_waitcnt lgkmcnt(0)" ::: "memory")
#define VM_WAIT() asm volatile("s_waitcnt vmcnt(0)" ::: "memory")
__device__ __forceinline__ unsigned long long rt() { return __builtin_amdgcn_s_memrealtime(); }
__device__ __forceinline__ unsigned f2bf(float f) { unsigned u = __builtin_bit_cast(unsigned, f); return (u + 0x7fffu + ((u >> 16) & 1u)) >> 16; }
__device__ __forceinline__ unsigned pk2(float lo, float hi) { return f2bf(lo) | (f2bf(hi) << 16); }
#define XB_TMO      128
#define XB_XCNT(j)  (256  + 64 * (j))
#define XB_XSUB(j)  (1280 + 64 * (j))
#define XB_XGEN(j)  (2304 + 64 * (j))
#define XB_TOP      3328
#define XB_TOPGEN   3392
#define XCD_BAR_WORDS 3456
#define XB_SPIN_CAP (1u << 18)

__device__ __forceinline__ unsigned xb_ld(unsigned* p)              { return __hip_atomic_load(p, __ATOMIC_RELAXED, __HIP_MEMORY_SCOPE_AGENT); }
__device__ __forceinline__ unsigned xb_add(unsigned* p, unsigned v) { return __hip_atomic_fetch_add(p, v, __ATOMIC_RELAXED, __HIP_MEMORY_SCOPE_AGENT); }
__device__ __forceinline__ unsigned xb_xcc_id() { return (unsigned)__builtin_amdgcn_s_getreg((3 << 11) | 20) & 0xFu; }
#define XB_SPIN(cond, bar) do { unsigned _sp = 0; while (cond) { __builtin_amdgcn_s_sleep(1); \
    if ((++_sp & 255u) == 0u) { if (xb_ld(&(bar)[XB_TMO])) break; if (_sp > XB_SPIN_CAP) { atomicAdd(&(bar)[XB_TMO], 1u); break; } } } } while (0)

struct XcdBarrier {
    unsigned* bar; unsigned x;
    volatile LAS unsigned* st;
};

__device__ __forceinline__ XcdBarrier xcd_barrier_post(unsigned* bar, volatile LAS unsigned* st) {
    XcdBarrier b; b.bar = bar; b.x = xb_xcc_id(); b.st = st;
    if (threadIdx.x == 0) (void)xb_add(&bar[XB_XCNT(b.x)], 1u);
    return b;
}
__device__ __forceinline__ void xcd_barrier_complete(unsigned* bar, unsigned x, unsigned& nloc, unsigned& nx) {
    const unsigned G = gridDim.x * gridDim.y * gridDim.z;
    unsigned sum, cnt, mine, sp = 0u;
    for (;;) {
        sum = 0u; cnt = 0u; mine = 0u;
#pragma unroll
        for (unsigned j = 0; j < 16; ++j) { const unsigned c = xb_ld(&bar[XB_XCNT(j)]); sum += c; cnt += (c > 0u) ? 1u : 0u; mine = (j == x) ? c : mine; }
        if (sum == G) break;
        __builtin_amdgcn_s_sleep(1);
        if ((++sp & 255u) == 0u) { if (xb_ld(&bar[XB_TMO])) break; if (sp > XB_SPIN_CAP) { atomicAdd(&bar[XB_TMO], 1u); break; } }
    }
    nloc = mine > 0u ? mine : 1u; nx = cnt > 0u ? cnt : 1u;
}

__device__ __forceinline__ void xcd_barrier(const XcdBarrier& b) {
    asm volatile("s_waitcnt vmcnt(0)" ::: "memory");
    __syncthreads();
    if (threadIdx.x == 0) {
        unsigned* bar = b.bar;
        __builtin_amdgcn_s_waitcnt(0);
        unsigned nloc = b.st[0], nx = b.st[1];
        if (nloc == 0u) { xcd_barrier_complete(bar, b.x, nloc, nx); b.st[0] = nloc; b.st[1] = nx; }
        const unsigned old = xb_add(&bar[XB_XSUB(b.x)], 1u);
        const unsigned gen = old / nloc;
        if (old + 1u == (gen + 1u) * nloc) {
            __builtin_amdgcn_fence(__ATOMIC_RELEASE, "agent");
            asm volatile("s_waitcnt vmcnt(0)" ::: "memory");
            const unsigned og = xb_add(&bar[XB_TOP], 1u);
            const unsigned tg = og / nx;
            if (og + 1u == (tg + 1u) * nx) xb_add(&bar[XB_TOPGEN], 1u);
            else XB_SPIN(xb_ld(&bar[XB_TOPGEN]) == tg, bar);
            __builtin_amdgcn_fence(__ATOMIC_ACQUIRE, "agent");
            xb_add(&bar[XB_XGEN(b.x)], 1u);
            asm volatile("s_waitcnt vmcnt(0)" ::: "memory");
        } else {
            XB_SPIN(xb_ld(&bar[XB_XGEN(b.x)]) == gen, bar);
            __builtin_amdgcn_fence(__ATOMIC_ACQUIRE, "agent");
            asm volatile("s_waitcnt vmcnt(0)" ::: "memory");
        }
    }
    __syncthreads();
}

struct Frame {
    LAS unsigned char* lds; volatile LAS unsigned* MISC; int tid, lane, wave, vcu, G;
    const float *xp, *xs, *ck, *cv, *nmix, *win, *bgate, *sgun, *wsp, *bsp, *wa, *wb, *wout, *nffn, *wgu, *wd, *nfin;
    float* out; unsigned char* ws;
};
__device__ __forceinline__ int opq(int x) { asm volatile("" : "+v"(x)); return x; }
__device__ __forceinline__ float bf2f_lo(unsigned w) { return __uint_as_float(w << 16); }
__device__ __forceinline__ float bf2f_hi(unsigned w) { return __uint_as_float(w & 0xffff0000u); }
typedef __bf16 bf16x2_t __attribute__((ext_vector_type(2)));
__device__ __forceinline__ unsigned cvtpk(float lo, float hi) { const bf16x2_t v = {(__bf16)lo, (__bf16)hi}; return __builtin_bit_cast(unsigned, v); }
__device__ __forceinline__ float fsig(float y) { return __builtin_amdgcn_rcpf(1.f + __builtin_amdgcn_exp2f(-1.4426950408889634f * y)); }
__device__ __forceinline__ float fgelu(float x) { const float t = x * (-2.3022081f + -0.10294324f * x * x); return x * __builtin_amdgcn_rcpf(1.f + __builtin_amdgcn_exp2f(t)); }
__device__ __forceinline__ float wave_sum(float v) {
#pragma unroll
    for (int o = 1; o < 64; o <<= 1) v += __shfl_xor(v, o);
    return v;
}
__device__ __forceinline__ void tile_of(int L, int nM, int nN, int& pm, int& pn) {
    const int nwg = nM * nN; int wgid = L; { const int q = nwg / 8, r = nwg % 8, xcd = wgid % 8, off = wgid / 8; wgid = (xcd < r ? xcd * (q + 1) : r * (q + 1) + (xcd - r) * q) + off; }
    const int nig = 8 * nN, gid = wgid / nig, fm = gid * 8, gsz = (nM - fm) < 8 ? (nM - fm) : 8;
    pm = fm + ((wgid % nig) % gsz); pn = (wgid % nig) / gsz;
}
struct SchedSimple {
    int nM, nN, G, c, K, KT; const char* A; const char* Bt;
    __device__ __forceinline__ bool next(int i, Unit& u) const { const int L = i * G + c; if (L >= nM * nN) return false; tile_of(L, nM, nN, u.pm, u.pn); u.br = 0; return true; }
    __device__ __forceinline__ int nt(const Unit&) const { return KT >> 6; }
    __device__ __forceinline__ const char* a_base(const Unit& u) const { return A + (size_t)u.pm * 512 * K; }
    __device__ __forceinline__ const char* b_base(const Unit& u) const { return Bt + (size_t)u.pn * 512 * K; }
};
constexpr int TAIL_T = 320, TAIL_F = 256, TAIL_NS = 4;
struct SchedTail {
    int nM, nN, G, c, K, KT; const char* A; const char* Bt;
    __device__ __forceinline__ bool next(int i, Unit& u) const {
        if (G == TAIL_F) { if (i > 1) return false; if (i == 0) { tile_of(c, nM, nN, u.pm, u.pn); u.br = 0; } else { tile_of(TAIL_F + (c >> 2), nM, nN, u.pm, u.pn); u.br = 1 + (c & 3); } return true; }
        const int L = i * G + c; if (L >= nM * nN) return false; tile_of(L, nM, nN, u.pm, u.pn); u.br = 0; return true; }
    __device__ __forceinline__ int nt(const Unit& u) const { return u.br ? (KT >> 8) : (KT >> 6); }
    __device__ __forceinline__ const char* a_base(const Unit& u) const { return A + (size_t)u.pm * 512 * K + (u.br ? (size_t)(u.br - 1) * (KT >> 2) * 2 : 0); }
    __device__ __forceinline__ const char* b_base(const Unit& u) const { return Bt + (size_t)u.pn * 512 * K + (u.br ? (size_t)(u.br - 1) * (KT >> 2) * 2 : 0); }
};
struct SchedBranch {
    int nM, nN, G, c, K, KT; const char *A0, *B0, *A1, *B1;
    __device__ __forceinline__ bool next(int i, Unit& u) const {
        if (G == TAIL_F) { if (i > 2) return false; if (i < 2) { tile_of(c, nM, nN, u.pm, u.pn); u.br = i; } else { tile_of(TAIL_F + (c >> 2), nM, nN, u.pm, u.pn); u.br = 2 + (c & 3); } return true; }
        const int L = (i >> 1) * G + c; if (L >= nM * nN) return false; tile_of(L, nM, nN, u.pm, u.pn); u.br = i & 1; return true; }
    __device__ __forceinline__ int nt(const Unit& u) const { return u.br < 2 ? (KT >> 6) : (KT >> 7); }
    __device__ __forceinline__ const char* a_base(const Unit& u) const { const int pr = u.br < 2 ? u.br : ((u.br - 2) >> 1); return (pr ? A1 : A0) + (size_t)u.pm * 512 * K + (u.br < 2 ? 0 : (size_t)((u.br - 2) & 1) * (KT >> 1) * 2); }
    __device__ __forceinline__ const char* b_base(const Unit& u) const { const int pr = u.br < 2 ? u.br : ((u.br - 2) >> 1); return (pr ? B1 : B0) + (size_t)u.pn * 512 * K + (u.br < 2 ? 0 : (size_t)((u.br - 2) & 1) * (KT >> 1) * 2); }
};
#define EPI_ROWS(ai, m) (u.pm * 256 + (ai) * 128 + wr * 64 + (m) * 16 + fr)
__device__ __forceinline__ void row_rstd(const float* SS, const Unit& u, int wr, int fr, int fq, float (&rs)[2][4]) {
#pragma unroll
    for (int ai = 0; ai < 2; ++ai)
#pragma unroll
        for (int m = 0; m < 4; ++m) { const f32x4* s = (const f32x4*)(SS + (size_t)EPI_ROWS(ai, m) * 32 + fq * 8); const f32x4 a = s[0], b = s[1];
            float t = ((a[0] + a[1]) + (a[2] + a[3])) + ((b[0] + b[1]) + (b[2] + b[3])); t += __shfl_xor(t, 16); t += __shfl_xor(t, 32);
            rs[ai][m] = __builtin_amdgcn_rsqf(t * (1.0f / 2048.0f) + EPS); }
}
__device__ __forceinline__ u32x4 pack8(const f32x4 v0, const f32x4 v1) { u32x4 w; w.x = cvtpk(v0[0], v0[1]); w.y = cvtpk(v0[2], v0[3]); w.z = cvtpk(v1[0], v1[1]); w.w = cvtpk(v1[2], v1[3]); return w; }
#ifdef DBG_GRAW
#define GATE_ACT(x) (x)
#else
#define GATE_ACT(x) fsig(x)
#endif
struct EpiIn {
    static constexpr bool PERM = true;
    const float* SS; bf16_t *Q, *Kb, *Vb, *U, *G; float* VS; const float* bgate; float *okp, *ovp, *oks, *ovs; float* SSV;
    __device__ __forceinline__ bool keep(const Unit&) const { return false; }
    __device__ __forceinline__ void operator()(f32x4 (&acc)[2][2][4][2], const Unit& u, int wr, int wc, int fr, int fq) const {
        float rs[2][4]; row_rstd(SS, u, wr, fr, fq, rs);
        const int colt = u.pn * 256, cl = wc * 32 + 8 * fq;
        if (colt < 1024) {
#pragma unroll
            for (int ai = 0; ai < 2; ++ai)
#pragma unroll
                for (int m = 0; m < 4; ++m) { const size_t row = EPI_ROWS(ai, m); const float sc = rs[ai][m] * QSCALE;
#pragma unroll
                    for (int bj = 0; bj < 2; ++bj) *(u32x4*)(Q + row * 1024 + colt + bj * 128 + cl) = pack8(acc[ai][bj][m][0] * sc, acc[ai][bj][m][1] * sc); }
        } else if (colt < 3072) {
            const bool isv = colt >= 2048; const int c0 = colt - (isv ? 2048 : 1024) + cl; bf16_t* B = isv ? Vb : Kb;
            float* O = (u.pm < 32) ? (isv ? ovp : okp) : ((isv ? ovs : oks) - (size_t)MP * 1024);
#pragma unroll
            for (int ai = 0; ai < 2; ++ai)
#pragma unroll
                for (int m = 0; m < 4; ++m) { const size_t row = EPI_ROWS(ai, m); const float sc = rs[ai][m];
#pragma unroll
                    for (int bj = 0; bj < 2; ++bj) { const f32x4 v0 = acc[ai][bj][m][0] * sc, v1 = acc[ai][bj][m][1] * sc; const size_t o = row * 1024 + c0 + bj * 128;
                        *(u32x4*)(B + o) = pack8(v0, v1); *(f32x4*)(O + o) = v0; *(f32x4*)(O + o + 4) = v1; } }
        } else if (colt < 5120) {
            const bool isvs = colt >= 4096; const int c0 = colt - (isvs ? 4096 : 3072) + cl;
#pragma unroll
            for (int ai = 0; ai < 2; ++ai)
#pragma unroll
                for (int m = 0; m < 4; ++m) { const size_t row = EPI_ROWS(ai, m); const float sc = rs[ai][m]; float q = 0.f;
#pragma unroll
                    for (int bj = 0; bj < 2; ++bj) { f32x4 v0 = acc[ai][bj][m][0] * sc, v1 = acc[ai][bj][m][1] * sc;
#pragma unroll
                        for (int j = 0; j < 4; ++j) { v0[j] = fgelu(v0[j]); v1[j] = fgelu(v1[j]); }
                        const size_t o = row * 1024 + c0 + bj * 128;
                        if (isvs) { *(f32x4*)(VS + o) = v0; *(f32x4*)(VS + o + 4) = v1;
                            q += ((v0[0] * v0[0] + v0[1] * v0[1]) + (v0[2] * v0[2] + v0[3] * v0[3])) + ((v1[0] * v1[0] + v1[1] * v1[1]) + (v1[2] * v1[2] + v1[3] * v1[3])); }
                        else *(u32x4*)(U + o) = pack8(v0, v1); }
                    if (isvs) { q += __shfl_xor(q, 16); q += __shfl_xor(q, 32); if (fq == 0) SSV[row * 16 + (u.pn - 16) * 4 + wc] = q; } }
        } else {
            const int c0 = colt - 5120 + cl;
#pragma unroll
            for (int bj = 0; bj < 2; ++bj) { const f32x4 b0 = *(const f32x4*)(bgate + c0 + bj * 128), b1 = *(const f32x4*)(bgate + c0 + bj * 128 + 4);
#pragma unroll
                for (int ai = 0; ai < 2; ++ai)
#pragma unroll
                    for (int m = 0; m < 4; ++m) { const size_t row = EPI_ROWS(ai, m); const float sc = rs[ai][m];
                        f32x4 v0 = acc[ai][bj][m][0] * sc + b0, v1 = acc[ai][bj][m][1] * sc + b1;
#pragma unroll
                        for (int j = 0; j < 4; ++j) { v0[j] = GATE_ACT(v0[j]); v1[j] = GATE_ACT(v1[j]); }
                        *(u32x4*)(G + row * 4096 + c0 + bj * 128) = pack8(v0, v1); } }
        }
    }
};
__device__ __forceinline__ void store_slab(float* slab, const f32x4 (&acc)[2][2][4][2], int wr, int wc, int fr, int fq) {
#pragma unroll
    for (int ai = 0; ai < 2; ++ai)
#pragma unroll
        for (int m = 0; m < 4; ++m) { float* rp = slab + (size_t)(ai * 128 + wr * 64 + m * 16 + fr) * 256 + wc * 32 + 8 * fq;
#pragma unroll
            for (int bj = 0; bj < 2; ++bj) { *(f32x4*)(rp + bj * 128) = acc[ai][bj][m][0]; *(f32x4*)(rp + bj * 128 + 4) = acc[ai][bj][m][1]; } }
}
struct EpiMerge {
    static constexpr bool PERM = true;
    const bf16_t* G; bf16_t* MG; float* slab;
    __device__ __forceinline__ bool keep(const Unit& u) const { return u.br == 0; }
    __device__ __forceinline__ void operator()(f32x4 (&acc)[2][2][4][2], const Unit& u, int wr, int wc, int fr, int fq) const {
        const int c0 = u.pn * 256 + wc * 32 + 8 * fq; const int pair = u.br < 2 ? u.br : ((u.br - 2) >> 1);
#pragma unroll
        for (int ai = 0; ai < 2; ++ai) {
            u32x4 gg[4][2], hh[4][2];
#pragma unroll
            for (int m = 0; m < 4; ++m)
#pragma unroll
                for (int bj = 0; bj < 2; ++bj) { const bf16_t* gp = G + (size_t)EPI_ROWS(ai, m) * 4096 + c0 + bj * 128; gg[m][bj] = *(const u32x4*)(gp + pair * 2048); if (u.br == 0) hh[m][bj] = *(const u32x4*)(gp + 2048); }
#pragma unroll
            for (int m = 0; m < 4; ++m) { const size_t row = EPI_ROWS(ai, m);
#pragma unroll
                for (int bj = 0; bj < 2; ++bj) { const int c = c0 + bj * 128; const u32x4 g = gg[m][bj];
                    f32x4 g0 = {bf2f_lo(g.x), bf2f_hi(g.x), bf2f_lo(g.y), bf2f_hi(g.y)}, g1 = {bf2f_lo(g.z), bf2f_hi(g.z), bf2f_lo(g.w), bf2f_hi(g.w)};
                    if (u.br == 0) {
                        const u32x4 h = hh[m][bj];
                        const f32x4 b0 = {bf2f_lo(h.x), bf2f_hi(h.x), bf2f_lo(h.y), bf2f_hi(h.y)}, b1 = {bf2f_lo(h.z), bf2f_hi(h.z), bf2f_lo(h.w), bf2f_hi(h.w)};
#pragma unroll
                        for (int j = 0; j < 4; ++j) { g0[j] *= __builtin_amdgcn_rcpf(fmaxf(b0[j], 1e-30f)); g1[j] *= __builtin_amdgcn_rcpf(fmaxf(b1[j], 1e-30f)); }
                    } else if (u.br == 1) {
#pragma unroll
                        for (int j = 0; j < 4; ++j) { g0[j] = fmaxf(g0[j], 1e-30f); g1[j] = fmaxf(g1[j], 1e-30f); }
                    }
                    acc[ai][bj][m][0] *= g0; acc[ai][bj][m][1] *= g1;
                    if (u.br == 1) *(u32x4*)(MG + row * 2048 + c) = pack8(acc[ai][bj][m][0], acc[ai][bj][m][1]); } }
        }
        if (u.br >= 2) store_slab(slab, acc, wr, wc, fr, fq);
    }
};
struct EpiRes {
    static constexpr bool PERM = true;
    const float* base_p; const float* base_s;
    float* H; bf16_t* HB; float* SS; int write_hb; float* slab;
    __device__ __forceinline__ bool keep(const Unit&) const { return false; }
    __device__ __forceinline__ void operator()(f32x4 (&acc)[2][2][4][2], const Unit& u, int wr, int wc, int fr, int fq) const {
        if (u.br) { store_slab(slab, acc, wr, wc, fr, fq); return; }
        const int c0 = u.pn * 256 + wc * 32 + 8 * fq; const float* bb = (u.pm < 32) ? base_p : (base_s - (size_t)MP * 2048);
#pragma unroll
        for (int ai = 0; ai < 2; ++ai) {
            f32x4 bv[4][2][2];
#pragma unroll
            for (int m = 0; m < 4; ++m)
#pragma unroll
                for (int bj = 0; bj < 2; ++bj) { const size_t o = (size_t)EPI_ROWS(ai, m) * 2048 + c0 + bj * 128; bv[m][bj][0] = *(const f32x4*)(bb + o); bv[m][bj][1] = *(const f32x4*)(bb + o + 4); }
#pragma unroll
            for (int m = 0; m < 4; ++m) { const size_t row = EPI_ROWS(ai, m); float q = 0.f;
#pragma unroll
                for (int bj = 0; bj < 2; ++bj) { const size_t o = row * 2048 + c0 + bj * 128;
                    const f32x4 h0 = bv[m][bj][0] + acc[ai][bj][m][0], h1 = bv[m][bj][1] + acc[ai][bj][m][1];
                    *(f32x4*)(H + o) = h0; *(f32x4*)(H + o + 4) = h1;
                    q += ((h0[0] * h0[0] + h0[1] * h0[1]) + (h0[2] * h0[2] + h0[3] * h0[3])) + ((h1[0] * h1[0] + h1[1] * h1[1]) + (h1[2] * h1[2] + h1[3] * h1[3]));
                    if (write_hb) *(u32x4*)(HB + o) = pack8(h0, h1); }
                q += __shfl_xor(q, 16); q += __shfl_xor(q, 32);
                if (fq == 0) SS[row * 32 + u.pn * 4 + wc] = q; }
        }
    }
};
struct EpiGU {
    static constexpr bool PERM = true;
    const float* SS; bf16_t* ACT;
    __device__ __forceinline__ bool keep(const Unit&) const { return false; }
    __device__ __forceinline__ void operator()(f32x4 (&acc)[2][2][4][2], const Unit& u, int wr, int wc, int fr, int fq) const {
        float rs[2][4]; row_rstd(SS, u, wr, fr, fq, rs);
        const int c0 = u.pn * 128 + wc * 32 + 8 * fq;
#pragma unroll
        for (int ai = 0; ai < 2; ++ai)
#pragma unroll
            for (int m = 0; m < 4; ++m) { const size_t row = EPI_ROWS(ai, m); const float sc = rs[ai][m]; f32x4 v0, v1;
#pragma unroll
                for (int j = 0; j < 4; ++j) { const float g0 = acc[ai][0][m][0][j] * sc, g1 = acc[ai][0][m][1][j] * sc;
                    v0[j] = g0 * fsig(g0) * (acc[ai][1][m][0][j] * sc); v1[j] = g1 * fsig(g1) * (acc[ai][1][m][1][j] * sc); }
                *(u32x4*)(ACT + row * 5632 + c0) = pack8(v0, v1); }
    }
};
__device__ __forceinline__ void p0_transpose_item(const float* W, int K, int N, const float* scale, bf16* WT, int drow0, int k0, int n0, LAS float* scr, int lane) {
    float v[32];
#pragma unroll
    for (int i = 0; i < 32; ++i) { const int kk = 2 * i + (lane >> 5); v[i] = W[(size_t)(k0 + kk) * N + n0 + (lane & 31)]; }
    if (scale) {
#pragma unroll
        for (int i = 0; i < 32; ++i) v[i] *= scale[k0 + 2 * i + (lane >> 5)]; }
#pragma unroll
    for (int i = 0; i < 32; ++i) scr[(2 * i + (lane >> 5)) * 33 + (lane & 31)] = v[i];
    LDS_WAIT(); asm volatile("" ::: "memory");
    const int c = lane & 7;
#pragma unroll
    for (int j = 0; j < 4; ++j) { const int n = (lane >> 3) + 8 * j; const LAS float* s = scr + (8 * c) * 33 + n;
        v4u o; o.x = pk2(s[0 * 33], s[1 * 33]); o.y = pk2(s[2 * 33], s[3 * 33]); o.z = pk2(s[4 * 33], s[5 * 33]); o.w = pk2(s[6 * 33], s[7 * 33]);
        *(GAS v4u*)(WT + (size_t)(drow0 + n) * K + k0 + 8 * c) = o; }
    LDS_WAIT(); asm volatile("" ::: "memory");
}
__device__ __forceinline__ void p0_prologue(Frame& F) {
    F.tid = opq(F.tid); F.lane = F.tid & 63;
    LAS float* scr = (LAS float*)(F.lds + F.wave * 16384);
    const int gw = F.vcu * NWAVES + F.wave, NGW = F.G * NWAVES;
    constexpr int I_IN = 32 * 288, I_A = 16 * 64, I_B = 16 * 64, I_O = 32 * 64, I_GU = 32 * 352, I_D = 88 * 64, I_L = I_IN + I_A + I_B + I_O + I_GU + I_D;
    for (int it = gw; it < 2 * I_L; it += NGW) {
        const int l = it / I_L; int r = it % I_L; unsigned char* wl = F.ws + W_WL + (size_t)l * WL_STRIDE;
        if (r < I_IN) { const int kb = r / 288, nb = r % 288; p0_transpose_item(F.win + (size_t)l * DM * NIN, DM, NIN, F.nmix + l * DM, (bf16*)(wl + WL_IN), nb * 32, kb * 64, nb * 32, scr, F.lane); continue; } r -= I_IN;
        if (r < I_A) { const int kb = r / 64, nb = r % 64; p0_transpose_item(F.wa + (size_t)l * 1024 * DM, 1024, DM, nullptr, (bf16*)(wl + WL_A), nb * 32, kb * 64, nb * 32, scr, F.lane); continue; } r -= I_A;
        if (r < I_B) { const int kb = r / 64, nb = r % 64; p0_transpose_item(F.wb + (size_t)l * 1024 * DM, 1024, DM, nullptr, (bf16*)(wl + WL_B), nb * 32, kb * 64, nb * 32, scr, F.lane); continue; } r -= I_B;
        if (r < I_O) { const int kb = r / 64, nb = r % 64; p0_transpose_item(F.wout + (size_t)l * DM * DM, DM, DM, nullptr, (bf16*)(wl + WL_OUT), nb * 32, kb * 64, nb * 32, scr, F.lane); continue; } r -= I_O;
        if (r < I_GU) { const int kb = r / 352, nb = r % 352; const int n0 = nb * 32; const int j0 = n0 < FF ? n0 : n0 - FF;
            const int drow = (j0 >> 7) * 256 + (n0 < FF ? 0 : 128) + (j0 & 127);
            p0_transpose_item(F.wgu + (size_t)l * DM * NGU, DM, NGU, F.nffn + l * DM, (bf16*)(wl + WL_GU), drow, kb * 64, n0, scr, F.lane); continue; } r -= I_GU;
        { const int kb = r / 64, nb = r % 64; p0_transpose_item(F.wd + (size_t)l * FF * DM, FF, DM, nullptr, (bf16*)(wl + WL_D), nb * 32, kb * 64, nb * 32, scr, F.lane); }
    }
    bf16* HB = (bf16*)(F.ws + W_HB); float* SS = (float*)(F.ws + W_SS);
    for (int m = gw; m < M; m += NGW) {
        const float* xr = (m < MP) ? F.xp + (size_t)m * DM : F.xs + (size_t)(m - MP) * DM; float q = 0.f;
#pragma unroll
        for (int j = 0; j < 8; ++j) { const f32x4 v = *(const f32x4*)(xr + j * 256 + F.lane * 4); q += (v[0] * v[0] + v[1] * v[1]) + (v[2] * v[2] + v[3] * v[3]);
            u32x2 w; w.x = cvtpk(v[0], v[1]); w.y = cvtpk(v[2], v[3]); *(u32x2*)(HB + (size_t)m * DM + j * 256 + F.lane * 4) = w; }
        q = wave_sum(q);
        if (F.lane < 32) SS[(size_t)m * 32 + F.lane] = F.lane == 0 ? q : 0.f;
    }
    bf16* WM = (bf16*)(F.ws + W_WM);
    for (int i = (F.vcu * NWAVES + F.wave) * 64 + F.lane; i < 2 * 2 * 8 * 128 * 128; i += NGW * 64) {
        const int s = i & 127, t = (i >> 7) & 127, g = (i >> 14) & 7, kind = (i >> 17) & 1, l = i >> 18;
        const float* w = F.wsp + ((size_t)l * 8 + g) * 16384; float v;
        if (kind == 0) v = ((s >> 6) <= (t >> 6)) ? w[t * 128 + s] : 0.f; else v = ((s >> 6) == (t >> 6)) ? w[(t & 63) * 128 + (s & 63)] : 0.f;
        WM[i] = (bf16)f2bf(v);
    }
}
template <int MODE>
__device__ __forceinline__ void p_fixup(Frame& F, const float* base_p, const float* base_s, int write_hb) {
    if (F.G != TAIL_F) return;
    const int tid = opq(F.tid), c = (int)blockIdx.x, q = c & 3; int pm, pn; tile_of(TAIL_F + (c >> 2), 40, 8, pm, pn);
    const float* slab = (const float*)(F.ws + W_SLAB) + (size_t)(c & ~3) * 65536;
    const int col = q * 64 + (tid & 15) * 4, gcol = pn * 256 + col; float* H = F.out + OUT_Y; bf16* HB = (bf16*)(F.ws + W_HB); bf16* MG = (bf16*)(F.ws + W_MG); float* SS = (float*)(F.ws + W_SS);
    const float* bb = (pm < 32) ? base_p : (base_s - (size_t)MP * 2048);
#pragma unroll
    for (int hb = 0; hb < 2; ++hb) { f32x4 s[4][4], bs[4];
#pragma unroll
        for (int i = 0; i < 4; ++i) { const int r = (tid >> 4) + 32 * (hb * 4 + i);
#pragma unroll
            for (int k = 0; k < 4; ++k) s[i][k] = *(const f32x4*)(slab + (size_t)k * 65536 + r * 256 + col);
            if (MODE == 0) bs[i] = *(const f32x4*)(bb + (size_t)(pm * 256 + r) * 2048 + gcol); }
#pragma unroll
        for (int i = 0; i < 4; ++i) { const int r = (tid >> 4) + 32 * (hb * 4 + i); const size_t o = (size_t)(pm * 256 + r) * 2048 + gcol;
            f32x4 v = (s[i][0] + s[i][1]) + (s[i][2] + s[i][3]);
            if (MODE == 0) { v = v + bs[i]; *(f32x4*)(H + o) = v; if (write_hb) { u32x2 w; w.x = cvtpk(v[0], v[1]); w.y = cvtpk(v[2], v[3]); *(u32x2*)(HB + o) = w; }
                float qq = (v[0] * v[0] + v[1] * v[1]) + (v[2] * v[2] + v[3] * v[3]); qq += __shfl_xor(qq, 1); qq += __shfl_xor(qq, 2); qq += __shfl_xor(qq, 4); qq += __shfl_xor(qq, 8);
                if ((tid & 15) == 0) SS[(size_t)(pm * 256 + r) * 32 + pn * 4 + q] = qq; }
            else { u32x2 w; w.x = cvtpk(v[0], v[1]); w.y = cvtpk(v[2], v[3]); *(u32x2*)(MG + o) = w; } } }
}
__device__ __forceinline__ void p_final(Frame& F, float dbg_scale_sample) {
    F.tid = opq(F.tid); F.lane = F.tid & 63;
    const int gw = F.vcu * NWAVES + F.wave, NGW = F.G * NWAVES; const float* SS = (const float*)(F.ws + W_SS);
    for (int m = gw; m < M; m += NGW) {
        float t = F.lane < 32 ? SS[(size_t)m * 32 + F.lane] : 0.f; t = wave_sum(t); float r = __builtin_amdgcn_rsqf(t * (1.0f / 2048.0f) + EPS); if (m >= MP) r *= dbg_scale_sample;
        float* h = F.out + OUT_Y + (size_t)m * DM;
#pragma unroll
        for (int j = 0; j < 8; ++j) { const int c = j * 256 + F.lane * 4; const f32x4 v = *(const f32x4*)(h + c), g = *(const f32x4*)(F.nfin + c); *(f32x4*)(h + c) = v * r * g; }
    }
}
constexpr int A_VOFF = 0, A_KOFF = 32768, A_TILE = 16384;
#define KSWZ(row, colB) ((row) * 256 + ((colB) ^ (((row) & 7) << 4)))
#define SBAR() __builtin_amdgcn_sched_barrier(0)
__device__ __forceinline__ int crow(int r, int hi) { return (r & 3) + 8 * (r >> 2) + 4 * hi; }
__device__ __forceinline__ int v_st(int k, int c) { const int kk = (k & ~0xC) | ((k & 4) << 1) | ((k & 8) >> 1); return ((kk >> 3) * 4 + (c >> 5)) * 512 + ((kk & 7) * 32 + (c & 31)) * 2; }
__device__ __forceinline__ int v_rd_base(int lane) { return ((lane & 3) << 3) | (((lane >> 2) & 3) << 6) | (((lane >> 4) & 1) << 5) | (((lane >> 5) & 1) << 8); }
constexpr int v_rd_off(int d0, int ks, int half) { return d0 * 512 + ks * 4096 + half * 2048; }
template <int OFF> __device__ __forceinline__ s16x4 tr_read(int vb) { s16x4 r; asm volatile("ds_read_b64_tr_b16 %0, %1 offset:%2" : "=&v"(r) : "v"(vb), "i"(OFF) : "memory"); return r; }
template <int D0> __device__ __forceinline__ void pv_one(f32x16& od, int vb, bf16x8 pa0, bf16x8 pa1, bf16x8 pa2, bf16x8 pa3) {
    const s16x4 l0 = tr_read<v_rd_off(D0, 0, 0)>(vb), h0 = tr_read<v_rd_off(D0, 0, 1)>(vb), l1 = tr_read<v_rd_off(D0, 1, 0)>(vb), h1 = tr_read<v_rd_off(D0, 1, 1)>(vb);
    const s16x4 l2 = tr_read<v_rd_off(D0, 2, 0)>(vb), h2 = tr_read<v_rd_off(D0, 2, 1)>(vb), l3 = tr_read<v_rd_off(D0, 3, 0)>(vb), h3 = tr_read<v_rd_off(D0, 3, 1)>(vb);
    asm volatile("s_waitcnt lgkmcnt(0)" ::: "memory"); SBAR();
#define PK(L, H) (bf16x8){L[0], L[1], L[2], L[3], H[0], H[1], H[2], H[3]}
    od = __builtin_amdgcn_mfma_f32_32x32x16_bf16(pa0, PK(l0, h0), od, 0, 0, 0);
    od = __builtin_amdgcn_mfma_f32_32x32x16_bf16(pa1, PK(l1, h1), od, 0, 0, 0);
    od = __builtin_amdgcn_mfma_f32_32x32x16_bf16(pa2, PK(l2, h2), od, 0, 0, 0);
    od = __builtin_amdgcn_mfma_f32_32x32x16_bf16(pa3, PK(l3, h3), od, 0, 0, 0);
#undef PK
}
__device__ __forceinline__ void qkt(f32x16& p0, f32x16& p1, const LAS unsigned char* Ks, const bf16x8 (&qr)[8], int r32, int hi) {
    p0 = f32x16{}; p1 = f32x16{};
#pragma unroll
    for (int d0 = 0; d0 < 8; ++d0) { const int cb = (d0 * 16 + hi * 8) * 2;
        const bf16x8 b0 = *(const LAS bf16x8*)(Ks + KSWZ(r32, cb)); const bf16x8 b1 = *(const LAS bf16x8*)(Ks + KSWZ(32 + r32, cb));
        p0 = __builtin_amdgcn_mfma_f32_32x32x16_bf16(b0, qr[d0], p0, 0, 0, 0); p1 = __builtin_amdgcn_mfma_f32_32x32x16_bf16(b1, qr[d0], p1, 0, 0, 0); }
}
__device__ __forceinline__ void sb_half(f32x16& p, float& R, int hi, bool need_mask, int kpos0, int qpos) {
    f32x16 st;
#pragma unroll
    for (int r = 0; r < 16; ++r) { const float zz = fmaxf(p[r], -120.f); const float e = __builtin_amdgcn_exp2f(-zz); float bt = __builtin_amdgcn_rcpf(1.f + e); float s = e * bt;
        if (need_mask) { const bool valid = (kpos0 + crow(r, hi)) < qpos; s = valid ? s : 1.f; bt = valid ? bt : 0.f; }
        p[r] = bt; st[r] = s; }
    float x1[4], x2[4], x3[4], c[4], f[4];
#pragma unroll
    for (int q = 0; q < 4; ++q) { x3[q] = st[4 * q + 3]; x2[q] = x3[q] * st[4 * q + 2]; x1[q] = x2[q] * st[4 * q + 1]; const float pq = x1[q] * st[4 * q];
        const auto rr = __builtin_amdgcn_permlane32_swap(__float_as_uint(pq), __float_as_uint(pq), false, false);
        const float v0 = __uint_as_float(rr[0]), v1 = __uint_as_float(rr[1]); c[q] = v0 * v1; f[q] = hi ? 1.f : v1; }
    const float S3 = R, S2 = S3 * c[3], S1 = S2 * c[2], S0 = S1 * c[1]; R = S0 * c[0];
    R = R < 7.8886e-31f ? 0.f : R;
    const float T[4] = {S0 * f[0], S1 * f[1], S2 * f[2], S3 * f[3]};
#pragma unroll
    for (int q = 0; q < 4; ++q) { p[4 * q + 3] *= T[q]; p[4 * q + 2] *= T[q] * x3[q]; p[4 * q + 1] *= T[q] * x2[q]; p[4 * q] *= T[q] * x1[q]; }
}
#define PK4(P, BASE, OUT) do { const unsigned a0 = cvtpk(P[BASE + 0], P[BASE + 1]), a1 = cvtpk(P[BASE + 2], P[BASE + 3]);   \
    const unsigned b0 = cvtpk(P[BASE + 4], P[BASE + 5]), b1 = cvtpk(P[BASE + 6], P[BASE + 7]);                              \
    const auto r0 = __builtin_amdgcn_permlane32_swap(a0, b0, false, false); const auto r1 = __builtin_amdgcn_permlane32_swap(a1, b1, false, false); \
    u32x4 w_ = {r0[0], r1[0], r0[1], r1[1]}; OUT = *reinterpret_cast<bf16x8*>(&w_); } while (0)
template <bool SAMPLE>
__device__ __forceinline__ void attn_unit(Frame& F, int l, int b, int h, int qb) {
    const int tid = opq(F.tid), wid = F.wave, lane = tid & 63, r32 = lane & 31, hi = lane >> 5;
    const LAS unsigned char* Kl = F.lds + A_KOFF; LAS unsigned char* Vl = F.lds + A_VOFF;
    const bool active = SAMPLE ? (wid < 2) : true;
    const int nt = SAMPLE ? 33 : 4 * qb + 4;
    const int wrow_lo = SAMPLE ? 2048 + 32 * wid : 256 * qb + 32 * wid;
    const int qpos = wrow_lo + r32;
    const size_t qrow = SAMPLE ? (size_t)(MP + b * 64 + 32 * wid + r32) : (size_t)(b * 2048 + qpos);
    const bf16* Qp = (const bf16*)(F.ws + W_Q) + qrow * 1024 + h * 128 + hi * 8;
    bf16x8 qr[8];
    if (active) {
#pragma unroll
        for (int d0 = 0; d0 < 8; ++d0) qr[d0] = *(const bf16x8*)(Qp + d0 * 16);
    } else {
#pragma unroll
        for (int d0 = 0; d0 < 8; ++d0) qr[d0] = bf16x8{};
    }
    f32x16 o[4] = {}; float R = 1.f;
    const int sr = tid >> 4, sc = (tid & 15) * 8, vst0 = v_st(sr, sc), vst1 = v_st(32 + sr, sc);
    const int vb0 = (int)(unsigned)(uintptr_t)Vl + v_rd_base(lane);
    const bf16* Kb = (const bf16*)(F.ws + W_K); const bf16* Vb = (const bf16*)(F.ws + W_V);
    const float* nk = F.out + OUT_KS + ((size_t)(l * 32 + b) * 64) * 1024 + h * 128; const float* nv = F.out + OUT_VS + ((size_t)(l * 32 + b) * 64) * 1024 + h * 128;
    const float* ckb = F.ck + ((size_t)(l * 32 + b) * 2048) * 1024 + h * 128; const float* cvb = F.cv + ((size_t)(l * 32 + b) * 2048) * 1024 + h * 128;
#define TILE_POS(j) (SAMPLE ? ((j) == 0 ? 2048 : 2048 - 64 * (j)) : 64 * (nt - 1 - (j)))
    f32x8v fk0, fk1, fv0, fv1; bf16x8 bk0, bk1, bv0, bv1;
#define SLOAD(j) do { if constexpr (SAMPLE) { const float* kp = (j) == 0 ? nk : ckb + (size_t)(2048 - 64 * (j)) * 1024; const float* vp = (j) == 0 ? nv : cvb + (size_t)(2048 - 64 * (j)) * 1024; \
        fk0 = *(const f32x8v*)(kp + (size_t)sr * 1024 + sc); fk1 = *(const f32x8v*)(kp + (size_t)(32 + sr) * 1024 + sc); fv0 = *(const f32x8v*)(vp + (size_t)sr * 1024 + sc); fv1 = *(const f32x8v*)(vp + (size_t)(32 + sr) * 1024 + sc); } \
    else { const size_t ro = ((size_t)(b * 2048 + TILE_POS(j) + sr)) * 1024 + h * 128 + sc; bk0 = *(const bf16x8*)(Kb + ro); bk1 = *(const bf16x8*)(Kb + ro + 32 * 1024); bv0 = *(const bf16x8*)(Vb + ro); bv1 = *(const bf16x8*)(Vb + ro + 32 * 1024); } } while (0)
#define TOBF(x) ({ u32x4 w__ = {cvtpk(x[0], x[1]), cvtpk(x[2], x[3]), cvtpk(x[4], x[5]), cvtpk(x[6], x[7])}; *reinterpret_cast<bf16x8*>(&w__); })
#define SWRITE(bufi) do { LAS unsigned char* vd = Vl + (bufi) * A_TILE; LAS unsigned char* kd = (LAS unsigned char*)Kl + (bufi) * A_TILE; const int kc = sc * 2; \
        if constexpr (SAMPLE) { *(LAS bf16x8*)(vd + vst0) = TOBF(fv0); *(LAS bf16x8*)(vd + vst1) = TOBF(fv1); *(LAS bf16x8*)(kd + KSWZ(sr, kc)) = TOBF(fk0); *(LAS bf16x8*)(kd + KSWZ(32 + sr, kc)) = TOBF(fk1); } \
        else { *(LAS bf16x8*)(vd + vst0) = bv0; *(LAS bf16x8*)(vd + vst1) = bv1; *(LAS bf16x8*)(kd + KSWZ(sr, kc)) = bk0; *(LAS bf16x8*)(kd + KSWZ(32 + sr, kc)) = bk1; } } while (0)
    volatile LAS unsigned* dflag = F.MISC + 16;
    SLOAD(0); asm volatile("s_waitcnt vmcnt(0)" ::: "memory"); SWRITE(0); __syncthreads();
    for (int j = 0; j < nt; ++j) {
        if (j > 0) {
            unsigned alld = 1u;
#pragma unroll
            for (int w = 0; w < 8; ++w) alld &= dflag[((j - 1) & 1) * 8 + w];
            if (alld) break;
        }
        if (j + 1 < nt) SLOAD(j + 1);
        const int kpos0 = TILE_POS(j);
        if (active && kpos0 < wrow_lo + 31) {
            f32x16 p0, p1; bf16x8 pa0, pa1, pa2, pa3;
            qkt(p0, p1, Kl + (j & 1) * A_TILE, qr, r32, hi);
            const bool need_mask = !(kpos0 + 63 < wrow_lo);
            sb_half(p1, R, hi, need_mask, kpos0 + 32, qpos);
            sb_half(p0, R, hi, need_mask, kpos0, qpos);
            PK4(p0, 0, pa0); PK4(p0, 8, pa1); PK4(p1, 0, pa2); PK4(p1, 8, pa3);
            const int vb = vb0 + (j & 1) * A_TILE;
            pv_one<0>(o[0], vb, pa0, pa1, pa2, pa3); pv_one<1>(o[1], vb, pa0, pa1, pa2, pa3); pv_one<2>(o[2], vb, pa0, pa1, pa2, pa3); pv_one<3>(o[3], vb, pa0, pa1, pa2, pa3);
        }
        { const bool wdone = !active || __all(R == 0.f); if (lane == 0) dflag[(j & 1) * 8 + wid] = wdone ? 1u : 0u; }
        if (j + 1 < nt) { asm volatile("s_waitcnt vmcnt(0)" ::: "memory"); SWRITE((j + 1) & 1); }
        __syncthreads();
    }
    if (active) {
        bf16* Ow = (bf16*)(F.ws + W_ATT) + (SAMPLE ? (size_t)(MP + b * 64 + 32 * wid) : (size_t)(b * 2048 + wrow_lo)) * 1024 + h * 128 + r32;
#pragma unroll
        for (int r = 0; r < 16; ++r) { const int orow = crow(r, hi);
#pragma unroll
            for (int d0 = 0; d0 < 4; ++d0) Ow[(size_t)orow * 1024 + d0 * 32] = (bf16)f2bf(o[d0][r]); }
    }
#undef SLOAD
#undef SWRITE
#undef TILE_POS
}
__device__ __forceinline__ void sgu_unit(Frame& F, int l, int tile, int g) {
    const int tid = opq(F.tid), wid = F.wave, lane = tid & 63, r32 = lane & 31, hi = lane >> 5;
    const int row0 = tile * 128; const bool samp = row0 >= MP;
    const float* VS = (const float*)(F.ws + W_VS); const float* SSV = (const float*)(F.ws + W_SSV); const bf16* U = (const bf16*)(F.ws + W_U); bf16* BB = (bf16*)(F.ws + W_BB);
    const bf16* WM = (const bf16*)(F.ws + W_WM) + ((size_t)(l * 2 + (samp ? 1 : 0)) * 8 + g) * 16384;
    const int sr = tid >> 4, sc = (tid & 15) * 8, rg = wid & 3, ch = wid >> 2;
    f32x8v vv[4]; f32x4 sl[4][4];
#pragma unroll
    for (int i = 0; i < 4; ++i) { const size_t grow = (size_t)(row0 + sr + 32 * i); vv[i] = *(const f32x8v*)(VS + grow * 1024 + g * 128 + sc);
#pragma unroll
        for (int j = 0; j < 4; ++j) sl[i][j] = *(const f32x4*)(SSV + grow * 16 + j * 4); }
    const f32x8v gv = *(const f32x8v*)(F.sgun + l * 1024 + g * 128 + sc);
    const bf16* wrow = WM + ((size_t)(rg * 32 + r32)) * 128 + hi * 8;
    bf16x8 pa[2][4];
#pragma unroll
    for (int kt = 0; kt < 2; ++kt)
#pragma unroll
        for (int ks = 0; ks < 4; ++ks) pa[kt][ks] = *(const bf16x8*)(wrow + kt * 64 + ks * 16);
    unsigned short uu[16][2]; float bias[16];
#pragma unroll
    for (int r = 0; r < 16; ++r) { const int t = rg * 32 + crow(r, hi); bias[r] = F.bsp[l * 1024 + g * 128 + (samp ? (t & 63) : t)];
#pragma unroll
        for (int i = 0; i < 2; ++i) uu[r][i] = U[(size_t)(row0 + t) * 1024 + g * 128 + (2 * ch + i) * 32 + r32]; }
    float* sgo = F.out + OUT_SG + ((size_t)l * MS) * 1024;
#pragma unroll
    for (int i = 0; i < 4; ++i) { const int s = sr + 32 * i; const size_t grow = (size_t)(row0 + s);
        float q = 0.f;
#pragma unroll
        for (int j = 0; j < 4; ++j) q += (sl[i][j][0] + sl[i][j][1]) + (sl[i][j][2] + sl[i][j][3]);
        const float rr = __builtin_amdgcn_rsqf(q * (1.0f / 1024.0f) + EPS); f32x8v v = vv[i];
#pragma unroll
        for (int j = 0; j < 8; ++j) v[j] = v[j] * rr * gv[j];
        if (samp) *(f32x8v*)(sgo + (grow - MP) * 1024 + g * 128 + sc) = v;
        u32x4 w = {cvtpk(v[0], v[1]), cvtpk(v[2], v[3]), cvtpk(v[4], v[5]), cvtpk(v[6], v[7])};
        *(LAS u32x4*)(F.lds + (s >> 6) * A_TILE + v_st(s & 63, sc)) = w; }
    __syncthreads();
    const int vb0 = (int)(unsigned)(uintptr_t)F.lds + v_rd_base(lane);
    f32x16 o2[2] = {};
#pragma unroll
    for (int kt = 0; kt < 2; ++kt) { const int vb = vb0 + kt * A_TILE;
        if (ch == 0) { pv_one<0>(o2[0], vb, pa[kt][0], pa[kt][1], pa[kt][2], pa[kt][3]); pv_one<1>(o2[1], vb, pa[kt][0], pa[kt][1], pa[kt][2], pa[kt][3]); }
        else { pv_one<2>(o2[0], vb, pa[kt][0], pa[kt][1], pa[kt][2], pa[kt][3]); pv_one<3>(o2[1], vb, pa[kt][0], pa[kt][1], pa[kt][2], pa[kt][3]); } }
#pragma unroll
    for (int r = 0; r < 16; ++r) { const int t = rg * 32 + crow(r, hi);
#pragma unroll
        for (int i = 0; i < 2; ++i) { const size_t off = (size_t)(row0 + t) * 1024 + g * 128 + (2 * ch + i) * 32 + r32;
            BB[off] = (bf16)f2bf(__uint_as_float(((unsigned)uu[r][i]) << 16) * (o2[i][r] + bias[r])); } }
    __syncthreads();
}
constexpr int N_PHASES = 20, PH_L = 9, PH_FINAL = 19;
struct Args { const float* in[17]; float* out; unsigned char* ws; int ph_lo, ph_hi, li, pad; };
__global__ void __launch_bounds__(NWAVES * 64, 2) mk_fwd(Args args) {
    extern __shared__ __attribute__((aligned(16))) unsigned char lds_raw[];
    Frame F;
    F.lds = (LAS unsigned char*)lds_raw; F.MISC = (volatile LAS unsigned*)(F.lds + MISC_OFF);
    F.tid = threadIdx.x; F.lane = F.tid & 63; F.wave = __builtin_amdgcn_readfirstlane(F.tid >> 6);
    F.G = gridDim.x; { const int bx = blockIdx.x; F.vcu = (F.G % 8 == 0) ? (bx % 8) * (F.G / 8) + bx / 8 : bx; }
    F.xp = args.in[0]; F.xs = args.in[1]; F.ck = args.in[2]; F.cv = args.in[3]; F.nmix = args.in[4]; F.win = args.in[5]; F.bgate = args.in[6]; F.sgun = args.in[7]; F.wsp = args.in[8]; F.bsp = args.in[9];
    F.wa = args.in[10]; F.wb = args.in[11]; F.wout = args.in[12]; F.nffn = args.in[13]; F.wgu = args.in[14]; F.wd = args.in[15]; F.nfin = args.in[16];
    F.out = args.out; F.ws = args.ws;
    for (int u = F.tid; u < (LDS_BYTES - LDSCTL_OFF) / 4; u += NWAVES * 64) ((LAS unsigned*)(F.lds + LDSCTL_OFF))[u] = 0u;
    __syncthreads();
    gu32* ctl = (gu32*)(F.ws + W_CTL);
    XcdBarrier bar = xcd_barrier_post((unsigned*)(ctl + CW_BAR) + args.li * XCD_BAR_WORDS, F.MISC + 8);
    const int lo = args.ph_lo, hi = args.ph_hi;
#define IN(k) (lo <= (k) && (k) < hi)
#ifdef TIMING
#define STAMP(k) do { if (blockIdx.x == 0 && F.tid == 0) __hip_atomic_store((gu64*)(ctl + 2048) + (k), (unsigned long long)wall_clock64(), RLX_AGENT); } while (0)
#else
#define STAMP(k) do { } while (0)
#endif
#define SEAM(k) do { if (IN(k) && IN((k) + 1)) xcd_barrier(bar); STAMP((k) + 1); } while (0)
    unsigned char* ws = F.ws;
    bf16_t* HB = (bf16_t*)(ws + W_HB); float* SS = (float*)(ws + W_SS); float* H = F.out + OUT_Y; float* myslab = (float*)(ws + W_SLAB) + (size_t)blockIdx.x * 65536;
    STAMP(0);
    if (IN(0)) p0_prologue(F);
    SEAM(0);
    for (int l = 0; l < 2; ++l) {
        const int pb = 1 + PH_L * l; unsigned char* wl = ws + W_WL + (size_t)l * WL_STRIDE;
        if (IN(pb)) {
            SchedSimple S{40, 36, F.G, (int)blockIdx.x, 2048, 2048, (const char*)HB, (const char*)(wl + WL_IN)};
            EpiIn E{SS, (bf16_t*)(ws + W_Q), (bf16_t*)(ws + W_K), (bf16_t*)(ws + W_V), (bf16_t*)(ws + W_U), (bf16_t*)(ws + W_G), (float*)(ws + W_VS), F.bgate + l * 4096,
                    F.out + OUT_KP + (size_t)l * MP * 1024, F.out + OUT_VP + (size_t)l * MP * 1024, F.out + OUT_KS + (size_t)l * MS * 1024, F.out + OUT_VS + (size_t)l * MS * 1024, (float*)(ws + W_SSV)};
            pg8::gemm_phase<EpiIn, SchedSimple>(F.lds, S, E);
        }
        SEAM(pb);
        if (IN(pb + 1)) {
            const int c = F.vcu;
            for (int pu = c; pu < 256; pu += F.G) { const int qb = 7 - (pu >> 5), bh = pu & 31; attn_unit<false>(F, l, bh >> 3, bh & 7, qb); }
            for (int su = c; su < 256; su += F.G) attn_unit<true>(F, l, su >> 3, su & 7, 0);
            for (int tu = c; tu < 640; tu += F.G) sgu_unit(F, l, tu >> 3, tu & 7);
        }
        SEAM(pb + 1);
        if (IN(pb + 2)) {
            SchedBranch S{40, 8, F.G, (int)blockIdx.x, 1024, 1024, (const char*)(ws + W_ATT), (const char*)(wl + WL_A), (const char*)(ws + W_BB), (const char*)(wl + WL_B)};
            EpiMerge E{(const bf16_t*)(ws + W_G), (bf16_t*)(ws + W_MG), myslab};
            pg8::gemm_phase<EpiMerge, SchedBranch>(F.lds, S, E);
        }
        SEAM(pb + 2);
        if (IN(pb + 3)) p_fixup<1>(F, nullptr, nullptr, 0);
        SEAM(pb + 3);
        const float* base_p = l == 0 ? F.xp : (const float*)H; const float* base_s = l == 0 ? F.xs : (const float*)(H + (size_t)MP * 2048);
        if (IN(pb + 4)) {
            SchedTail S{40, 8, F.G, (int)blockIdx.x, 2048, 2048, (const char*)(ws + W_MG), (const char*)(wl + WL_OUT)};
            EpiRes E{base_p, base_s, H, HB, SS, 1, myslab};
            pg8::gemm_phase<EpiRes, SchedTail>(F.lds, S, E);
        }
        SEAM(pb + 4);
        if (IN(pb + 5)) p_fixup<0>(F, base_p, base_s, 1);
        SEAM(pb + 5);
        if (IN(pb + 6)) {
            SchedSimple S{40, 44, F.G, (int)blockIdx.x, 2048, 2048, (const char*)HB, (const char*)(wl + WL_GU)};
            EpiGU E{SS, (bf16_t*)(ws + W_ACT)};
            pg8::gemm_phase<EpiGU, SchedSimple>(F.lds, S, E);
        }
        SEAM(pb + 6);
        if (IN(pb + 7)) {
            SchedTail S{40, 8, F.G, (int)blockIdx.x, 5632, 5632, (const char*)(ws + W_ACT), (const char*)(wl + WL_D)};
            EpiRes E{(const float*)H, (const float*)(H + (size_t)MP * 2048), H, HB, SS, l == 0 ? 1 : 0, myslab};
            pg8::gemm_phase<EpiRes, SchedTail>(F.lds, S, E);
        }
        SEAM(pb + 7);
        if (IN(pb + 8)) p_fixup<0>(F, (const float*)H, (const float*)(H + (size_t)MP * 2048), l == 0 ? 1 : 0);
        SEAM(pb + 8);
    }
#ifdef TIMING
    if (IN(PH_FINAL)) { const unsigned long long* st = (const unsigned long long*)(ctl + 2048);
        const float t1 = (float)(__hip_atomic_load((gu64*)st + TIM_A1, RLX_AGENT) - __hip_atomic_load((gu64*)st + TIM_A0, RLX_AGENT)) * 0.01f, t2 = (float)(__hip_atomic_load((gu64*)st + TIM_B1, RLX_AGENT) - __hip_atomic_load((gu64*)st + TIM_B0, RLX_AGENT)) * 0.01f;
        p_final(F, 1.f + t1 * (1.f / 3000.f));
        if (blockIdx.x == 0 && F.tid == 0) F.out[OUT_KS] += t2 * 0.1f; }
#else
    if (IN(PH_FINAL)) p_final(F, 1.f);
#endif
#undef IN
#undef SEAM
}
static int g_grid = 0;
static inline bool fast_setup() {
    if (g_grid == 0) {
        int dev = 0, cus = 0;
        if (hipGetDevice(&dev) != hipSuccess || hipDeviceGetAttribute(&cus, hipDeviceAttributeMultiprocessorCount, dev) != hipSuccess) { g_grid = -1; return false; }
        if (hipFuncSetAttribute((const void*)mk_fwd, hipFuncAttributeMaxDynamicSharedMemorySize, LDS_BYTES) != hipSuccess) { fprintf(stderr, "hipFuncSetAttribute failed\n"); g_grid = -1; return false; }
        int per_cu = 0; (void)hipOccupancyMaxActiveBlocksPerMultiprocessor(&per_cu, (const void*)mk_fwd, NWAVES * 64, LDS_BYTES); (void)hipGetLastError();
        if (per_cu < 1) fprintf(stderr, "note: occupancy query reports %d\n", per_cu);
        g_grid = cus;
    }
    return g_grid > 0;
}
static inline void fast_launch(hipStream_t stream, void* const* d_in, float* out, unsigned char* wsbase, int lo, int hi, int li) {
    Args a{}; for (int i = 0; i < 17; ++i) a.in[i] = (const float*)d_in[i];
    a.out = out; a.ws = wsbase; a.ph_lo = lo; a.ph_hi = hi; a.li = li; a.pad = 0;
    hipLaunchKernelGGL(mk_fwd, dim3(g_grid), dim3(NWAVES * 64), LDS_BYTES, stream, a);
}
}
extern "C" void kernel_launch(void* const* d_in, const int* in_sizes, int n_in, void* d_out, int out_size, void* d_ws, size_t ws_size, hipStream_t stream) {
    if (!fk::fast_setup()) return;
    if (n_in != 17 || out_size != (int)fk::OUT_N || ws_size < fk::W_END) { fprintf(stderr, "kernel_launch: unexpected shapes (n_in %d out %d ws %zu)\n", n_in, out_size, ws_size); return; }
    (void)hipMemsetAsync((char*)d_ws + fk::W_CTL, 0, fk::CTL_ZERO_BYTES, stream);
#if defined(PROBE_DUP)
    fk::fast_launch(stream, d_in, (float*)d_out, (unsigned char*)d_ws, 0, PROBE_DUP + 1, 0);
    fk::fast_launch(stream, d_in, (float*)d_out, (unsigned char*)d_ws, PROBE_DUP, fk::N_PHASES, 1);
#elif MK_N_LAUNCHES == 1
    fk::fast_launch(stream, d_in, (float*)d_out, (unsigned char*)d_ws, 0, fk::N_PHASES, 0);
#else
    for (int p = 0; p < fk::N_PHASES; ++p) fk::fast_launch(stream, d_in, (float*)d_out, (unsigned char*)d_ws, p, p + 1, p);
#endif
}
```

```cpp
#include <hip/hip_runtime.h>
#include <cstdio>
#include <cstdint>
#ifndef MK_N_LAUNCHES
#define MK_N_LAUNCHES 1
#endif
namespace pg8 {
#define PG8_LAS __attribute__((address_space(3)))
typedef unsigned short bf16_t;
typedef short bf16x8 __attribute__((ext_vector_type(8)));
typedef float f32x4 __attribute__((ext_vector_type(4)));
typedef unsigned u32x4 __attribute__((ext_vector_type(4)));
constexpr int BM = 256, BK = 64, HALF = 128, HTB = HALF * BK * 2  , STAGE_BYTES = 8 * HTB, NXCD = 8, WGM = 8;

__host__ __device__ __forceinline__ int lds_byte(int r, int c) { const int st = (r >> 4) * 2 + (c >> 5), rr = r & 15, cc = c & 31, ob = rr * 64 + cc * 2; return st * 1024 + (ob ^ (((ob >> 9) & 1) << 5)); }
__host__ __device__ __forceinline__ void stage_rc(int b, int& R, int& C) { const int st = b / 1024, sb = b % 1024, swz = sb ^ (((sb >> 9) & 1) << 5); R = (st >> 1) * 16 + swz / 64; C = (st & 1) * 32 + (swz % 64) / 2; }
__host__ __device__ __forceinline__ int perm32(int rho) { const int n = rho >> 4, i = rho & 15; return 8 * (i >> 2) + 4 * n + (i & 3); }

struct Unit { int pm, pn, br; };
template <class Epi, class Sched, bool ALIGN_EPI = true, bool SP2 = true>
__device__ __forceinline__ void gemm_phase(PG8_LAS unsigned char* lds, const Sched& S, const Epi& E) {
    int tid_ = threadIdx.x; asm volatile("" : "+v"(tid_));
    const int tid = tid_, wid = __builtin_amdgcn_readfirstlane(tid >> 6), lane = tid & 63, wr = wid >> 2, wc = wid & 3, fr = lane & 15, fq = lane >> 4;
    const int K = S.K;
    unsigned voffA[2], voffB[2];
#pragma unroll
    for (int i = 0; i < 2; ++i) { int R, C; stage_rc(tid * 16 + i * 8192, R, C); const int Rb = Epi::PERM ? ((R & ~31) + perm32(R & 31)) : R;
        voffA[i] = (unsigned)(R * K + C) * 2u; voffB[i] = (unsigned)(Rb * K + C) * 2u; }
    const size_t kstep = (size_t)(BK * 2);
    const size_t hstep = (size_t)HALF * K * 2;
        const unsigned ldsw = (unsigned)wid * 1024u;
    const int aoff = lds_byte(wr * 64 + fr, fq * 8), boff = lds_byte(wc * 32 + fr, fq * 8);
#define PG8_SA(b, h) (((b) * 2 + (h)) * HTB)
#define PG8_SB(b, h) ((4 + (b) * 2 + (h)) * HTB)
#define PG8_STAGE(bufoff, gbase, voff) do { _Pragma("unroll") for (int _i = 0; _i < 2; ++_i) \
        __builtin_amdgcn_global_load_lds((const unsigned*)((const char*)(gbase) + (voff)[_i]), (PG8_LAS unsigned*)(lds + (bufoff) + ldsw + _i * 8192), 16, 0, 0); } while (0)
#define PG8_LDA(dst, b, h) do { _Pragma("unroll") for (int m = 0; m < 4; ++m) _Pragma("unroll") for (int k = 0; k < 2; ++k) dst[m][k] = *(const PG8_LAS bf16x8*)(lds + PG8_SA(b, h) + aoff + m * 2048 + k * 1024); } while (0)
#define PG8_LDB(dst, b, h) do { _Pragma("unroll") for (int n = 0; n < 2; ++n) _Pragma("unroll") for (int k = 0; k < 2; ++k) dst[n][k] = *(const PG8_LAS bf16x8*)(lds + PG8_SB(b, h) + boff + n * 2048 + k * 1024); } while (0)
#define PG8_MMA(ai, bj, At, Bt) do { __builtin_amdgcn_s_setprio(1); _Pragma("unroll") for (int m = 0; m < 4; ++m) _Pragma("unroll") for (int n = 0; n < 2; ++n) _Pragma("unroll") for (int k = 0; k < 2; ++k) \
        acc[ai][bj][m][n] = __builtin_amdgcn_mfma_f32_16x16x32_bf16(Bt[n][k], At[m][k], acc[ai][bj][m][n], 0, 0, 0); __builtin_amdgcn_s_setprio(0); } while (0)
#define PG8_WAIT_V(n) asm volatile("s_waitcnt vmcnt(" #n ")" ::: "memory")
#define PG8_WAIT_L(n) asm volatile("s_waitcnt lgkmcnt(" #n ")" ::: "memory")
#define PG8_BAR __builtin_amdgcn_s_barrier()
#define PG8_SCHED __builtin_amdgcn_sched_barrier(0)
    Unit cur, nxt; int ui = 0;
    if (!S.next(0, cur)) return;
    f32x4 acc[2][2][4][2];
#pragma unroll
    for (int a = 0; a < 2; ++a)
#pragma unroll
        for (int b = 0; b < 2; ++b)
#pragma unroll
            for (int m = 0; m < 4; ++m)
#pragma unroll
                for (int n = 0; n < 2; ++n) acc[a][b][m][n] = (f32x4){0.f, 0.f, 0.f, 0.f};
    bf16x8 At[4][2], B0[2][2], B1[2][2];
    const char* cA = S.a_base(cur); const char* cB = S.b_base(cur);
    if constexpr (SP2) {
        PG8_STAGE(PG8_SB(0, 0), cB, voffB); PG8_STAGE(PG8_SB(0, 1), cB + hstep, voffB); PG8_STAGE(PG8_SA(0, 0), cA, voffA); PG8_STAGE(PG8_SA(0, 1), cA + hstep, voffA);
        if (wr == 1) PG8_BAR;
        PG8_WAIT_V(2); PG8_BAR;
        PG8_STAGE(PG8_SB(1, 0), cB + kstep, voffB); PG8_STAGE(PG8_SA(1, 0), cA + kstep, voffA); PG8_STAGE(PG8_SB(1, 1), cB + hstep + kstep, voffB);
        PG8_WAIT_V(6); PG8_BAR;
    } else {
        PG8_STAGE(PG8_SB(0, 0), cB, voffB); PG8_STAGE(PG8_SA(0, 0), cA, voffA); PG8_STAGE(PG8_SB(0, 1), cB + hstep, voffB); PG8_STAGE(PG8_SA(0, 1), cA + hstep, voffA);
        if (wr == 1) PG8_BAR;
        PG8_WAIT_V(4); PG8_BAR;
        PG8_STAGE(PG8_SB(1, 0), cB + kstep, voffB); PG8_STAGE(PG8_SA(1, 0), cA + kstep, voffA); PG8_STAGE(PG8_SB(1, 1), cB + hstep + kstep, voffB);
        PG8_WAIT_V(6); PG8_BAR;
    }
    for (;;) {
        const bool has_next = S.next(ui + 1, nxt); const int nt = S.nt(cur);
        const char* nA = has_next ? S.a_base(nxt) : cA; const char* nB = has_next ? S.b_base(nxt) : cB;
#ifdef TIMING_K
        unsigned long long tk0 = 0, tr0 = 0; const bool stamper = S.stamp != nullptr && blockIdx.x == 0 && wid == 0 && ui == 1;
        if (stamper) { tk0 = __builtin_amdgcn_s_memtime(); tr0 = __builtin_amdgcn_s_memrealtime(); }
#ifdef TIMING_GAP
        if (S.stamp != nullptr && blockIdx.x == 0 && wid == 0 && ui == 2 && lane == 0) { S.stamp[0] = __builtin_amdgcn_s_memtime() - S.stamp[4]; S.stamp[1] = __builtin_amdgcn_s_memrealtime() - S.stamp[5]; S.stamp[2] = 1ull; }
#endif
#endif
        for (int t = 0; t < nt; t += 2) {
            const bool last = (t == nt - 2);
            const char* a1 = cA + (size_t)(t + 1) * kstep;
            const char* a2 = last ? nA : cA + (size_t)(t + 2) * kstep; const char* b2 = last ? nB : cB + (size_t)(t + 2) * kstep;
            const char* a3 = a2 + kstep; const char* b3 = b2 + kstep;
            if constexpr (SP2) {
            PG8_LDB(B0, 0, 0); PG8_LDB(B1, 0, 1); PG8_SCHED; PG8_LDA(At, 0, 0); PG8_STAGE(PG8_SA(1, 1), a1 + hstep, voffA);
            PG8_WAIT_V(8); PG8_WAIT_L(0); PG8_BAR; PG8_MMA(0, 0, At, B0); PG8_MMA(0, 1, At, B1); PG8_BAR; PG8_SCHED;
            PG8_LDA(At, 0, 1); PG8_STAGE(PG8_SB(0, 0), b2, voffB); PG8_STAGE(PG8_SB(0, 1), b2 + hstep, voffB); PG8_STAGE(PG8_SA(0, 0), a2, voffA);
            PG8_WAIT_V(8); PG8_WAIT_L(0); PG8_BAR; PG8_MMA(1, 0, At, B0); PG8_MMA(1, 1, At, B1); PG8_BAR; PG8_SCHED;
            PG8_LDB(B0, 1, 0); PG8_LDB(B1, 1, 1); PG8_SCHED; PG8_LDA(At, 1, 0); PG8_STAGE(PG8_SA(0, 1), a2 + hstep, voffA);
            PG8_WAIT_V(8); PG8_WAIT_L(0); PG8_BAR; PG8_MMA(0, 0, At, B0); PG8_MMA(0, 1, At, B1); PG8_BAR; PG8_SCHED;
            PG8_LDA(At, 1, 1); PG8_STAGE(PG8_SB(1, 0), b3, voffB); PG8_STAGE(PG8_SB(1, 1), b3 + hstep, voffB); PG8_STAGE(PG8_SA(1, 0), a3, voffA);
            PG8_WAIT_V(8); PG8_WAIT_L(0); PG8_BAR; PG8_MMA(1, 0, At, B0); PG8_MMA(1, 1, At, B1); PG8_BAR; PG8_SCHED;
            } else {
            PG8_LDB(B0, 0, 0); PG8_SCHED; PG8_LDA(At, 0, 0); PG8_STAGE(PG8_SA(1, 1), a1 + hstep, voffA);
            PG8_WAIT_L(8); PG8_BAR; PG8_WAIT_L(0); PG8_MMA(0, 0, At, B0); PG8_BAR; PG8_SCHED;
            PG8_LDB(B1, 0, 1); PG8_STAGE(PG8_SB(0, 0), b2, voffB);
            PG8_BAR; PG8_WAIT_L(0); PG8_MMA(0, 1, At, B1); PG8_BAR;
            PG8_LDA(At, 0, 1); PG8_STAGE(PG8_SA(0, 0), a2, voffA);
            PG8_BAR; PG8_WAIT_L(0); PG8_MMA(1, 0, At, B0); PG8_BAR; PG8_SCHED;
            PG8_STAGE(PG8_SB(0, 1), b2 + hstep, voffB);
            PG8_WAIT_V(6); PG8_BAR; PG8_MMA(1, 1, At, B1); PG8_BAR;
            PG8_LDB(B0, 1, 0); PG8_SCHED; PG8_LDA(At, 1, 0); PG8_STAGE(PG8_SA(0, 1), a2 + hstep, voffA);
            PG8_WAIT_L(8); PG8_BAR; PG8_WAIT_L(0); PG8_MMA(0, 0, At, B0); PG8_BAR; PG8_SCHED;
            PG8_LDB(B1, 1, 1); PG8_STAGE(PG8_SB(1, 0), b3, voffB);
            PG8_BAR; PG8_WAIT_L(0); PG8_MMA(0, 1, At, B1); PG8_BAR;
            PG8_LDA(At, 1, 1); PG8_STAGE(PG8_SA(1, 0), a3, voffA);
            PG8_BAR; PG8_WAIT_L(0); PG8_MMA(1, 0, At, B0); PG8_BAR; PG8_SCHED;
            PG8_STAGE(PG8_SB(1, 1), b3 + hstep, voffB);
            PG8_WAIT_V(6); PG8_BAR; PG8_MMA(1, 1, At, B1); PG8_BAR;
            }
        }
#ifdef TIMING_K
#ifdef TIMING_GAP
        if (stamper && lane == 0) { S.stamp[4] = __builtin_amdgcn_s_memtime(); S.stamp[5] = __builtin_amdgcn_s_memrealtime(); }
#else
        if (stamper && lane == 0) { S.stamp[0] = __builtin_amdgcn_s_memtime() - tk0; S.stamp[1] = __builtin_amdgcn_s_memrealtime() - tr0; S.stamp[2] = (unsigned long long)nt; }
#endif
#endif
        if constexpr (ALIGN_EPI) { if (wr == 0) PG8_BAR; }
        { int fr_e = fr, fq_e = fq; asm volatile("" : "+v"(fr_e), "+v"(fq_e));
          E(acc, cur, wr, wc, fr_e, fq_e); }
        if (!has_next) break;
        if (!E.keep(cur)) {
#pragma unroll
        for (int a = 0; a < 2; ++a)
#pragma unroll
            for (int b = 0; b < 2; ++b)
#pragma unroll
                for (int m = 0; m < 4; ++m)
#pragma unroll
                    for (int n = 0; n < 2; ++n) acc[a][b][m][n] = (f32x4){0.f, 0.f, 0.f, 0.f};
        }
        cur = nxt; cA = nA; cB = nB; ++ui;
        if constexpr (ALIGN_EPI) { if (wr == 1) PG8_BAR; }
    }
    PG8_WAIT_V(0);
    if constexpr (!ALIGN_EPI) { if (wr == 0) PG8_BAR; }
    PG8_BAR;
#undef PG8_SA
#undef PG8_SB
#undef PG8_STAGE
#undef PG8_LDA
#undef PG8_LDB
#undef PG8_MMA
#undef PG8_WAIT_V
#undef PG8_WAIT_L
#undef PG8_BAR
#undef PG8_SCHED
}
}
namespace fk {
using pg8::Unit; using pg8::bf16_t;
typedef float f32x16 __attribute__((ext_vector_type(16)));
typedef float f32x8v __attribute__((ext_vector_type(8)));
typedef short s16x4 __attribute__((ext_vector_type(4)));
typedef unsigned u32x4 __attribute__((ext_vector_type(4)));
typedef unsigned u32x2 __attribute__((ext_vector_type(2)));
constexpr int NWAVES = 8;
constexpr int M = 10240, MP = 8192, MS = 2048, DM = 2048, NIN = 9216, FF = 5632, NGU = 11264, SBW = 1024;
constexpr float EPS = 1e-6f;
constexpr float QSCALE = 1.4426950408889634f * 0.08838834764831845f;
constexpr size_t OUT_Y = 0, OUT_KP = 20971520, OUT_VP = 37748736, OUT_KS = 54525952, OUT_VS = 58720256, OUT_SG = 62914560, OUT_N = 67108864;
constexpr size_t MiB = 1u << 20;
constexpr size_t W_CTL = 0, CTL_ZERO_BYTES = 1 * MiB;
constexpr size_t W_WL = 1 * MiB, WL_STRIDE = 118 * MiB;
constexpr size_t WL_IN = 0, WL_A = 36 * MiB, WL_B = 40 * MiB, WL_OUT = 44 * MiB, WL_GU = 52 * MiB, WL_D = 96 * MiB;
constexpr size_t W_WM = 237 * MiB;
constexpr size_t W_HB = 238 * MiB, W_SS = 278 * MiB, W_Q = 280 * MiB, W_K = 300 * MiB, W_V = 320 * MiB, W_U = 340 * MiB, W_VS = 360 * MiB, W_G = 400 * MiB,
                 W_ATT = 480 * MiB, W_BB = 500 * MiB, W_MG = 520 * MiB, W_ACT = 560 * MiB, W_SLAB = 670 * MiB  , W_END = 734 * MiB;
constexpr size_t W_SSV = W_SS + 1280 * 1024;
constexpr int CW_TMO = 0, CW_BAR = 4096;
constexpr int RING_BYTES = 131072, LDSCTL_OFF = RING_BYTES, MISC_OFF = LDSCTL_OFF + 320, LDS_BYTES = 147456;

#define GAS __attribute__((address_space(1)))
#define LAS __attribute__((address_space(3)))
typedef unsigned short bf16;
typedef unsigned v4u __attribute__((ext_vector_type(4)));
typedef float f32x4 __attribute__((ext_vector_type(4)));
typedef short bf16x8 __attribute__((ext_vector_type(8)));
typedef GAS unsigned gu32;
typedef GAS unsigned long long gu64;
#define RLX_AGENT __ATOMIC_RELAXED, __HIP_MEMORY_SCOPE_AGENT
#define LDS_WAIT() asm volatile("s_waitcnt lgkmcnt(0)" ::: "memory")
#define VM_WAIT() asm volatile("s_waitcnt vmcnt(0)" ::: "memory")
__device__ __forceinline__ unsigned long long rt() { return __builtin_amdgcn_s_memrealtime(); }
__device__ __forceinline__ unsigned f2bf(float f) { unsigned u = __builtin_bit_cast(unsigned, f); return (u + 0x7fffu + ((u >> 16) & 1u)) >> 16; }
__device__ __forceinline__ unsigned pk2(float lo, float hi) { return f2bf(lo) | (f2bf(hi) << 16); }
#define XB_TMO      128
#define XB_XCNT(j)  (256  + 64 * (j))
#define XB_XSUB(j)  (1280 + 64 * (j))
#define XB_XGEN(j)  (2304 + 64 * (j))
#define XB_TOP      3328
#define XB_TOPGEN   3392
#define XCD_BAR_WORDS 3456
#define XB_SPIN_CAP (1u << 18)

__device__ __forceinline__ unsigned xb_ld(unsigned* p)              { return __hip_atomic_load(p, __ATOMIC_RELAXED, __HIP_MEMORY_SCOPE_AGENT); }
__device__ __forceinline__ unsigned xb_add(unsigned* p, unsigned v) { return __hip_atomic_fetch_add(p, v, __ATOMIC_RELAXED, __HIP_MEMORY_SCOPE_AGENT); }
__device__ __forceinline__ unsigned xb_xcc_id() { return (unsigned)__builtin_amdgcn_s_getreg((3 << 11) | 20) & 0xFu; }
#define XB_SPIN(cond, bar) do { unsigned _sp = 0; while (cond) { __builtin_amdgcn_s_sleep(1); \
    if ((++_sp & 255u) == 0u) { if (xb_ld(&(bar)[XB_TMO])) break; if (_sp > XB_SPIN_CAP) { atomicAdd(&(bar)[XB_TMO], 1u); break; } } } } while (0)

struct XcdBarrier {
    unsigned* bar; unsigned x;
    volatile LAS unsigned* st;
};

__device__ __forceinline__ XcdBarrier xcd_barrier_post(unsigned* bar, volatile LAS unsigned* st) {
    XcdBarrier b; b.bar = bar; b.x = xb_xcc_id(); b.st = st;
    if (threadIdx.x == 0) (void)xb_add(&bar[XB_XCNT(b.x)], 1u);
    return b;
}
__device__ __forceinline__ void xcd_barrier_complete(unsigned* bar, unsigned x, unsigned& nloc, unsigned& nx) {
    const unsigned G = gridDim.x * gridDim.y * gridDim.z;
    unsigned sum, cnt, mine, sp = 0u;
    for (;;) {
        sum = 0u; cnt = 0u; mine = 0u;
#pragma unroll
        for (unsigned j = 0; j < 16; ++j) { const unsigned c = xb_ld(&bar[XB_XCNT(j)]); sum += c; cnt += (c > 0u) ? 1u : 0u; mine = (j == x) ? c : mine; }
        if (sum == G) break;
        __builtin_amdgcn_s_sleep(1);
        if ((++sp & 255u) == 0u) { if (xb_ld(&bar[XB_TMO])) break; if (sp > XB_SPIN_CAP) { atomicAdd(&bar[XB_TMO], 1u); break; } }
    }
    nloc = mine > 0u ? mine : 1u; nx = cnt > 0u ? cnt : 1u;
}

__device__ __forceinline__ void xcd_barrier(const XcdBarrier& b) {
    asm volatile("s_waitcnt vmcnt(0)" ::: "memory");
    __syncthreads();
    if (threadIdx.x == 0) {
        unsigned* bar = b.bar;
        __builtin_amdgcn_s_waitcnt(0);
        unsigned nloc = b.st[0], nx = b.st[1];
        if (nloc == 0u) { xcd_barrier_complete(bar, b.x, nloc, nx); b.st[0] = nloc; b.st[1] = nx; }
        const unsigned old = xb_add(&bar[XB_XSUB(b.x)], 1u);
        const unsigned gen = old / nloc;
        if (old + 1u == (gen + 1u) * nloc) {
            __builtin_amdgcn_fence(__ATOMIC_RELEASE, "agent");
            asm volatile("s_waitcnt vmcnt(0)" ::: "memory");
            const unsigned og = xb_add(&bar[XB_TOP], 1u);
            const unsigned tg = og / nx;
            if (og + 1u == (tg + 1u) * nx) xb_add(&bar[XB_TOPGEN], 1u);
            else XB_SPIN(xb_ld(&bar[XB_TOPGEN]) == tg, bar);
            __builtin_amdgcn_fence(__ATOMIC_ACQUIRE, "agent");
            xb_add(&bar[XB_XGEN(b.x)], 1u);
            asm volatile("s_waitcnt vmcnt(0)" ::: "memory");
        } else {
            XB_SPIN(xb_ld(&bar[XB_XGEN(b.x)]) == gen, bar);
            __builtin_amdgcn_fence(__ATOMIC_ACQUIRE, "agent");
            asm volatile("s_waitcnt vmcnt(0)" ::: "memory");
        }
    }
    __syncthreads();
}

struct Frame {
    LAS unsigned char* lds; volatile LAS unsigned* MISC; int tid, lane, wave, vcu, G;
    const float *xp, *xs, *ck, *cv, *nmix, *win, *bgate, *sgun, *wsp, *bsp, *wa, *wb, *wout, *nffn, *wgu, *wd, *nfin;
    float* out; unsigned char* ws;
};
__device__ __forceinline__ int opq(int x) { asm volatile("" : "+v"(x)); return x; }
__device__ __forceinline__ float bf2f_lo(unsigned w) { return __uint_as_float(w << 16); }
__device__ __forceinline__ float bf2f_hi(unsigned w) { return __uint_as_float(w & 0xffff0000u); }
typedef __bf16 bf16x2_t __attribute__((ext_vector_type(2)));
__device__ __forceinline__ unsigned cvtpk(float lo, float hi) { const bf16x2_t v = {(__bf16)lo, (__bf16)hi}; return __builtin_bit_cast(unsigned, v); }
__device__ __forceinline__ float fsig(float y) { return __builtin_amdgcn_rcpf(1.f + __builtin_amdgcn_exp2f(-1.4426950408889634f * y)); }
__device__ __forceinline__ float fgelu(float x) { const float t = x * (-2.3022081f + -0.10294324f * x * x); return x * __builtin_amdgcn_rcpf(1.f + __builtin_amdgcn_exp2f(t)); }
__device__ __forceinline__ float wave_sum(float v) {
#pragma unroll
    for (int o = 1; o < 64; o <<= 1) v += __shfl_xor(v, o);
    return v;
}
__device__ __forceinline__ void tile_of(int L, int nM, int nN, int& pm, int& pn) {
    const int nwg = nM * nN; int wgid = L; { const int q = nwg / 8, r = nwg % 8, xcd = wgid % 8, off = wgid / 8; wgid = (xcd < r ? xcd * (q + 1) : r * (q + 1) + (xcd - r) * q) + off; }
    const int nig = 8 * nN, gid = wgid / nig, fm = gid * 8, gsz = (nM - fm) < 8 ? (nM - fm) : 8;
    pm = fm + ((wgid % nig) % gsz); pn = (wgid % nig) / gsz;
}
struct SchedSimple {
    int nM, nN, G, c, K, KT; const char* A; const char* Bt; unsigned long long* stamp;
    __device__ __forceinline__ bool next(int i, Unit& u) const { const int L = i * G + c; if (L >= nM * nN) return false; tile_of(L, nM, nN, u.pm, u.pn); u.br = 0; return true; }
    __device__ __forceinline__ int nt(const Unit&) const { return KT >> 6; }
    __device__ __forceinline__ const char* a_base(const Unit& u) const { return A + (size_t)u.pm * 512 * K; }
    __device__ __forceinline__ const char* b_base(const Unit& u) const { return Bt + (size_t)u.pn * 512 * K; }
};
constexpr int TAIL_T = 320, TAIL_F = 256, TAIL_NS = 4;
struct SchedTail {
    int nM, nN, G, c, K, KT; const char* A; const char* Bt; unsigned long long* stamp; int split;
    __device__ __forceinline__ bool next(int i, Unit& u) const {
        if (split && G == TAIL_F) { if (i > 1) return false; if (i == 0) { tile_of(c, nM, nN, u.pm, u.pn); u.br = 0; } else { tile_of(TAIL_F + (c >> 2), nM, nN, u.pm, u.pn); u.br = 1 + (c & 3); } return true; }
        const int L = i * G + c; if (L >= nM * nN) return false; tile_of(L, nM, nN, u.pm, u.pn); u.br = 0; return true; }
    __device__ __forceinline__ int nt(const Unit& u) const { return u.br ? (KT >> 8) : (KT >> 6); }
    __device__ __forceinline__ const char* a_base(const Unit& u) const { return A + (size_t)u.pm * 512 * K + (u.br ? (size_t)(u.br - 1) * (KT >> 2) * 2 : 0); }
    __device__ __forceinline__ const char* b_base(const Unit& u) const { return Bt + (size_t)u.pn * 512 * K + (u.br ? (size_t)(u.br - 1) * (KT >> 2) * 2 : 0); }
};
struct SchedBranch {
    int nM, nN, G, c, K, KT; const char *A0, *B0, *A1, *B1; unsigned long long* stamp; int split;
    __device__ __forceinline__ bool next(int i, Unit& u) const {
        if (split && G == TAIL_F) { if (i > 2) return false; if (i < 2) { tile_of(c, nM, nN, u.pm, u.pn); u.br = i; } else { tile_of(TAIL_F + (c >> 2), nM, nN, u.pm, u.pn); u.br = 2 + (c & 3); } return true; }
        const int L = (i >> 1) * G + c; if (L >= nM * nN) return false; tile_of(L, nM, nN, u.pm, u.pn); u.br = i & 1; return true; }
    __device__ __forceinline__ int nt(const Unit& u) const { return u.br < 2 ? (KT >> 6) : (KT >> 7); }
    __device__ __forceinline__ const char* a_base(const Unit& u) const { const int pr = u.br < 2 ? u.br : ((u.br - 2) >> 1); return (pr ? A1 : A0) + (size_t)u.pm * 512 * K + (u.br < 2 ? 0 : (size_t)((u.br - 2) & 1) * (KT >> 1) * 2); }
    __device__ __forceinline__ const char* b_base(const Unit& u) const { const int pr = u.br < 2 ? u.br : ((u.br - 2) >> 1); return (pr ? B1 : B0) + (size_t)u.pn * 512 * K + (u.br < 2 ? 0 : (size_t)((u.br - 2) & 1) * (KT >> 1) * 2); }
};
#define EPI_ROWS(ai, m) (u.pm * 256 + (ai) * 128 + wr * 64 + (m) * 16 + fr)
__device__ __forceinline__ void row_rstd(const float* SS, const Unit& u, int wr, int fr, int fq, float (&rs)[2][4]) {
    f32x4 a[2][4], b[2][4];
#pragma unroll
    for (int ai = 0; ai < 2; ++ai)
#pragma unroll
        for (int m = 0; m < 4; ++m) { const f32x4* s = (const f32x4*)(SS + (size_t)EPI_ROWS(ai, m) * 32 + fq * 8); a[ai][m] = s[0]; b[ai][m] = s[1]; }
    float t[2][4];
#pragma unroll
    for (int ai = 0; ai < 2; ++ai)
#pragma unroll
        for (int m = 0; m < 4; ++m) t[ai][m] = ((a[ai][m][0] + a[ai][m][1]) + (a[ai][m][2] + a[ai][m][3])) + ((b[ai][m][0] + b[ai][m][1]) + (b[ai][m][2] + b[ai][m][3]));
#pragma unroll
    for (int ai = 0; ai < 2; ++ai)
#pragma unroll
        for (int m = 0; m < 4; ++m) t[ai][m] += __shfl_xor(t[ai][m], 16);
#pragma unroll
    for (int ai = 0; ai < 2; ++ai)
#pragma unroll
        for (int m = 0; m < 4; ++m) t[ai][m] += __shfl_xor(t[ai][m], 32);
#pragma unroll
    for (int ai = 0; ai < 2; ++ai)
#pragma unroll
        for (int m = 0; m < 4; ++m) rs[ai][m] = __builtin_amdgcn_rsqf(t[ai][m] * (1.0f / 2048.0f) + EPS);
}
__device__ __forceinline__ u32x4 pack8(const f32x4 v0, const f32x4 v1) { u32x4 w; w.x = cvtpk(v0[0], v0[1]); w.y = cvtpk(v0[2], v0[3]); w.z = cvtpk(v1[0], v1[1]); w.w = cvtpk(v1[2], v1[3]); return w; }
#ifdef DBG_GRAW
#define GATE_ACT(x) (x)
#else
#define GATE_ACT(x) fsig(x)
#endif
struct EpiIn {
    static constexpr bool PERM = true;
    const float* SS; bf16_t *Q, *Kb, *Vb, *U, *G; float* VS; const float* bgate; float *okp, *ovp, *oks, *ovs; float* SSV;
    __device__ __forceinline__ bool keep(const Unit&) const { return false; }
    __device__ __forceinline__ void operator()(f32x4 (&acc)[2][2][4][2], const Unit& u, int wr, int wc, int fr, int fq) const {
        float rs[2][4]; row_rstd(SS, u, wr, fr, fq, rs);
        const int colt = u.pn * 256, cl = wc * 32 + 8 * fq;
        if (colt < 1024) {
#pragma unroll
            for (int ai = 0; ai < 2; ++ai)
#pragma unroll
                for (int m = 0; m < 4; ++m) { const size_t row = EPI_ROWS(ai, m); const float sc = rs[ai][m] * QSCALE;
#pragma unroll
                    for (int bj = 0; bj < 2; ++bj) *(u32x4*)(Q + row * 1024 + colt + bj * 128 + cl) = pack8(acc[ai][bj][m][0] * sc, acc[ai][bj][m][1] * sc); }
        } else if (colt < 3072) {
            const bool isv = colt >= 2048; const int c0 = colt - (isv ? 2048 : 1024) + cl; bf16_t* B = isv ? Vb : Kb;
            float* O = (u.pm < 32) ? (isv ? ovp : okp) : ((isv ? ovs : oks) - (size_t)MP * 1024);
#pragma unroll
            for (int ai = 0; ai < 2; ++ai)
#pragma unroll
                for (int m = 0; m < 4; ++m) { const size_t row = EPI_ROWS(ai, m); const float sc = rs[ai][m];
#pragma unroll
                    for (int bj = 0; bj < 2; ++bj) { const f32x4 v0 = acc[ai][bj][m][0] * sc, v1 = acc[ai][bj][m][1] * sc; const size_t o = row * 1024 + c0 + bj * 128;
                        *(u32x4*)(B + o) = pack8(v0, v1); *(f32x4*)(O + o) = v0; *(f32x4*)(O + o + 4) = v1; } }
        } else if (colt < 5120) {
            const bool isvs = colt >= 4096; const int c0 = colt - (isvs ? 4096 : 3072) + cl;
#pragma unroll
            for (int ai = 0; ai < 2; ++ai)
#pragma unroll
                for (int m = 0; m < 4; ++m) { const size_t row = EPI_ROWS(ai, m); const float sc = rs[ai][m]; float q = 0.f;
#pragma unroll
                    for (int bj = 0; bj < 2; ++bj) { f32x4 v0 = acc[ai][bj][m][0] * sc, v1 = acc[ai][bj][m][1] * sc;
#pragma unroll
                        for (int j = 0; j < 4; ++j) { v0[j] = fgelu(v0[j]); v1[j] = fgelu(v1[j]); }
                        const size_t o = row * 1024 + c0 + bj * 128;
                        if (isvs) { *(f32x4*)(VS + o) = v0; *(f32x4*)(VS + o + 4) = v1;
                            q += ((v0[0] * v0[0] + v0[1] * v0[1]) + (v0[2] * v0[2] + v0[3] * v0[3])) + ((v1[0] * v1[0] + v1[1] * v1[1]) + (v1[2] * v1[2] + v1[3] * v1[3])); }
                        else *(u32x4*)(U + o) = pack8(v0, v1); }
                    if (isvs) { q += __shfl_xor(q, 16); q += __shfl_xor(q, 32); if (fq == 0) SSV[row * 16 + (u.pn - 16) * 4 + wc] = q; } }
        } else {
            const int c0 = colt - 5120 + cl;
#pragma unroll
            for (int bj = 0; bj < 2; ++bj) { const f32x4 b0 = *(const f32x4*)(bgate + c0 + bj * 128), b1 = *(const f32x4*)(bgate + c0 + bj * 128 + 4);
#pragma unroll
                for (int ai = 0; ai < 2; ++ai)
#pragma unroll
                    for (int m = 0; m < 4; ++m) { const size_t row = EPI_ROWS(ai, m); const float sc = rs[ai][m];
                        f32x4 v0 = acc[ai][bj][m][0] * sc + b0, v1 = acc[ai][bj][m][1] * sc + b1;
#pragma unroll
                        for (int j = 0; j < 4; ++j) { v0[j] = GATE_ACT(v0[j]); v1[j] = GATE_ACT(v1[j]); }
                        *(u32x4*)(G + row * 4096 + c0 + bj * 128) = pack8(v0, v1); } }
        }
    }
};
__device__ __forceinline__ void store_slab(float* slab, const f32x4 (&acc)[2][2][4][2], int wr, int wc, int fr, int fq) {
#pragma unroll
    for (int ai = 0; ai < 2; ++ai)
#pragma unroll
        for (int m = 0; m < 4; ++m) { float* rp = slab + (size_t)(ai * 128 + wr * 64 + m * 16 + fr) * 256 + wc * 32 + 8 * fq;
#pragma unroll
            for (int bj = 0; bj < 2; ++bj) { *(f32x4*)(rp + bj * 128) = acc[ai][bj][m][0]; *(f32x4*)(rp + bj * 128 + 4) = acc[ai][bj][m][1]; } }
}
struct EpiMerge {
    static constexpr bool PERM = true;
    const bf16_t* G; bf16_t* MG; float* slab;
    __device__ __forceinline__ bool keep(const Unit& u) const { return u.br == 0; }
    __device__ __forceinline__ void operator()(f32x4 (&acc)[2][2][4][2], const Unit& u, int wr, int wc, int fr, int fq) const {
        const int c0 = u.pn * 256 + wc * 32 + 8 * fq; const int pair = u.br < 2 ? u.br : ((u.br - 2) >> 1);
#pragma unroll
        for (int ai = 0; ai < 2; ++ai) {
            u32x4 gg[4][2], hh[4][2];
#pragma unroll
            for (int m = 0; m < 4; ++m)
#pragma unroll
                for (int bj = 0; bj < 2; ++bj) { const bf16_t* gp = G + (size_t)EPI_ROWS(ai, m) * 4096 + c0 + bj * 128; gg[m][bj] = *(const u32x4*)(gp + pair * 2048); if (u.br == 0) hh[m][bj] = *(const u32x4*)(gp + 2048); }
#pragma unroll
            for (int m = 0; m < 4; ++m) { const size_t row = EPI_ROWS(ai, m);
#pragma unroll
                for (int bj = 0; bj < 2; ++bj) { const int c = c0 + bj * 128; const u32x4 g = gg[m][bj];
                    f32x4 g0 = {bf2f_lo(g.x), bf2f_hi(g.x), bf2f_lo(g.y), bf2f_hi(g.y)}, g1 = {bf2f_lo(g.z), bf2f_hi(g.z), bf2f_lo(g.w), bf2f_hi(g.w)};
                    if (u.br == 0) {
                        const u32x4 h = hh[m][bj];
                        const f32x4 b0 = {bf2f_lo(h.x), bf2f_hi(h.x), bf2f_lo(h.y), bf2f_hi(h.y)}, b1 = {bf2f_lo(h.z), bf2f_hi(h.z), bf2f_lo(h.w), bf2f_hi(h.w)};
#pragma unroll
                        for (int j = 0; j < 4; ++j) { g0[j] *= __builtin_amdgcn_rcpf(fmaxf(b0[j], 1e-30f)); g1[j] *= __builtin_amdgcn_rcpf(fmaxf(b1[j], 1e-30f)); }
                    } else if (u.br == 1) {
#pragma unroll
                        for (int j = 0; j < 4; ++j) { g0[j] = fmaxf(g0[j], 1e-30f); g1[j] = fmaxf(g1[j], 1e-30f); }
                    }
                    acc[ai][bj][m][0] *= g0; acc[ai][bj][m][1] *= g1;
                    if (u.br == 1) *(u32x4*)(MG + row * 2048 + c) = pack8(acc[ai][bj][m][0], acc[ai][bj][m][1]); } }
        }
        if (u.br >= 2) store_slab(slab, acc, wr, wc, fr, fq);
    }
};
struct EpiRes {
    static constexpr bool PERM = true;
    const float* base_p; const float* base_s;
    float* H; bf16_t* HB; float* SS; int write_hb; float* slab;
    __device__ __forceinline__ bool keep(const Unit&) const { return false; }
    __device__ __forceinline__ void operator()(f32x4 (&acc)[2][2][4][2], const Unit& u, int wr, int wc, int fr, int fq) const {
        if (u.br) { store_slab(slab, acc, wr, wc, fr, fq); return; }
        const int c0 = u.pn * 256 + wc * 32 + 8 * fq; const float* bb = (u.pm < 32) ? base_p : (base_s - (size_t)MP * 2048);
#pragma unroll
        for (int ai = 0; ai < 2; ++ai) {
            f32x4 bv[4][2][2];
#pragma unroll
            for (int m = 0; m < 4; ++m)
#pragma unroll
                for (int bj = 0; bj < 2; ++bj) { const size_t o = (size_t)EPI_ROWS(ai, m) * 2048 + c0 + bj * 128; bv[m][bj][0] = *(const f32x4*)(bb + o); bv[m][bj][1] = *(const f32x4*)(bb + o + 4); }
#pragma unroll
            for (int m = 0; m < 4; ++m) { const size_t row = EPI_ROWS(ai, m); float q = 0.f;
#pragma unroll
                for (int bj = 0; bj < 2; ++bj) { const size_t o = row * 2048 + c0 + bj * 128;
                    const f32x4 h0 = bv[m][bj][0] + acc[ai][bj][m][0], h1 = bv[m][bj][1] + acc[ai][bj][m][1];
                    *(f32x4*)(H + o) = h0; *(f32x4*)(H + o + 4) = h1;
                    q += ((h0[0] * h0[0] + h0[1] * h0[1]) + (h0[2] * h0[2] + h0[3] * h0[3])) + ((h1[0] * h1[0] + h1[1] * h1[1]) + (h1[2] * h1[2] + h1[3] * h1[3]));
                    if (write_hb) *(u32x4*)(HB + o) = pack8(h0, h1); }
                q += __shfl_xor(q, 16); q += __shfl_xor(q, 32);
                if (fq == 0) SS[row * 32 + u.pn * 4 + wc] = q; }
        }
    }
};
struct EpiGU {
    static constexpr bool PERM = true;
    const float* SS; bf16_t* ACT;
    __device__ __forceinline__ bool keep(const Unit&) const { return false; }
    __device__ __forceinline__ void operator()(f32x4 (&acc)[2][2][4][2], const Unit& u, int wr, int wc, int fr, int fq) const {
        float rs[2][4]; row_rstd(SS, u, wr, fr, fq, rs);
        const int c0 = u.pn * 128 + wc * 32 + 8 * fq;
#pragma unroll
        for (int ai = 0; ai < 2; ++ai)
#pragma unroll
            for (int m = 0; m < 4; ++m) { const size_t row = EPI_ROWS(ai, m); const float sc = rs[ai][m]; f32x4 v0, v1;
#pragma unroll
                for (int j = 0; j < 4; ++j) { const float g0 = acc[ai][0][m][0][j] * sc, g1 = acc[ai][0][m][1][j] * sc;
                    v0[j] = g0 * fsig(g0) * (acc[ai][1][m][0][j] * sc); v1[j] = g1 * fsig(g1) * (acc[ai][1][m][1][j] * sc); }
                *(u32x4*)(ACT + row * 5632 + c0) = pack8(v0, v1); }
    }
};
__device__ __forceinline__ void p0_transpose_item(const float* W, int K, int N, const float* scale, bf16* WT, int drow0, int k0, int n0, LAS float* scr, int lane) {
    float v[32];
#pragma unroll
    for (int i = 0; i < 32; ++i) { const int kk = 2 * i + (lane >> 5); v[i] = W[(size_t)(k0 + kk) * N + n0 + (lane & 31)]; }
    if (scale) {
#pragma unroll
        for (int i = 0; i < 32; ++i) v[i] *= scale[k0 + 2 * i + (lane >> 5)]; }
#pragma unroll
    for (int i = 0; i < 32; ++i) scr[(2 * i + (lane >> 5)) * 33 + (lane & 31)] = v[i];
    LDS_WAIT(); asm volatile("" ::: "memory");
    const int c = lane & 7;
#pragma unroll
    for (int j = 0; j < 4; ++j) { const int n = (lane >> 3) + 8 * j; const LAS float* s = scr + (8 * c) * 33 + n;
        v4u o; o.x = pk2(s[0 * 33], s[1 * 33]); o.y = pk2(s[2 * 33], s[3 * 33]); o.z = pk2(s[4 * 33], s[5 * 33]); o.w = pk2(s[6 * 33], s[7 * 33]);
        *(GAS v4u*)(WT + (size_t)(drow0 + n) * K + k0 + 8 * c) = o; }
    LDS_WAIT(); asm volatile("" ::: "memory");
}
constexpr int I_IN = 32 * 288, I_A = 16 * 64, I_B = 16 * 64, I_O = 32 * 64, I_GU = 32 * 352, I_D = 88 * 64, I_L = I_IN + I_A + I_B + I_O + I_GU + I_D;
__device__ __forceinline__ void p0_weights(Frame& F, int l, int slot, int nslots, int it_lo, int it_hi) {
    const int lane = opq(F.tid) & 63;
    LAS float* scr = (LAS float*)(F.lds + F.wave * 16384); unsigned char* wl = F.ws + W_WL + (size_t)l * WL_STRIDE;
    for (int it = it_lo + slot; it < it_hi; it += nslots) {
        int r = it;
        if (r < I_IN) { const int kb = r / 288, nb = r % 288; p0_transpose_item(F.win + (size_t)l * DM * NIN, DM, NIN, F.nmix + l * DM, (bf16*)(wl + WL_IN), nb * 32, kb * 64, nb * 32, scr, lane); continue; } r -= I_IN;
        if (r < I_A) { const int kb = r / 64, nb = r % 64; p0_transpose_item(F.wa + (size_t)l * 1024 * DM, 1024, DM, nullptr, (bf16*)(wl + WL_A), nb * 32, kb * 64, nb * 32, scr, lane); continue; } r -= I_A;
        if (r < I_B) { const int kb = r / 64, nb = r % 64; p0_transpose_item(F.wb + (size_t)l * 1024 * DM, 1024, DM, nullptr, (bf16*)(wl + WL_B), nb * 32, kb * 64, nb * 32, scr, lane); continue; } r -= I_B;
        if (r < I_O) { const int kb = r / 64, nb = r % 64; p0_transpose_item(F.wout + (size_t)l * DM * DM, DM, DM, nullptr, (bf16*)(wl + WL_OUT), nb * 32, kb * 64, nb * 32, scr, lane); continue; } r -= I_O;
        if (r < I_GU) { const int kb = r / 352, nb = r % 352; const int n0 = nb * 32; const int j0 = n0 < FF ? n0 : n0 - FF;
            const int drow = (j0 >> 7) * 256 + (n0 < FF ? 0 : 128) + (j0 & 127);
            p0_transpose_item(F.wgu + (size_t)l * DM * NGU, DM, NGU, F.nffn + l * DM, (bf16*)(wl + WL_GU), drow, kb * 64, n0, scr, lane); continue; } r -= I_GU;
        { const int kb = r / 64, nb = r % 64; p0_transpose_item(F.wd + (size_t)l * FF * DM, FF, DM, nullptr, (bf16*)(wl + WL_D), nb * 32, kb * 64, nb * 32, scr, lane); }
    }
}
constexpr int L1_R0 = 4608, L1_R1 = 11008, L1_R2 = 19712, L1_R3 = 28416;
__device__ __forceinline__ void p0_late_weights(Frame& F, int first_idle, int it_lo, int it_hi) {
    if (F.G != 256 || (int)blockIdx.x < first_idle) return;
    p0_weights(F, 1, ((int)blockIdx.x - first_idle) * NWAVES + F.wave, (256 - first_idle) * NWAVES, it_lo, it_hi);
}
__device__ __forceinline__ void p0_prologue(Frame& F) {
    F.tid = opq(F.tid); F.lane = F.tid & 63;
    const int gw = F.vcu * NWAVES + F.wave, NGW = F.G * NWAVES;
    p0_weights(F, 0, gw, NGW, 0, I_L);
    p0_weights(F, 1, gw, NGW, 0, F.G == 256 ? L1_R0 : I_L);
    bf16* HB = (bf16*)(F.ws + W_HB); float* SS = (float*)(F.ws + W_SS);
    for (int m = gw; m < M; m += NGW) {
        const float* xr = (m < MP) ? F.xp + (size_t)m * DM : F.xs + (size_t)(m - MP) * DM; float q = 0.f;
#pragma unroll
        for (int j = 0; j < 8; ++j) { const f32x4 v = *(const f32x4*)(xr + j * 256 + F.lane * 4); q += (v[0] * v[0] + v[1] * v[1]) + (v[2] * v[2] + v[3] * v[3]);
            u32x2 w; w.x = cvtpk(v[0], v[1]); w.y = cvtpk(v[2], v[3]); *(u32x2*)(HB + (size_t)m * DM + j * 256 + F.lane * 4) = w; }
        q = wave_sum(q);
        if (F.lane < 32) SS[(size_t)m * 32 + F.lane] = F.lane == 0 ? q : 0.f;
    }
    bf16* WM = (bf16*)(F.ws + W_WM);
    for (int i = (F.vcu * NWAVES + F.wave) * 64 + F.lane; i < 2 * 2 * 8 * 128 * 128; i += NGW * 64) {
        const int s = i & 127, t = (i >> 7) & 127, g = (i >> 14) & 7, kind = (i >> 17) & 1, l = i >> 18;
        const float* w = F.wsp + ((size_t)l * 8 + g) * 16384; float v;
        if (kind == 0) v = ((s >> 6) <= (t >> 6)) ? w[t * 128 + s] : 0.f; else v = ((s >> 6) == (t >> 6)) ? w[(t & 63) * 128 + (s & 63)] : 0.f;
        WM[i] = (bf16)f2bf(v);
    }
}
template <int MODE>
__device__ __forceinline__ void p_fixup(Frame& F, const float* base_p, const float* base_s, int write_hb) {
    if (F.G != TAIL_F) return;
    const int tid = opq(F.tid), c = (int)blockIdx.x, q = c & 3; int pm, pn; tile_of(TAIL_F + (c >> 2), 40, 8, pm, pn);
    const float* slab = (const float*)(F.ws + W_SLAB) + (size_t)(c & ~3) * 65536;
    const int col = q * 64 + (tid & 15) * 4, gcol = pn * 256 + col; float* H = F.out + OUT_Y; bf16* HB = (bf16*)(F.ws + W_HB); bf16* MG = (bf16*)(F.ws + W_MG); float* SS = (float*)(F.ws + W_SS);
    const float* bb = (pm < 32) ? base_p : (base_s - (size_t)MP * 2048);
#pragma unroll
    for (int hb = 0; hb < 2; ++hb) { f32x4 s[4][4], bs[4];
#pragma unroll
        for (int i = 0; i < 4; ++i) { const int r = (tid >> 4) + 32 * (hb * 4 + i);
#pragma unroll
            for (int k = 0; k < 4; ++k) s[i][k] = *(const f32x4*)(slab + (size_t)k * 65536 + r * 256 + col);
            if (MODE == 0) bs[i] = *(const f32x4*)(bb + (size_t)(pm * 256 + r) * 2048 + gcol); }
#pragma unroll
        for (int i = 0; i < 4; ++i) { const int r = (tid >> 4) + 32 * (hb * 4 + i); const size_t o = (size_t)(pm * 256 + r) * 2048 + gcol;
            f32x4 v = (s[i][0] + s[i][1]) + (s[i][2] + s[i][3]);
            if (MODE == 0) { v = v + bs[i]; *(f32x4*)(H + o) = v; if (write_hb) { u32x2 w; w.x = cvtpk(v[0], v[1]); w.y = cvtpk(v[2], v[3]); *(u32x2*)(HB + o) = w; }
                float qq = (v[0] * v[0] + v[1] * v[1]) + (v[2] * v[2] + v[3] * v[3]); qq += __shfl_xor(qq, 1); qq += __shfl_xor(qq, 2); qq += __shfl_xor(qq, 4); qq += __shfl_xor(qq, 8);
                if ((tid & 15) == 0) SS[(size_t)(pm * 256 + r) * 32 + pn * 4 + q] = qq; }
            else { u32x2 w; w.x = cvtpk(v[0], v[1]); w.y = cvtpk(v[2], v[3]); *(u32x2*)(MG + o) = w; } } }
}
__device__ __forceinline__ void p_final(Frame& F, float dbg_scale_sample) {
    F.tid = opq(F.tid); F.lane = F.tid & 63;
    const int gw = F.vcu * NWAVES + F.wave, NGW = F.G * NWAVES; const float* SS = (const float*)(F.ws + W_SS);
    for (int m = gw; m < M; m += NGW) {
        float t = F.lane < 32 ? SS[(size_t)m * 32 + F.lane] : 0.f; t = wave_sum(t); float r = __builtin_amdgcn_rsqf(t * (1.0f / 2048.0f) + EPS); if (m >= MP) r *= dbg_scale_sample;
        float* h = F.out + OUT_Y + (size_t)m * DM;
#pragma unroll
        for (int j = 0; j < 8; ++j) { const int c = j * 256 + F.lane * 4; const f32x4 v = *(const f32x4*)(h + c), g = *(const f32x4*)(F.nfin + c); *(f32x4*)(h + c) = v * r * g; }
    }
}
constexpr int A_VOFF = 0, A_KOFF = 32768, A_TILE = 16384;
#define KSWZ(row, colB) ((row) * 256 + ((colB) ^ (((row) & 7) << 4)))
#define SBAR() __builtin_amdgcn_sched_barrier(0)
__device__ __forceinline__ int crow(int r, int hi) { return (r & 3) + 8 * (r >> 2) + 4 * hi; }
__device__ __forceinline__ int v_st(int k, int c) { const int kk = (k & ~0xC) | ((k & 4) << 1) | ((k & 8) >> 1); return ((kk >> 3) * 4 + (c >> 5)) * 512 + ((kk & 7) * 32 + (c & 31)) * 2; }
__device__ __forceinline__ int v_rd_base(int lane) { return ((lane & 3) << 3) | (((lane >> 2) & 3) << 6) | (((lane >> 4) & 1) << 5) | (((lane >> 5) & 1) << 8); }
constexpr int v_rd_off(int d0, int ks, int half) { return d0 * 512 + ks * 4096 + half * 2048; }
template <int OFF> __device__ __forceinline__ s16x4 tr_read(int vb) { s16x4 r; asm volatile("ds_read_b64_tr_b16 %0, %1 offset:%2" : "=&v"(r) : "v"(vb), "i"(OFF) : "memory"); return r; }
template <int D0> __device__ __forceinline__ void pv_one(f32x16& od, int vb, bf16x8 pa0, bf16x8 pa1, bf16x8 pa2, bf16x8 pa3) {
    const s16x4 l0 = tr_read<v_rd_off(D0, 0, 0)>(vb), h0 = tr_read<v_rd_off(D0, 0, 1)>(vb), l1 = tr_read<v_rd_off(D0, 1, 0)>(vb), h1 = tr_read<v_rd_off(D0, 1, 1)>(vb);
    const s16x4 l2 = tr_read<v_rd_off(D0, 2, 0)>(vb), h2 = tr_read<v_rd_off(D0, 2, 1)>(vb), l3 = tr_read<v_rd_off(D0, 3, 0)>(vb), h3 = tr_read<v_rd_off(D0, 3, 1)>(vb);
    asm volatile("s_waitcnt lgkmcnt(0)" ::: "memory"); SBAR();
#define PK(L, H) (bf16x8){L[0], L[1], L[2], L[3], H[0], H[1], H[2], H[3]}
    od = __builtin_amdgcn_mfma_f32_32x32x16_bf16(pa0, PK(l0, h0), od, 0, 0, 0);
    od = __builtin_amdgcn_mfma_f32_32x32x16_bf16(pa1, PK(l1, h1), od, 0, 0, 0);
    od = __builtin_amdgcn_mfma_f32_32x32x16_bf16(pa2, PK(l2, h2), od, 0, 0, 0);
    od = __builtin_amdgcn_mfma_f32_32x32x16_bf16(pa3, PK(l3, h3), od, 0, 0, 0);
#undef PK
}
__device__ __forceinline__ void qkt(f32x16& p0, f32x16& p1, const LAS unsigned char* Ks, const bf16x8 (&qr)[8], int r32, int hi) {
    p0 = f32x16{}; p1 = f32x16{};
#pragma unroll
    for (int d0 = 0; d0 < 8; ++d0) { const int cb = (d0 * 16 + hi * 8) * 2;
        const bf16x8 b0 = *(const LAS bf16x8*)(Ks + KSWZ(r32, cb)); const bf16x8 b1 = *(const LAS bf16x8*)(Ks + KSWZ(32 + r32, cb));
        p0 = __builtin_amdgcn_mfma_f32_32x32x16_bf16(b0, qr[d0], p0, 0, 0, 0); p1 = __builtin_amdgcn_mfma_f32_32x32x16_bf16(b1, qr[d0], p1, 0, 0, 0); }
}
__device__ __forceinline__ void sb_half(f32x16& p, float& R, int hi, bool need_mask, int kpos0, int qpos) {
    f32x16 st;
#pragma unroll
    for (int r = 0; r < 16; ++r) { const float zz = fmaxf(p[r], -120.f); const float e = __builtin_amdgcn_exp2f(-zz); float bt = __builtin_amdgcn_rcpf(1.f + e); float s = e * bt;
        if (need_mask) { const bool valid = (kpos0 + crow(r, hi)) < qpos; s = valid ? s : 1.f; bt = valid ? bt : 0.f; }
        p[r] = bt; st[r] = s; }
    float x1[4], x2[4], x3[4], c[4], f[4];
#pragma unroll
    for (int q = 0; q < 4; ++q) { x3[q] = st[4 * q + 3]; x2[q] = x3[q] * st[4 * q + 2]; x1[q] = x2[q] * st[4 * q + 1]; const float pq = x1[q] * st[4 * q];
        const auto rr = __builtin_amdgcn_permlane32_swap(__float_as_uint(pq), __float_as_uint(pq), false, false);
        const float v0 = __uint_as_float(rr[0]), v1 = __uint_as_float(rr[1]); c[q] = v0 * v1; f[q] = hi ? 1.f : v1; }
    const float S3 = R, S2 = S3 * c[3], S1 = S2 * c[2], S0 = S1 * c[1]; R = S0 * c[0];
    R = R < 7.8886e-31f ? 0.f : R;
    const float T[4] = {S0 * f[0], S1 * f[1], S2 * f[2], S3 * f[3]};
#pragma unroll
    for (int q = 0; q < 4; ++q) { p[4 * q + 3] *= T[q]; p[4 * q + 2] *= T[q] * x3[q]; p[4 * q + 1] *= T[q] * x2[q]; p[4 * q] *= T[q] * x1[q]; }
}
#define PK4(P, BASE, OUT) do { const unsigned a0 = cvtpk(P[BASE + 0], P[BASE + 1]), a1 = cvtpk(P[BASE + 2], P[BASE + 3]);   \
    const unsigned b0 = cvtpk(P[BASE + 4], P[BASE + 5]), b1 = cvtpk(P[BASE + 6], P[BASE + 7]);                              \
    const auto r0 = __builtin_amdgcn_permlane32_swap(a0, b0, false, false); const auto r1 = __builtin_amdgcn_permlane32_swap(a1, b1, false, false); \
    u32x4 w_ = {r0[0], r1[0], r0[1], r1[1]}; OUT = *reinterpret_cast<bf16x8*>(&w_); } while (0)
template <bool SAMPLE>
__device__ __forceinline__ void attn_unit(Frame& F, int l, int b, int h, int qb) {
    const int tid = opq(F.tid), wid = F.wave, lane = tid & 63, r32 = lane & 31, hi = lane >> 5;
    const LAS unsigned char* Kl = F.lds + A_KOFF; LAS unsigned char* Vl = F.lds + A_VOFF;
    const bool active = SAMPLE ? (wid < 2) : true;
    const int nt = SAMPLE ? 33 : 4 * qb + 4;
    const int wrow_lo = SAMPLE ? 2048 + 32 * wid : 256 * qb + 32 * wid;
    const int qpos = wrow_lo + r32;
    const size_t qrow = SAMPLE ? (size_t)(MP + b * 64 + 32 * wid + r32) : (size_t)(b * 2048 + qpos);
    const bf16* Qp = (const bf16*)(F.ws + W_Q) + qrow * 1024 + h * 128 + hi * 8;
    bf16x8 qr[8];
    if (active) {
#pragma unroll
        for (int d0 = 0; d0 < 8; ++d0) qr[d0] = *(const bf16x8*)(Qp + d0 * 16);
    } else {
#pragma unroll
        for (int d0 = 0; d0 < 8; ++d0) qr[d0] = bf16x8{};
    }
    f32x16 o[4] = {}; float R = 1.f;
    const int sr = tid >> 4, sc = (tid & 15) * 8, vst0 = v_st(sr, sc), vst1 = v_st(32 + sr, sc);
    const int vb0 = (int)(unsigned)(uintptr_t)Vl + v_rd_base(lane);
    const bf16* Kb = (const bf16*)(F.ws + W_K); const bf16* Vb = (const bf16*)(F.ws + W_V);
    const float* nk = F.out + OUT_KS + ((size_t)(l * 32 + b) * 64) * 1024 + h * 128; const float* nv = F.out + OUT_VS + ((size_t)(l * 32 + b) * 64) * 1024 + h * 128;
    const float* ckb = F.ck + ((size_t)(l * 32 + b) * 2048) * 1024 + h * 128; const float* cvb = F.cv + ((size_t)(l * 32 + b) * 2048) * 1024 + h * 128;
#define TILE_POS(j) (SAMPLE ? ((j) == 0 ? 2048 : 2048 - 64 * (j)) : 64 * (nt - 1 - (j)))
    f32x8v fk0, fk1, fv0, fv1; bf16x8 bk0, bk1, bv0, bv1;
#define SLOAD(j) do { if constexpr (SAMPLE) { const float* kp = (j) == 0 ? nk : ckb + (size_t)(2048 - 64 * (j)) * 1024; const float* vp = (j) == 0 ? nv : cvb + (size_t)(2048 - 64 * (j)) * 1024; \
        fk0 = *(const f32x8v*)(kp + (size_t)sr * 1024 + sc); fk1 = *(const f32x8v*)(kp + (size_t)(32 + sr) * 1024 + sc); fv0 = *(const f32x8v*)(vp + (size_t)sr * 1024 + sc); fv1 = *(const f32x8v*)(vp + (size_t)(32 + sr) * 1024 + sc); } \
    else { const size_t ro = ((size_t)(b * 2048 + TILE_POS(j) + sr)) * 1024 + h * 128 + sc; bk0 = *(const bf16x8*)(Kb + ro); bk1 = *(const bf16x8*)(Kb + ro + 32 * 1024); bv0 = *(const bf16x8*)(Vb + ro); bv1 = *(const bf16x8*)(Vb + ro + 32 * 1024); } } while (0)
#define TOBF(x) ({ u32x4 w__ = {cvtpk(x[0], x[1]), cvtpk(x[2], x[3]), cvtpk(x[4], x[5]), cvtpk(x[6], x[7])}; *reinterpret_cast<bf16x8*>(&w__); })
#define SWRITE(bufi) do { LAS unsigned char* vd = Vl + (bufi) * A_TILE; LAS unsigned char* kd = (LAS unsigned char*)Kl + (bufi) * A_TILE; const int kc = sc * 2; \
        if constexpr (SAMPLE) { *(LAS bf16x8*)(vd + vst0) = TOBF(fv0); *(LAS bf16x8*)(vd + vst1) = TOBF(fv1); *(LAS bf16x8*)(kd + KSWZ(sr, kc)) = TOBF(fk0); *(LAS bf16x8*)(kd + KSWZ(32 + sr, kc)) = TOBF(fk1); } \
        else { *(LAS bf16x8*)(vd + vst0) = bv0; *(LAS bf16x8*)(vd + vst1) = bv1; *(LAS bf16x8*)(kd + KSWZ(sr, kc)) = bk0; *(LAS bf16x8*)(kd + KSWZ(32 + sr, kc)) = bk1; } } while (0)
    volatile LAS unsigned* dflag = F.MISC + 16;
    SLOAD(0); asm volatile("s_waitcnt vmcnt(0)" ::: "memory"); SWRITE(0); __syncthreads();
    for (int j = 0; j < nt; ++j) {
        if (j > 0) {
            unsigned alld = 1u;
#pragma unroll
            for (int w = 0; w < 8; ++w) alld &= dflag[((j - 1) & 1) * 8 + w];
            if (alld) break;
        }
        if (j + 1 < nt) SLOAD(j + 1);
        const int kpos0 = TILE_POS(j);
        if (active && kpos0 < wrow_lo + 31) {
            f32x16 p0, p1; bf16x8 pa0, pa1, pa2, pa3;
            qkt(p0, p1, Kl + (j & 1) * A_TILE, qr, r32, hi);
            const bool need_mask = !(kpos0 + 63 < wrow_lo);
            sb_half(p1, R, hi, need_mask, kpos0 + 32, qpos);
            sb_half(p0, R, hi, need_mask, kpos0, qpos);
            PK4(p0, 0, pa0); PK4(p0, 8, pa1); PK4(p1, 0, pa2); PK4(p1, 8, pa3);
            const int vb = vb0 + (j & 1) * A_TILE;
            pv_one<0>(o[0], vb, pa0, pa1, pa2, pa3); pv_one<1>(o[1], vb, pa0, pa1, pa2, pa3); pv_one<2>(o[2], vb, pa0, pa1, pa2, pa3); pv_one<3>(o[3], vb, pa0, pa1, pa2, pa3);
        }
        { const bool wdone = !active || __all(R == 0.f); if (lane == 0) dflag[(j & 1) * 8 + wid] = wdone ? 1u : 0u; }
        if (j + 1 < nt) { asm volatile("s_waitcnt vmcnt(0)" ::: "memory"); SWRITE((j + 1) & 1); }
        __syncthreads();
    }
    if (active) {
        bf16* Ow = (bf16*)(F.ws + W_ATT) + (SAMPLE ? (size_t)(MP + b * 64 + 32 * wid) : (size_t)(b * 2048 + wrow_lo)) * 1024 + h * 128 + r32;
#pragma unroll
        for (int r = 0; r < 16; ++r) { const int orow = crow(r, hi);
#pragma unroll
            for (int d0 = 0; d0 < 4; ++d0) Ow[(size_t)orow * 1024 + d0 * 32] = (bf16)f2bf(o[d0][r]); }
    }
#undef SLOAD
#undef SWRITE
#undef TILE_POS
}
__device__ __forceinline__ void sgu_unit(Frame& F, int l, int tile, int g) {
    const int tid = opq(F.tid), wid = F.wave, lane = tid & 63, r32 = lane & 31, hi = lane >> 5;
    const int row0 = tile * 128; const bool samp = row0 >= MP;
    const float* VS = (const float*)(F.ws + W_VS); const float* SSV = (const float*)(F.ws + W_SSV); const bf16* U = (const bf16*)(F.ws + W_U); bf16* BB = (bf16*)(F.ws + W_BB);
    const bf16* WM = (const bf16*)(F.ws + W_WM) + ((size_t)(l * 2 + (samp ? 1 : 0)) * 8 + g) * 16384;
    const int sr = tid >> 4, sc = (tid & 15) * 8, rg = wid & 3, ch = wid >> 2;
    f32x8v vv[4]; f32x4 sl[4][4];
#pragma unroll
    for (int i = 0; i < 4; ++i) { const size_t grow = (size_t)(row0 + sr + 32 * i); vv[i] = *(const f32x8v*)(VS + grow * 1024 + g * 128 + sc);
#pragma unroll
        for (int j = 0; j < 4; ++j) sl[i][j] = *(const f32x4*)(SSV + grow * 16 + j * 4); }
    const f32x8v gv = *(const f32x8v*)(F.sgun + l * 1024 + g * 128 + sc);
    const bf16* wrow = WM + ((size_t)(rg * 32 + r32)) * 128 + hi * 8;
    bf16x8 pa[2][4];
#pragma unroll
    for (int kt = 0; kt < 2; ++kt)
#pragma unroll
        for (int ks = 0; ks < 4; ++ks) pa[kt][ks] = *(const bf16x8*)(wrow + kt * 64 + ks * 16);
    unsigned short uu[16][2]; float bias[16];
#pragma unroll
    for (int r = 0; r < 16; ++r) { const int t = rg * 32 + crow(r, hi); bias[r] = F.bsp[l * 1024 + g * 128 + (samp ? (t & 63) : t)];
#pragma unroll
        for (int i = 0; i < 2; ++i) uu[r][i] = U[(size_t)(row0 + t) * 1024 + g * 128 + (2 * ch + i) * 32 + r32]; }
    float* sgo = F.out + OUT_SG + ((size_t)l * MS) * 1024;
#pragma unroll
    for (int i = 0; i < 4; ++i) { const int s = sr + 32 * i; const size_t grow = (size_t)(row0 + s);
        float q = 0.f;
#pragma unroll
        for (int j = 0; j < 4; ++j) q += (sl[i][j][0] + sl[i][j][1]) + (sl[i][j][2] + sl[i][j][3]);
        const float rr = __builtin_amdgcn_rsqf(q * (1.0f / 1024.0f) + EPS); f32x8v v = vv[i];
#pragma unroll
        for (int j = 0; j < 8; ++j) v[j] = v[j] * rr * gv[j];
        if (samp) *(f32x8v*)(sgo + (grow - MP) * 1024 + g * 128 + sc) = v;
        u32x4 w = {cvtpk(v[0], v[1]), cvtpk(v[2], v[3]), cvtpk(v[4], v[5]), cvtpk(v[6], v[7])};
        *(LAS u32x4*)(F.lds + (s >> 6) * A_TILE + v_st(s & 63, sc)) = w; }
    __syncthreads();
    const int vb0 = (int)(unsigned)(uintptr_t)F.lds + v_rd_base(lane);
    f32x16 o2[2] = {};
#pragma unroll
    for (int kt = 0; kt < 2; ++kt) { const int vb = vb0 + kt * A_TILE;
        if (ch == 0) { pv_one<0>(o2[0], vb, pa[kt][0], pa[kt][1], pa[kt][2], pa[kt][3]); pv_one<1>(o2[1], vb, pa[kt][0], pa[kt][1], pa[kt][2], pa[kt][3]); }
        else { pv_one<2>(o2[0], vb, pa[kt][0], pa[kt][1], pa[kt][2], pa[kt][3]); pv_one<3>(o2[1], vb, pa[kt][0], pa[kt][1], pa[kt][2], pa[kt][3]); } }
#pragma unroll
    for (int r = 0; r < 16; ++r) { const int t = rg * 32 + crow(r, hi);
#pragma unroll
        for (int i = 0; i < 2; ++i) { const size_t off = (size_t)(row0 + t) * 1024 + g * 128 + (2 * ch + i) * 32 + r32;
            BB[off] = (bf16)f2bf(__uint_as_float(((unsigned)uu[r][i]) << 16) * (o2[i][r] + bias[r])); } }
    __syncthreads();
}
template <bool SAMPLE>
__device__ __forceinline__ void attn_item(Frame& F, int l, int item, LAS unsigned char* pl) {
    const int lane = opq(F.tid) & 63, r32 = lane & 31, hi = lane >> 5;
    int b, h, rg, nt, wrow_lo; size_t qrow0;
    if (SAMPLE) { rg = item & 1; h = (item >> 1) & 7; b = item >> 4; nt = 33; wrow_lo = 2048 + 32 * rg; qrow0 = (size_t)(MP + b * 64 + 32 * rg); }
    else { rg = item & 63; h = (item >> 6) & 7; b = item >> 9; nt = (rg >> 1) + 1; wrow_lo = 32 * rg; qrow0 = (size_t)(b * 2048 + 32 * rg); }
    const int qpos = wrow_lo + r32;
    const bf16* Qp = (const bf16*)(F.ws + W_Q) + (qrow0 + r32) * 1024 + h * 128 + hi * 8;
    bf16x8 qr[8];
#pragma unroll
    for (int d0 = 0; d0 < 8; ++d0) qr[d0] = *(const bf16x8*)(Qp + d0 * 16);
    f32x16 o[4] = {}; float R = 1.f;
    const bf16* Kb = (const bf16*)(F.ws + W_K) + (size_t)b * 2048 * 1024 + h * 128; const bf16* Vb = (const bf16*)(F.ws + W_V) + (size_t)b * 2048 * 1024 + h * 128;
    const float* nk = F.out + OUT_KS + ((size_t)(l * 32 + b) * 64) * 1024 + h * 128; const float* nv = F.out + OUT_VS + ((size_t)(l * 32 + b) * 64) * 1024 + h * 128;
    const float* ckb = F.ck + ((size_t)(l * 32 + b) * 2048) * 1024 + h * 128; const float* cvb = F.cv + ((size_t)(l * 32 + b) * 2048) * 1024 + h * 128;
    const int vb = (int)(unsigned)(uintptr_t)pl + v_rd_base(lane);
    const int vrow = lane >> 4, vcol = (lane & 15) * 8;
    for (int j = 0; j < nt; ++j) {
        if (j > 0 && __all(R == 0.f)) break;
        const int kpos0 = SAMPLE ? (j == 0 ? 2048 : 2048 - 64 * j) : 64 * (nt - 1 - j);
        const bool need_mask = !(kpos0 + 63 < wrow_lo);
        f32x16 p0 = {}, p1 = {};
        if constexpr (SAMPLE) {
            const float* kp = (j == 0 ? nk : ckb + (size_t)kpos0 * 1024) + (size_t)r32 * 1024 + hi * 8;
#pragma unroll
            for (int half = 0; half < 2; ++half) { f32x8v kf[8];
#pragma unroll
                for (int d0 = 0; d0 < 8; ++d0) kf[d0] = *(const f32x8v*)(kp + (size_t)half * 32 * 1024 + d0 * 16);
#pragma unroll
                for (int d0 = 0; d0 < 8; ++d0) { const u32x4 w = {cvtpk(kf[d0][0], kf[d0][1]), cvtpk(kf[d0][2], kf[d0][3]), cvtpk(kf[d0][4], kf[d0][5]), cvtpk(kf[d0][6], kf[d0][7])};
                    if (half == 0) p0 = __builtin_amdgcn_mfma_f32_32x32x16_bf16(*reinterpret_cast<const bf16x8*>(&w), qr[d0], p0, 0, 0, 0);
                    else p1 = __builtin_amdgcn_mfma_f32_32x32x16_bf16(*reinterpret_cast<const bf16x8*>(&w), qr[d0], p1, 0, 0, 0); } }
        } else {
            const bf16* kp = Kb + (size_t)(kpos0 + r32) * 1024 + hi * 8; bf16x8 k0[8], k1[8];
#pragma unroll
            for (int d0 = 0; d0 < 8; ++d0) { k0[d0] = *(const bf16x8*)(kp + d0 * 16); k1[d0] = *(const bf16x8*)(kp + 32 * 1024 + d0 * 16); }
#pragma unroll
            for (int d0 = 0; d0 < 8; ++d0) { p0 = __builtin_amdgcn_mfma_f32_32x32x16_bf16(k0[d0], qr[d0], p0, 0, 0, 0); p1 = __builtin_amdgcn_mfma_f32_32x32x16_bf16(k1[d0], qr[d0], p1, 0, 0, 0); }
        }
        bf16x8 vv[16]; f32x8v vf[8];
        if constexpr (!SAMPLE) { const bf16* vp = Vb + (size_t)(kpos0 + vrow) * 1024 + vcol;
#pragma unroll
            for (int i = 0; i < 16; ++i) vv[i] = *(const bf16x8*)(vp + (size_t)(4 * i) * 1024); }
        const float* vpf = SAMPLE ? (j == 0 ? nv : cvb + (size_t)kpos0 * 1024) + (size_t)vrow * 1024 + vcol : nullptr;
        if constexpr (SAMPLE) {
#pragma unroll
            for (int i = 0; i < 8; ++i) vf[i] = *(const f32x8v*)(vpf + (size_t)(4 * i) * 1024); }
        sb_half(p1, R, hi, need_mask, kpos0 + 32, qpos);
        sb_half(p0, R, hi, need_mask, kpos0, qpos);
        bf16x8 pa0, pa1, pa2, pa3;
        PK4(p0, 0, pa0); PK4(p0, 8, pa1); PK4(p1, 0, pa2); PK4(p1, 8, pa3);
        if constexpr (!SAMPLE) {
#pragma unroll
            for (int i = 0; i < 16; ++i) *(LAS bf16x8*)(pl + v_st(vrow + 4 * i, vcol)) = vv[i];
        } else {
#pragma unroll
            for (int i = 0; i < 8; ++i) { const u32x4 w = {cvtpk(vf[i][0], vf[i][1]), cvtpk(vf[i][2], vf[i][3]), cvtpk(vf[i][4], vf[i][5]), cvtpk(vf[i][6], vf[i][7])}; *(LAS u32x4*)(pl + v_st(vrow + 4 * i, vcol)) = w; }
#pragma unroll
            for (int i = 0; i < 8; ++i) vf[i] = *(const f32x8v*)(vpf + (size_t)(32 + 4 * i) * 1024);
#pragma unroll
            for (int i = 0; i < 8; ++i) { const u32x4 w = {cvtpk(vf[i][0], vf[i][1]), cvtpk(vf[i][2], vf[i][3]), cvtpk(vf[i][4], vf[i][5]), cvtpk(vf[i][6], vf[i][7])}; *(LAS u32x4*)(pl + v_st(32 + vrow + 4 * i, vcol)) = w; }
        }
        asm volatile("s_waitcnt lgkmcnt(0)" ::: "memory");
        pv_one<0>(o[0], vb, pa0, pa1, pa2, pa3); pv_one<1>(o[1], vb, pa0, pa1, pa2, pa3); pv_one<2>(o[2], vb, pa0, pa1, pa2, pa3); pv_one<3>(o[3], vb, pa0, pa1, pa2, pa3);
        asm volatile("" ::: "memory");
    }
#pragma unroll
    for (int r = 0; r < 16; ++r) { const int orow = crow(r, hi);
#pragma unroll
        for (int d0 = 0; d0 < 4; ++d0) *(LAS unsigned short*)(pl + orow * 272 + (d0 * 32 + r32) * 2) = (unsigned short)f2bf(o[d0][r]); }
    asm volatile("s_waitcnt lgkmcnt(0)" ::: "memory");
    bf16* Ow = (bf16*)(F.ws + W_ATT) + qrow0 * 1024 + h * 128;
#pragma unroll
    for (int i = 0; i < 8; ++i) { const int idx = lane + 64 * i, row = idx >> 4, c16 = idx & 15; const u32x4 w = *(const LAS u32x4*)(pl + row * 272 + c16 * 16); *(u32x4*)(Ow + (size_t)row * 1024 + c16 * 8) = w; }
    asm volatile("s_waitcnt lgkmcnt(0)" ::: "memory");
}
__device__ __forceinline__ int v_st_c(int k, int c) { const int kk = (k & ~0xC) | ((k & 4) << 1) | ((k & 8) >> 1); return (kk >> 3) * 512 + ((kk & 7) * 32 + c) * 2; }
template <int KT> __device__ __forceinline__ void pv_c(f32x16& od, int vb, bf16x8 pa0, bf16x8 pa1, bf16x8 pa2, bf16x8 pa3) {
    const s16x4 l0 = tr_read<KT * 4096 + 0>(vb), h0 = tr_read<KT * 4096 + 512>(vb), l1 = tr_read<KT * 4096 + 1024>(vb), h1 = tr_read<KT * 4096 + 1536>(vb);
    const s16x4 l2 = tr_read<KT * 4096 + 2048>(vb), h2 = tr_read<KT * 4096 + 2560>(vb), l3 = tr_read<KT * 4096 + 3072>(vb), h3 = tr_read<KT * 4096 + 3584>(vb);
    asm volatile("s_waitcnt lgkmcnt(0)" ::: "memory"); SBAR();
#define PK(L, H) (bf16x8){L[0], L[1], L[2], L[3], H[0], H[1], H[2], H[3]}
    od = __builtin_amdgcn_mfma_f32_32x32x16_bf16(pa0, PK(l0, h0), od, 0, 0, 0);
    od = __builtin_amdgcn_mfma_f32_32x32x16_bf16(pa1, PK(l1, h1), od, 0, 0, 0);
    od = __builtin_amdgcn_mfma_f32_32x32x16_bf16(pa2, PK(l2, h2), od, 0, 0, 0);
    od = __builtin_amdgcn_mfma_f32_32x32x16_bf16(pa3, PK(l3, h3), od, 0, 0, 0);
#undef PK
}
__device__ __forceinline__ void sgu_item(Frame& F, int l, int item, LAS unsigned char* pl) {
    const int lane = opq(F.tid) & 63, r32 = lane & 31, hi = lane >> 5;
    const int cs = item & 3, g = (item >> 2) & 7, tile = item >> 5, row0 = tile * 128; const bool samp = row0 >= MP;
    const int cb = g * 128 + cs * 32;
    const float* VS = (const float*)(F.ws + W_VS); const float* SSV = (const float*)(F.ws + W_SSV); const bf16* U = (const bf16*)(F.ws + W_U); bf16* BB = (bf16*)(F.ws + W_BB);
    const bf16* WM = (const bf16*)(F.ws + W_WM) + ((size_t)(l * 2 + (samp ? 1 : 0)) * 8 + g) * 16384;
    LAS float* rst = (LAS float*)(pl + 8192); LAS float* bia = (LAS float*)(pl + 8704);
    f32x4 sl[2][4];
#pragma unroll
    for (int i = 0; i < 2; ++i)
#pragma unroll
        for (int k = 0; k < 4; ++k) sl[i][k] = *(const f32x4*)(SSV + (size_t)(row0 + lane + 64 * i) * 16 + k * 4);
    const float b0 = F.bsp[l * 1024 + g * 128 + (samp ? (lane & 63) : lane)], b1 = F.bsp[l * 1024 + g * 128 + (samp ? (lane & 63) : lane + 64)];
    const int srow = lane >> 3, col4 = (lane & 7) * 4;
    f32x4 vv[16];
#pragma unroll
    for (int i = 0; i < 16; ++i) vv[i] = *(const f32x4*)(VS + (size_t)(row0 + srow + 8 * i) * 1024 + cb + col4);
    const f32x4 gv = *(const f32x4*)(F.sgun + l * 1024 + cb + col4);
#pragma unroll
    for (int i = 0; i < 2; ++i) { float q = 0.f;
#pragma unroll
        for (int k = 0; k < 4; ++k) q += (sl[i][k][0] + sl[i][k][1]) + (sl[i][k][2] + sl[i][k][3]);
        rst[lane + 64 * i] = __builtin_amdgcn_rsqf(q * (1.0f / 1024.0f) + EPS); }
    bia[lane] = b0; bia[lane + 64] = b1;
    asm volatile("s_waitcnt lgkmcnt(0)" ::: "memory");
    float* sgo = F.out + OUT_SG + ((size_t)l * MS) * 1024;
#pragma unroll
    for (int i = 0; i < 16; ++i) { const int s = srow + 8 * i; f32x4 v = vv[i] * rst[s] * gv;
        if (samp) *(f32x4*)(sgo + (size_t)(row0 + s - MP) * 1024 + cb + col4) = v;
        u32x2 w; w.x = cvtpk(v[0], v[1]); w.y = cvtpk(v[2], v[3]); *(LAS u32x2*)(pl + (s >> 6) * 4096 + v_st_c(s & 63, col4)) = w; }
    asm volatile("s_waitcnt lgkmcnt(0)" ::: "memory");
    const int vb = (int)(unsigned)(uintptr_t)pl + v_rd_base(lane);
#pragma unroll
    for (int rg = 0; rg < 4; ++rg) {
        const bf16* wrow = WM + ((size_t)(rg * 32 + r32)) * 128 + hi * 8; bf16x8 pa[2][4];
#pragma unroll
        for (int kt = 0; kt < 2; ++kt)
#pragma unroll
            for (int ks = 0; ks < 4; ++ks) pa[kt][ks] = *(const bf16x8*)(wrow + kt * 64 + ks * 16);
        unsigned short uu[16];
#pragma unroll
        for (int r = 0; r < 16; ++r) uu[r] = U[(size_t)(row0 + rg * 32 + crow(r, hi)) * 1024 + cb + r32];
        f32x16 o2 = {};
        pv_c<0>(o2, vb, pa[0][0], pa[0][1], pa[0][2], pa[0][3]); pv_c<1>(o2, vb, pa[1][0], pa[1][1], pa[1][2], pa[1][3]);
#pragma unroll
        for (int r = 0; r < 16; ++r) { const int t = rg * 32 + crow(r, hi);
            BB[(size_t)(row0 + t) * 1024 + cb + r32] = (bf16)f2bf(__uint_as_float(((unsigned)uu[r]) << 16) * (o2[r] + bia[t])); }
    }
    asm volatile("s_waitcnt lgkmcnt(0)" ::: "memory");
}
#ifdef TIMING
#define P2STAMP(k, bx) do { if (l == 0 && blockIdx.x == (bx) && F.tid == 0) __hip_atomic_store((gu64*)((gu32*)(F.ws + W_CTL) + 2048) + (k), (unsigned long long)wall_clock64(), RLX_AGENT); } while (0)
#else
#define P2STAMP(k, bx) do { } while (0)
#endif
__device__ __forceinline__ void p2_items(Frame& F, int l) {
    LAS unsigned char* pl = F.lds + F.wave * 16384;
    const int gw = F.vcu * NWAVES + F.wave, NGW = F.G * NWAVES;
    if (NGW == 2048) {
        if (gw < 512) { attn_item<true>(F, l, gw, pl); P2STAMP(20, 0); }
        else for (int k = 0; k < 3; ++k) { const int it = (gw - 512) + 1536 * k; if (it < 2048) attn_item<false>(F, l, it, pl); else sgu_item(F, l, it - 2048, pl); P2STAMP(21 + k, 58); }
    } else {
        for (int it = gw; it < 5120; it += NGW) { if (it < 512) attn_item<true>(F, l, it, pl); else if (it < 2560) attn_item<false>(F, l, it - 512, pl); else sgu_item(F, l, it - 2560, pl); }
    }
}
constexpr int N_PHASES = 20, PH_L = 9, PH_FINAL = 19;
#ifndef SPLIT_P3
#define SPLIT_P3 0
#endif
#ifndef SPLIT_P4
#define SPLIT_P4 0
#endif
struct Args { const float* in[17]; float* out; unsigned char* ws; int ph_lo, ph_hi, li, pad; };
__global__ void __launch_bounds__(NWAVES * 64, 2) mk_fwd(Args args) {
    extern __shared__ __attribute__((aligned(16))) unsigned char lds_raw[];
    Frame F;
    F.lds = (LAS unsigned char*)lds_raw; F.MISC = (volatile LAS unsigned*)(F.lds + MISC_OFF);
    F.tid = threadIdx.x; F.lane = F.tid & 63; F.wave = __builtin_amdgcn_readfirstlane(F.tid >> 6);
    F.G = gridDim.x; { const int bx = blockIdx.x; F.vcu = (F.G % 8 == 0) ? (bx % 8) * (F.G / 8) + bx / 8 : bx; }
    F.xp = args.in[0]; F.xs = args.in[1]; F.ck = args.in[2]; F.cv = args.in[3]; F.nmix = args.in[4]; F.win = args.in[5]; F.bgate = args.in[6]; F.sgun = args.in[7]; F.wsp = args.in[8]; F.bsp = args.in[9];
    F.wa = args.in[10]; F.wb = args.in[11]; F.wout = args.in[12]; F.nffn = args.in[13]; F.wgu = args.in[14]; F.wd = args.in[15]; F.nfin = args.in[16];
    F.out = args.out; F.ws = args.ws;
    for (int u = F.tid; u < (LDS_BYTES - LDSCTL_OFF) / 4; u += NWAVES * 64) ((LAS unsigned*)(F.lds + LDSCTL_OFF))[u] = 0u;
    __syncthreads();
    gu32* ctl = (gu32*)(F.ws + W_CTL);
    XcdBarrier bar = xcd_barrier_post((unsigned*)(ctl + CW_BAR) + args.li * XCD_BAR_WORDS, F.MISC + 8);
    const int lo = args.ph_lo, hi = args.ph_hi;
#define IN(k) (lo <= (k) && (k) < hi)
#ifdef TIMING_K
#define STAMP_PTR(p) ((p) == TIMING_K && l == 0 ? (unsigned long long*)(ctl + 3072) : nullptr)
#else
#define STAMP_PTR(p) nullptr
#endif
#ifdef TIMING
#define STAMP(k) do { if (blockIdx.x == 0 && F.tid == 0) __hip_atomic_store((gu64*)(ctl + 2048) + (k), (unsigned long long)wall_clock64(), RLX_AGENT); } while (0)
#else
#define STAMP(k) do { } while (0)
#endif
#define SEAM(k) do { if (IN(k) && IN((k) + 1)) xcd_barrier(bar); STAMP((k) + 1); } while (0)
    unsigned char* ws = F.ws;
    bf16_t* HB = (bf16_t*)(ws + W_HB); float* SS = (float*)(ws + W_SS); float* H = F.out + OUT_Y; float* myslab = (float*)(ws + W_SLAB) + (size_t)blockIdx.x * 65536;
    STAMP(0);
    if (IN(0)) p0_prologue(F);
    SEAM(0);
    for (int l = 0; l < 2; ++l) {
        const int pb = 1 + PH_L * l; unsigned char* wl = ws + W_WL + (size_t)l * WL_STRIDE;
        if (IN(pb)) {
            SchedSimple S{40, 36, F.G, (int)blockIdx.x, 2048, 2048, (const char*)HB, (const char*)(wl + WL_IN), STAMP_PTR(1)};
            EpiIn E{SS, (bf16_t*)(ws + W_Q), (bf16_t*)(ws + W_K), (bf16_t*)(ws + W_V), (bf16_t*)(ws + W_U), (bf16_t*)(ws + W_G), (float*)(ws + W_VS), F.bgate + l * 4096,
                    F.out + OUT_KP + (size_t)l * MP * 1024, F.out + OUT_VP + (size_t)l * MP * 1024, F.out + OUT_KS + (size_t)l * MS * 1024, F.out + OUT_VS + (size_t)l * MS * 1024, (float*)(ws + W_SSV)};
            pg8::gemm_phase<EpiIn, SchedSimple>(F.lds, S, E);
            if (l == 0) p0_late_weights(F, 160, L1_R0, L1_R1);
        }
        SEAM(pb);
        if (IN(pb + 1)) {
            p2_items(F, l);
        }
        SEAM(pb + 1);
        if (IN(pb + 2)) {
            SchedBranch S{40, 8, F.G, (int)blockIdx.x, 1024, 1024, (const char*)(ws + W_ATT), (const char*)(wl + WL_A), (const char*)(ws + W_BB), (const char*)(wl + WL_B), STAMP_PTR(3), SPLIT_P3};
            EpiMerge E{(const bf16_t*)(ws + W_G), (bf16_t*)(ws + W_MG), myslab};
            pg8::gemm_phase<EpiMerge, SchedBranch>(F.lds, S, E);
            if (l == 0) p0_late_weights(F, 64, L1_R1, L1_R2);
        }
        SEAM(pb + 2);
        if (SPLIT_P3) { if (IN(pb + 3)) p_fixup<1>(F, nullptr, nullptr, 0); SEAM(pb + 3); }
        const float* base_p = l == 0 ? F.xp : (const float*)H; const float* base_s = l == 0 ? F.xs : (const float*)(H + (size_t)MP * 2048);
        if (IN(pb + 4)) {
            SchedTail S{40, 8, F.G, (int)blockIdx.x, 2048, 2048, (const char*)(ws + W_MG), (const char*)(wl + WL_OUT), STAMP_PTR(4), SPLIT_P4};
            EpiRes E{base_p, base_s, H, HB, SS, 1, myslab};
            pg8::gemm_phase<EpiRes, SchedTail>(F.lds, S, E);
            if (l == 0) p0_late_weights(F, 64, L1_R2, L1_R3);
        }
        SEAM(pb + 4);
        if (SPLIT_P4) { if (IN(pb + 5)) p_fixup<0>(F, base_p, base_s, 1); SEAM(pb + 5); }
        if (IN(pb + 6)) {
            SchedSimple S{40, 44, F.G, (int)blockIdx.x, 2048, 2048, (const char*)HB, (const char*)(wl + WL_GU), STAMP_PTR(5)};
            EpiGU E{SS, (bf16_t*)(ws + W_ACT)};
            pg8::gemm_phase<EpiGU, SchedSimple>(F.lds, S, E);
            if (l == 0) p0_late_weights(F, 224, L1_R3, I_L);
        }
        SEAM(pb + 6);
        if (IN(pb + 7)) {
            SchedTail S{40, 8, F.G, (int)blockIdx.x, 5632, 5632, (const char*)(ws + W_ACT), (const char*)(wl + WL_D), STAMP_PTR(6), 1};
            EpiRes E{(const float*)H, (const float*)(H + (size_t)MP * 2048), H, HB, SS, l == 0 ? 1 : 0, myslab};
            pg8::gemm_phase<EpiRes, SchedTail>(F.lds, S, E);
        }
        SEAM(pb + 7);
        if (IN(pb + 8)) p_fixup<0>(F, (const float*)H, (const float*)(H + (size_t)MP * 2048), l == 0 ? 1 : 0);
        SEAM(pb + 8);
    }
#ifdef TIMING_K
    if (IN(PH_FINAL)) { const gu64* st = (const gu64*)(ctl + 3072); const float cyc = (float)__hip_atomic_load(st, RLX_AGENT), ns = (float)__hip_atomic_load(st + 1, RLX_AGENT) * 10.f, n = (float)__hip_atomic_load(st + 2, RLX_AGENT);
        const float c1 = rintf(cyc / n / TIMING_QC + TIMING_SHIFT), x = rintf(ns / n / TIMING_QN + TIMING_SHIFT);
        p_final(F, 1.f + c1 * TIMING_S1);
        if (blockIdx.x == 0 && F.tid == 0) F.out[OUT_KS] += x * TIMING_S2; }
#elif defined(TIMING)
    if (IN(PH_FINAL)) { const gu64* st = (const gu64*)(ctl + 2048);
        const float t1 = (float)(__hip_atomic_load(st + TIM_A1, RLX_AGENT) - __hip_atomic_load(st + TIM_A0, RLX_AGENT)) * 0.01f, t2 = (float)(__hip_atomic_load(st + TIM_B1, RLX_AGENT) - __hip_atomic_load(st + TIM_B0, RLX_AGENT)) * 0.01f;
        const float c1 = rintf(t1 / TIMING_Q + TIMING_SHIFT), x = rintf(t2 / TIMING_Q + TIMING_SHIFT);
        p_final(F, 1.f + c1 * 0.002f);
        if (blockIdx.x == 0 && F.tid == 0) F.out[OUT_KS] += x * 0.1f; }
#else
    if (IN(PH_FINAL)) p_final(F, 1.f);
#endif
#undef IN
#undef SEAM
}
static int g_grid = 0;
static inline bool fast_setup() {
    if (g_grid == 0) {
        int dev = 0, cus = 0;
        if (hipGetDevice(&dev) != hipSuccess || hipDeviceGetAttribute(&cus, hipDeviceAttributeMultiprocessorCount, dev) != hipSuccess) { g_grid = -1; return false; }
        if (hipFuncSetAttribute((const void*)mk_fwd, hipFuncAttributeMaxDynamicSharedMemorySize, LDS_BYTES) != hipSuccess) { fprintf(stderr, "hipFuncSetAttribute failed\n"); g_grid = -1; return false; }
        int per_cu = 0; (void)hipOccupancyMaxActiveBlocksPerMultiprocessor(&per_cu, (const void*)mk_fwd, NWAVES * 64, LDS_BYTES); (void)hipGetLastError();
        if (per_cu < 1) fprintf(stderr, "note: occupancy query reports %d\n", per_cu);
        g_grid = cus;
    }
    return g_grid > 0;
}
static inline void fast_launch(hipStream_t stream, void* const* d_in, float* out, unsigned char* wsbase, int lo, int hi, int li) {
    Args a{}; for (int i = 0; i < 17; ++i) a.in[i] = (const float*)d_in[i];
    a.out = out; a.ws = wsbase; a.ph_lo = lo; a.ph_hi = hi; a.li = li; a.pad = 0;
    hipLaunchKernelGGL(mk_fwd, dim3(g_grid), dim3(NWAVES * 64), LDS_BYTES, stream, a);
}
}
extern "C" void kernel_launch(void* const* d_in, const int* in_sizes, int n_in, void* d_out, int out_size, void* d_ws, size_t ws_size, hipStream_t stream) {
    if (!fk::fast_setup()) return;
    if (n_in != 17 || out_size != (int)fk::OUT_N || ws_size < fk::W_END) { fprintf(stderr, "kernel_launch: unexpected shapes (n_in %d out %d ws %zu)\n", n_in, out_size, ws_size); return; }
    (void)hipMemsetAsync((char*)d_ws + fk::W_CTL, 0, fk::CTL_ZERO_BYTES, stream);
#if defined(PROBE_DUP)
    fk::fast_launch(stream, d_in, (float*)d_out, (unsigned char*)d_ws, 0, PROBE_DUP + 1, 0);
    fk::fast_launch(stream, d_in, (float*)d_out, (unsigned char*)d_ws, PROBE_DUP, fk::N_PHASES, 1);
#elif MK_N_LAUNCHES == 1
    fk::fast_launch(stream, d_in, (float*)d_out, (unsigned char*)d_ws, 0, fk::N_PHASES, 0);
#else
    for (int p = 0; p < fk::N_PHASES; ++p) fk::fast_launch(stream, d_in, (float*)d_out, (unsigned char*)d_ws, p, p + 1, p);
#endif
}
```

```cpp
#include <hip/hip_runtime.h>
#include <cstdio>
#include <cstdint>
#ifndef MK_N_LAUNCHES
#define MK_N_LAUNCHES 1
#endif
namespace pg8 {
#define PG8_LAS __attribute__((address_space(3)))
typedef unsigned short bf16_t;
typedef short bf16x8 __attribute__((ext_vector_type(8)));
typedef float f32x4 __attribute__((ext_vector_type(4)));
typedef unsigned u32x4 __attribute__((ext_vector_type(4)));
constexpr int BM = 256, BK = 64, HALF = 128, HTB = HALF * BK * 2  , STAGE_BYTES = 8 * HTB, NXCD = 8, WGM = 8;

__host__ __device__ __forceinline__ int lds_byte(int r, int c) { const int st = (r >> 4) * 2 + (c >> 5), rr = r & 15, cc = c & 31, ob = rr * 64 + cc * 2; return st * 1024 + (ob ^ (((ob >> 9) & 1) << 5)); }
__host__ __device__ __forceinline__ void stage_rc(int b, int& R, int& C) { const int st = b / 1024, sb = b % 1024, swz = sb ^ (((sb >> 9) & 1) << 5); R = (st >> 1) * 16 + swz / 64; C = (st & 1) * 32 + (swz % 64) / 2; }
__host__ __device__ __forceinline__ int perm32(int rho) { const int n = rho >> 4, i = rho & 15; return 8 * (i >> 2) + 4 * n + (i & 3); }

struct Unit { int pm, pn, br; };
template <class Epi, class Sched, bool ALIGN_EPI = true, bool SP2 = true>
__device__ __forceinline__ void gemm_phase(PG8_LAS unsigned char* lds, const Sched& S, const Epi& E) {
    int tid_ = threadIdx.x; asm volatile("" : "+v"(tid_));
    const int tid = tid_, wid = __builtin_amdgcn_readfirstlane(tid >> 6), lane = tid & 63, wr = wid >> 2, wc = wid & 3, fr = lane & 15, fq = lane >> 4;
    const int K = S.K;
    unsigned voffA[2], voffB[2];
#pragma unroll
    for (int i = 0; i < 2; ++i) { int R, C; stage_rc(tid * 16 + i * 8192, R, C); const int Rb = Epi::PERM ? ((R & ~31) + perm32(R & 31)) : R;
        voffA[i] = (unsigned)(R * K + C) * 2u; voffB[i] = (unsigned)(Rb * K + C) * 2u; }
    const size_t kstep = (size_t)(BK * 2);
    const size_t hstep = (size_t)HALF * K * 2;
        const unsigned ldsw = (unsigned)wid * 1024u;
    const int aoff = lds_byte(wr * 64 + fr, fq * 8), boff = lds_byte(wc * 32 + fr, fq * 8);
#define PG8_SA(b, h) (((b) * 2 + (h)) * HTB)
#define PG8_SB(b, h) ((4 + (b) * 2 + (h)) * HTB)
#define PG8_STAGE(bufoff, gbase, voff) do { _Pragma("unroll") for (int _i = 0; _i < 2; ++_i) \
        __builtin_amdgcn_global_load_lds((const unsigned*)((const char*)(gbase) + (voff)[_i]), (PG8_LAS unsigned*)(lds + (bufoff) + ldsw + _i * 8192), 16, 0, 0); } while (0)
#define PG8_LDA(dst, b, h) do { _Pragma("unroll") for (int m = 0; m < 4; ++m) _Pragma("unroll") for (int k = 0; k < 2; ++k) dst[m][k] = *(const PG8_LAS bf16x8*)(lds + PG8_SA(b, h) + aoff + m * 2048 + k * 1024); } while (0)
#define PG8_LDB(dst, b, h) do { _Pragma("unroll") for (int n = 0; n < 2; ++n) _Pragma("unroll") for (int k = 0; k < 2; ++k) dst[n][k] = *(const PG8_LAS bf16x8*)(lds + PG8_SB(b, h) + boff + n * 2048 + k * 1024); } while (0)
#define PG8_MMA(ai, bj, At, Bt) do { __builtin_amdgcn_s_setprio(1); _Pragma("unroll") for (int m = 0; m < 4; ++m) _Pragma("unroll") for (int n = 0; n < 2; ++n) _Pragma("unroll") for (int k = 0; k < 2; ++k) \
        acc[ai][bj][m][n] = __builtin_amdgcn_mfma_f32_16x16x32_bf16(Bt[n][k], At[m][k], acc[ai][bj][m][n], 0, 0, 0); __builtin_amdgcn_s_setprio(0); } while (0)
#define PG8_WAIT_V(n) asm volatile("s_waitcnt vmcnt(" #n ")" ::: "memory")
#define PG8_WAIT_L(n) asm volatile("s_waitcnt lgkmcnt(" #n ")" ::: "memory")
#define PG8_BAR __builtin_amdgcn_s_barrier()
#define PG8_SCHED __builtin_amdgcn_sched_barrier(0)
    Unit cur, nxt; int ui = 0;
    if (!S.next(0, cur)) return;
    f32x4 acc[2][2][4][2];
#pragma unroll
    for (int a = 0; a < 2; ++a)
#pragma unroll
        for (int b = 0; b < 2; ++b)
#pragma unroll
            for (int m = 0; m < 4; ++m)
#pragma unroll
                for (int n = 0; n < 2; ++n) acc[a][b][m][n] = (f32x4){0.f, 0.f, 0.f, 0.f};
    bf16x8 At[4][2], B0[2][2], B1[2][2];
    const char* cA = S.a_base(cur); const char* cB = S.b_base(cur);
    if constexpr (SP2) {
        PG8_STAGE(PG8_SB(0, 0), cB, voffB); PG8_STAGE(PG8_SB(0, 1), cB + hstep, voffB); PG8_STAGE(PG8_SA(0, 0), cA, voffA); PG8_STAGE(PG8_SA(0, 1), cA + hstep, voffA);
        if (wr == 1) PG8_BAR;
        PG8_WAIT_V(2); PG8_BAR;
        PG8_STAGE(PG8_SB(1, 0), cB + kstep, voffB); PG8_STAGE(PG8_SA(1, 0), cA + kstep, voffA); PG8_STAGE(PG8_SB(1, 1), cB + hstep + kstep, voffB);
        PG8_WAIT_V(6); PG8_BAR;
    } else {
        PG8_STAGE(PG8_SB(0, 0), cB, voffB); PG8_STAGE(PG8_SA(0, 0), cA, voffA); PG8_STAGE(PG8_SB(0, 1), cB + hstep, voffB); PG8_STAGE(PG8_SA(0, 1), cA + hstep, voffA);
        if (wr == 1) PG8_BAR;
        PG8_WAIT_V(4); PG8_BAR;
        PG8_STAGE(PG8_SB(1, 0), cB + kstep, voffB); PG8_STAGE(PG8_SA(1, 0), cA + kstep, voffA); PG8_STAGE(PG8_SB(1, 1), cB + hstep + kstep, voffB);
        PG8_WAIT_V(6); PG8_BAR;
    }
    for (;;) {
        const bool has_next = S.next(ui + 1, nxt); const int nt = S.nt(cur);
        const char* nA = has_next ? S.a_base(nxt) : cA; const char* nB = has_next ? S.b_base(nxt) : cB;
#ifdef TIMING_K
        unsigned long long tk0 = 0, tr0 = 0; const bool stamper = S.stamp != nullptr && blockIdx.x == 0 && wid == 0 && ui == 1;
        if (stamper) { tk0 = __builtin_amdgcn_s_memtime(); tr0 = __builtin_amdgcn_s_memrealtime(); }
#ifdef TIMING_GAP
        if (S.stamp != nullptr && blockIdx.x == 0 && wid == 0 && ui == 2 && lane == 0) { S.stamp[0] = __builtin_amdgcn_s_memtime() - S.stamp[4]; S.stamp[1] = __builtin_amdgcn_s_memrealtime() - S.stamp[5]; S.stamp[2] = 1ull; }
#endif
#endif
        for (int t = 0; t < nt; t += 2) {
            const bool last = (t == nt - 2);
            const char* a1 = cA + (size_t)(t + 1) * kstep;
            const char* a2 = last ? nA : cA + (size_t)(t + 2) * kstep; const char* b2 = last ? nB : cB + (size_t)(t + 2) * kstep;
            const char* a3 = a2 + kstep; const char* b3 = b2 + kstep;
            if constexpr (SP2) {
            PG8_LDB(B0, 0, 0); PG8_LDB(B1, 0, 1); PG8_SCHED; PG8_LDA(At, 0, 0); PG8_STAGE(PG8_SA(1, 1), a1 + hstep, voffA);
            PG8_WAIT_V(8); PG8_WAIT_L(0); PG8_BAR; PG8_MMA(0, 0, At, B0); PG8_MMA(0, 1, At, B1); PG8_BAR; PG8_SCHED;
            PG8_LDA(At, 0, 1); PG8_STAGE(PG8_SB(0, 0), b2, voffB); PG8_STAGE(PG8_SB(0, 1), b2 + hstep, voffB); PG8_STAGE(PG8_SA(0, 0), a2, voffA);
            PG8_WAIT_V(8); PG8_WAIT_L(0); PG8_BAR; PG8_MMA(1, 0, At, B0); PG8_MMA(1, 1, At, B1); PG8_BAR; PG8_SCHED;
            PG8_LDB(B0, 1, 0); PG8_LDB(B1, 1, 1); PG8_SCHED; PG8_LDA(At, 1, 0); PG8_STAGE(PG8_SA(0, 1), a2 + hstep, voffA);
            PG8_WAIT_V(8); PG8_WAIT_L(0); PG8_BAR; PG8_MMA(0, 0, At, B0); PG8_MMA(0, 1, At, B1); PG8_BAR; PG8_SCHED;
            PG8_LDA(At, 1, 1); PG8_STAGE(PG8_SB(1, 0), b3, voffB); PG8_STAGE(PG8_SB(1, 1), b3 + hstep, voffB); PG8_STAGE(PG8_SA(1, 0), a3, voffA);
            PG8_WAIT_V(8); PG8_WAIT_L(0); PG8_BAR; PG8_MMA(1, 0, At, B0); PG8_MMA(1, 1, At, B1); PG8_BAR; PG8_SCHED;
            } else {
            PG8_LDB(B0, 0, 0); PG8_SCHED; PG8_LDA(At, 0, 0); PG8_STAGE(PG8_SA(1, 1), a1 + hstep, voffA);
            PG8_WAIT_L(8); PG8_BAR; PG8_WAIT_L(0); PG8_MMA(0, 0, At, B0); PG8_BAR; PG8_SCHED;
            PG8_LDB(B1, 0, 1); PG8_STAGE(PG8_SB(0, 0), b2, voffB);
            PG8_BAR; PG8_WAIT_L(0); PG8_MMA(0, 1, At, B1); PG8_BAR;
            PG8_LDA(At, 0, 1); PG8_STAGE(PG8_SA(0, 0), a2, voffA);
            PG8_BAR; PG8_WAIT_L(0); PG8_MMA(1, 0, At, B0); PG8_BAR; PG8_SCHED;
            PG8_STAGE(PG8_SB(0, 1), b2 + hstep, voffB);
            PG8_WAIT_V(6); PG8_BAR; PG8_MMA(1, 1, At, B1); PG8_BAR;
            PG8_LDB(B0, 1, 0); PG8_SCHED; PG8_LDA(At, 1, 0); PG8_STAGE(PG8_SA(0, 1), a2 + hstep, voffA);
            PG8_WAIT_L(8); PG8_BAR; PG8_WAIT_L(0); PG8_MMA(0, 0, At, B0); PG8_BAR; PG8_SCHED;
            PG8_LDB(B1, 1, 1); PG8_STAGE(PG8_SB(1, 0), b3, voffB);
            PG8_BAR; PG8_WAIT_L(0); PG8_MMA(0, 1, At, B1); PG8_BAR;
            PG8_LDA(At, 1, 1); PG8_STAGE(PG8_SA(1, 0), a3, voffA);
            PG8_BAR; PG8_WAIT_L(0); PG8_MMA(1, 0, At, B0); PG8_BAR; PG8_SCHED;
            PG8_STAGE(PG8_SB(1, 1), b3 + hstep, voffB);
            PG8_WAIT_V(6); PG8_BAR; PG8_MMA(1, 1, At, B1); PG8_BAR;
            }
        }
#ifdef TIMING_K
#ifdef TIMING_GAP
        if (stamper && lane == 0) { S.stamp[4] = __builtin_amdgcn_s_memtime(); S.stamp[5] = __builtin_amdgcn_s_memrealtime(); }
#else
        if (stamper && lane == 0) { S.stamp[0] = __builtin_amdgcn_s_memtime() - tk0; S.stamp[1] = __builtin_amdgcn_s_memrealtime() - tr0; S.stamp[2] = (unsigned long long)nt; }
#endif
#endif
        if constexpr (ALIGN_EPI) { if (wr == 0) PG8_BAR; }
        { int fr_e = fr, fq_e = fq; asm volatile("" : "+v"(fr_e), "+v"(fq_e));
          E(acc, cur, wr, wc, fr_e, fq_e); }
        if (!has_next) break;
        if (!E.keep(cur)) {
#pragma unroll
        for (int a = 0; a < 2; ++a)
#pragma unroll
            for (int b = 0; b < 2; ++b)
#pragma unroll
                for (int m = 0; m < 4; ++m)
#pragma unroll
                    for (int n = 0; n < 2; ++n) acc[a][b][m][n] = (f32x4){0.f, 0.f, 0.f, 0.f};
        }
        cur = nxt; cA = nA; cB = nB; ++ui;
        if constexpr (ALIGN_EPI) { if (wr == 1) PG8_BAR; }
    }
    PG8_WAIT_V(0);
    if constexpr (!ALIGN_EPI) { if (wr == 0) PG8_BAR; }
    PG8_BAR;
#undef PG8_SA
#undef PG8_SB
#undef PG8_STAGE
#undef PG8_LDA
#undef PG8_LDB
#undef PG8_MMA
#undef PG8_WAIT_V
#undef PG8_WAIT_L
#undef PG8_BAR
#undef PG8_SCHED
}
}
namespace fk {
using pg8::Unit; using pg8::bf16_t;
typedef float f32x16 __attribute__((ext_vector_type(16)));
typedef float f32x8v __attribute__((ext_vector_type(8)));
typedef short s16x4 __attribute__((ext_vector_type(4)));
typedef unsigned u32x4 __attribute__((ext_vector_type(4)));
typedef unsigned u32x2 __attribute__((ext_vector_type(2)));
constexpr int NWAVES = 8;
constexpr int M = 10240, MP = 8192, MS = 2048, DM = 2048, NIN = 9216, FF = 5632, NGU = 11264, SBW = 1024;
constexpr float EPS = 1e-6f;
constexpr float QSCALE = 1.4426950408889634f * 0.08838834764831845f;
constexpr size_t OUT_Y = 0, OUT_KP = 20971520, OUT_VP = 37748736, OUT_KS = 54525952, OUT_VS = 58720256, OUT_SG = 62914560, OUT_N = 67108864;
constexpr size_t MiB = 1u << 20;
constexpr size_t W_CTL = 0, CTL_ZERO_BYTES = 1 * MiB;
constexpr size_t W_WL = 1 * MiB, WL_STRIDE = 118 * MiB;
constexpr size_t WL_IN = 0, WL_A = 36 * MiB, WL_B = 40 * MiB, WL_OUT = 44 * MiB, WL_GU = 52 * MiB, WL_D = 96 * MiB;
constexpr size_t W_WM = 237 * MiB;
constexpr size_t W_HB = 238 * MiB, W_SS = 278 * MiB, W_Q = 280 * MiB, W_K = 300 * MiB, W_V = 320 * MiB, W_U = 340 * MiB, W_VS = 360 * MiB, W_G = 400 * MiB,
                 W_ATT = 480 * MiB, W_BB = 500 * MiB, W_MG = 520 * MiB, W_ACT = 560 * MiB, W_SLAB = 670 * MiB  , W_END = 734 * MiB;
constexpr size_t W_SSV = W_SS + 1280 * 1024;
constexpr int CW_TMO = 0, CW_BAR = 4096;
constexpr int RING_BYTES = 131072, LDSCTL_OFF = RING_BYTES, MISC_OFF = LDSCTL_OFF + 320, LDS_BYTES = 147456;

#define GAS __attribute__((address_space(1)))
#define LAS __attribute__((address_space(3)))
typedef unsigned short bf16;
typedef unsigned v4u __attribute__((ext_vector_type(4)));
typedef float f32x4 __attribute__((ext_vector_type(4)));
typedef short bf16x8 __attribute__((ext_vector_type(8)));
typedef GAS unsigned gu32;
typedef GAS unsigned long long gu64;
#define RLX_AGENT __ATOMIC_RELAXED, __HIP_MEMORY_SCOPE_AGENT
#define LDS_WAIT() asm volatile("s_waitcnt lgkmcnt(0)" ::: "memory")
#define VM_WAIT() asm volatile("s_waitcnt vmcnt(0)" ::: "memory")
__device__ __forceinline__ unsigned long long rt() { return __builtin_amdgcn_s_memrealtime(); }
__device__ __forceinline__ unsigned f2bf(float f) { unsigned u = __builtin_bit_cast(unsigned, f); return (u + 0x7fffu + ((u >> 16) & 1u)) >> 16; }
__device__ __forceinline__ unsigned pk2(float lo, float hi) { return f2bf(lo) | (f2bf(hi) << 16); }
#define XB_TMO      128
#define XB_XCNT(j)  (256  + 64 * (j))
#define XB_XSUB(j)  (1280 + 64 * (j))
#define XB_XGEN(j)  (2304 + 64 * (j))
#define XB_TOP      3328
#define XB_TOPGEN   3392
#define XCD_BAR_WORDS 3456
#define XB_SPIN_CAP (1u << 18)

__device__ __forceinline__ unsigned xb_ld(unsigned* p)              { return __hip_atomic_load(p, __ATOMIC_RELAXED, __HIP_MEMORY_SCOPE_AGENT); }
__device__ __forceinline__ unsigned xb_add(unsigned* p, unsigned v) { return __hip_atomic_fetch_add(p, v, __ATOMIC_RELAXED, __HIP_MEMORY_SCOPE_AGENT); }
__device__ __forceinline__ unsigned xb_xcc_id() { return (unsigned)__builtin_amdgcn_s_getreg((3 << 11) | 20) & 0xFu; }
#define XB_SPIN(cond, bar) do { unsigned _sp = 0; while (cond) { __builtin_amdgcn_s_sleep(1); \
    if ((++_sp & 255u) == 0u) { if (xb_ld(&(bar)[XB_TMO])) break; if (_sp > XB_SPIN_CAP) { atomicAdd(&(bar)[XB_TMO], 1u); break; } } } } while (0)

struct XcdBarrier {
    unsigned* bar; unsigned x;
    volatile LAS unsigned* st;
};

__device__ __forceinline__ XcdBarrier xcd_barrier_post(unsigned* bar, volatile LAS unsigned* st) {
    XcdBarrier b; b.bar = bar; b.x = xb_xcc_id(); b.st = st;
    if (threadIdx.x == 0) (void)xb_add(&bar[XB_XCNT(b.x)], 1u);
    return b;
}
__device__ __forceinline__ void xcd_barrier_complete(unsigned* bar, unsigned x, unsigned& nloc, unsigned& nx) {
    const unsigned G = gridDim.x * gridDim.y * gridDim.z;
    unsigned sum, cnt, mine, sp = 0u;
    for (;;) {
        sum = 0u; cnt = 0u; mine = 0u;
#pragma unroll
        for (unsigned j = 0; j < 16; ++j) { const unsigned c = xb_ld(&bar[XB_XCNT(j)]); sum += c; cnt += (c > 0u) ? 1u : 0u; mine = (j == x) ? c : mine; }
        if (sum == G) break;
        __builtin_amdgcn_s_sleep(1);
        if ((++sp & 255u) == 0u) { if (xb_ld(&bar[XB_TMO])) break; if (sp > XB_SPIN_CAP) { atomicAdd(&bar[XB_TMO], 1u); break; } }
    }
    nloc = mine > 0u ? mine : 1u; nx = cnt > 0u ? cnt : 1u;
}

__device__ __forceinline__ void xcd_barrier(const XcdBarrier& b) {
    asm volatile("s_waitcnt vmcnt(0)" ::: "memory");
    __syncthreads();
    if (threadIdx.x == 0) {
        unsigned* bar = b.bar;
        __builtin_amdgcn_s_waitcnt(0);
        unsigned nloc = b.st[0], nx = b.st[1];
        if (nloc == 0u) { xcd_barrier_complete(bar, b.x, nloc, nx); b.st[0] = nloc; b.st[1] = nx; }
        const unsigned old = xb_add(&bar[XB_XSUB(b.x)], 1u);
        const unsigned gen = old / nloc;
        if (old + 1u == (gen + 1u) * nloc) {
            __builtin_amdgcn_fence(__ATOMIC_RELEASE, "agent");
            asm volatile("s_waitcnt vmcnt(0)" ::: "memory");
            const unsigned og = xb_add(&bar[XB_TOP], 1u);
            const unsigned tg = og / nx;
            if (og + 1u == (tg + 1u) * nx) xb_add(&bar[XB_TOPGEN], 1u);
            else XB_SPIN(xb_ld(&bar[XB_TOPGEN]) == tg, bar);
            __builtin_amdgcn_fence(__ATOMIC_ACQUIRE, "agent");
            xb_add(&bar[XB_XGEN(b.x)], 1u);
            asm volatile("s_waitcnt vmcnt(0)" ::: "memory");
        } else {
            XB_SPIN(xb_ld(&bar[XB_XGEN(b.x)]) == gen, bar);
            __builtin_amdgcn_fence(__ATOMIC_ACQUIRE, "agent");
            asm volatile("s_waitcnt vmcnt(0)" ::: "memory");
        }
    }
    __syncthreads();
}

struct Frame {
    LAS unsigned char* lds; volatile LAS unsigned* MISC; int tid, lane, wave, vcu, G;
    const float *xp, *xs, *ck, *cv, *nmix, *win, *bgate, *sgun, *wsp, *bsp, *wa, *wb, *wout, *nffn, *wgu, *wd, *nfin;
    float* out; unsigned char* ws;
};
__device__ __forceinline__ int opq(int x) { asm volatile("" : "+v"(x)); return x; }
__device__ __forceinline__ float bf2f_lo(unsigned w) { return __uint_as_float(w << 16); }
__device__ __forceinline__ float bf2f_hi(unsigned w) { return __uint_as_float(w & 0xffff0000u); }
typedef __bf16 bf16x2_t __attribute__((ext_vector_type(2)));
__device__ __forceinline__ unsigned cvtpk(float lo, float hi) { const bf16x2_t v = {(__bf16)lo, (__bf16)hi}; return __builtin_bit_cast(unsigned, v); }
__device__ __forceinline__ float fsig(float y) { return __builtin_amdgcn_rcpf(1.f + __builtin_amdgcn_exp2f(-1.4426950408889634f * y)); }
__device__ __forceinline__ float fgelu(float x) { const float t = x * (-2.3022081f + -0.10294324f * x * x); return x * __builtin_amdgcn_rcpf(1.f + __builtin_amdgcn_exp2f(t)); }
__device__ __forceinline__ float wave_sum(float v) {
#pragma unroll
    for (int o = 1; o < 64; o <<= 1) v += __shfl_xor(v, o);
    return v;
}
__device__ __forceinline__ void tile_of(int L, int nM, int nN, int& pm, int& pn) {
    const int nwg = nM * nN; int wgid = L; { const int q = nwg / 8, r = nwg % 8, xcd = wgid % 8, off = wgid / 8; wgid = (xcd < r ? xcd * (q + 1) : r * (q + 1) + (xcd - r) * q) + off; }
    const int nig = 8 * nN, gid = wgid / nig, fm = gid * 8, gsz = (nM - fm) < 8 ? (nM - fm) : 8;
    pm = fm + ((wgid % nig) % gsz); pn = (wgid % nig) / gsz;
}
struct SchedSimple {
    int nM, nN, G, c, K, KT; const char* A; const char* Bt; unsigned long long* stamp;
    __device__ __forceinline__ bool next(int i, Unit& u) const { const int L = i * G + c; if (L >= nM * nN) return false; tile_of(L, nM, nN, u.pm, u.pn); u.br = 0; return true; }
    __device__ __forceinline__ int nt(const Unit&) const { return KT >> 6; }
    __device__ __forceinline__ const char* a_base(const Unit& u) const { return A + (size_t)u.pm * 512 * K; }
    __device__ __forceinline__ const char* b_base(const Unit& u) const { return Bt + (size_t)u.pn * 512 * K; }
};
constexpr int TAIL_T = 320, TAIL_F = 256, TAIL_NS = 4;
struct SchedTail {
    int nM, nN, G, c, K, KT; const char* A; const char* Bt; unsigned long long* stamp; int split;
    __device__ __forceinline__ bool next(int i, Unit& u) const {
        if (split && G == TAIL_F) { if (i > 1) return false; if (i == 0) { tile_of(c, nM, nN, u.pm, u.pn); u.br = 0; } else { tile_of(TAIL_F + (c >> 2), nM, nN, u.pm, u.pn); u.br = 1 + (c & 3); } return true; }
        const int L = i * G + c; if (L >= nM * nN) return false; tile_of(L, nM, nN, u.pm, u.pn); u.br = 0; return true; }
    __device__ __forceinline__ int nt(const Unit& u) const { return u.br ? (KT >> 8) : (KT >> 6); }
    __device__ __forceinline__ const char* a_base(const Unit& u) const { return A + (size_t)u.pm * 512 * K + (u.br ? (size_t)(u.br - 1) * (KT >> 2) * 2 : 0); }
    __device__ __forceinline__ const char* b_base(const Unit& u) const { return Bt + (size_t)u.pn * 512 * K + (u.br ? (size_t)(u.br - 1) * (KT >> 2) * 2 : 0); }
};
struct SchedBranch {
    int nM, nN, G, c, K, KT; const char *A0, *B0, *A1, *B1; unsigned long long* stamp; int split;
    __device__ __forceinline__ bool next(int i, Unit& u) const {
        if (split && G == TAIL_F) { if (i > 2) return false; if (i < 2) { tile_of(c, nM, nN, u.pm, u.pn); u.br = i; } else { tile_of(TAIL_F + (c >> 2), nM, nN, u.pm, u.pn); u.br = 2 + (c & 3); } return true; }
        const int L = (i >> 1) * G + c; if (L >= nM * nN) return false; tile_of(L, nM, nN, u.pm, u.pn); u.br = i & 1; return true; }
    __device__ __forceinline__ int nt(const Unit& u) const { return u.br < 2 ? (KT >> 6) : (KT >> 7); }
    __device__ __forceinline__ const char* a_base(const Unit& u) const { const int pr = u.br < 2 ? u.br : ((u.br - 2) >> 1); return (pr ? A1 : A0) + (size_t)u.pm * 512 * K + (u.br < 2 ? 0 : (size_t)((u.br - 2) & 1) * (KT >> 1) * 2); }
    __device__ __forceinline__ const char* b_base(const Unit& u) const { const int pr = u.br < 2 ? u.br : ((u.br - 2) >> 1); return (pr ? B1 : B0) + (size_t)u.pn * 512 * K + (u.br < 2 ? 0 : (size_t)((u.br - 2) & 1) * (KT >> 1) * 2); }
};
#define EPI_ROWS(ai, m) (u.pm * 256 + (ai) * 128 + wr * 64 + (m) * 16 + fr)
__device__ __forceinline__ void row_rstd(const float* SS, const Unit& u, int wr, int fr, int fq, float (&rs)[2][4]) {
    f32x4 a[2][4], b[2][4];
#pragma unroll
    for (int ai = 0; ai < 2; ++ai)
#pragma unroll
        for (int m = 0; m < 4; ++m) { const f32x4* s = (const f32x4*)(SS + (size_t)EPI_ROWS(ai, m) * 32 + fq * 8); a[ai][m] = s[0]; b[ai][m] = s[1]; }
    float t[2][4];
#pragma unroll
    for (int ai = 0; ai < 2; ++ai)
#pragma unroll
        for (int m = 0; m < 4; ++m) t[ai][m] = ((a[ai][m][0] + a[ai][m][1]) + (a[ai][m][2] + a[ai][m][3])) + ((b[ai][m][0] + b[ai][m][1]) + (b[ai][m][2] + b[ai][m][3]));
#pragma unroll
    for (int ai = 0; ai < 2; ++ai)
#pragma unroll
        for (int m = 0; m < 4; ++m) t[ai][m] += __shfl_xor(t[ai][m], 16);
#pragma unroll
    for (int ai = 0; ai < 2; ++ai)
#pragma unroll
        for (int m = 0; m < 4; ++m) t[ai][m] += __shfl_xor(t[ai][m], 32);
#pragma unroll
    for (int ai = 0; ai < 2; ++ai)
#pragma unroll
        for (int m = 0; m < 4; ++m) rs[ai][m] = __builtin_amdgcn_rsqf(t[ai][m] * (1.0f / 2048.0f) + EPS);
}
#ifndef ST_SC1
#define ST_SC1 0
#endif
__device__ __forceinline__ void st16(void* p, u32x4 v) {
#if ST_SC1
    asm volatile("global_store_dwordx4 %0, %1, off sc1\n\ts_nop 1" :: "v"(p), "v"(v) : "memory");
#else
    *(u32x4*)p = v;
#endif
}
__device__ __forceinline__ void st16f(float* p, f32x4 v) { st16((void*)p, __builtin_bit_cast(u32x4, v)); }
__device__ __forceinline__ u32x4 pack8(const f32x4 v0, const f32x4 v1) { u32x4 w; w.x = cvtpk(v0[0], v0[1]); w.y = cvtpk(v0[2], v0[3]); w.z = cvtpk(v1[0], v1[1]); w.w = cvtpk(v1[2], v1[3]); return w; }
#ifdef DBG_GRAW
#define GATE_ACT(x) (x)
#else
#define GATE_ACT(x) fsig(x)
#endif
struct EpiIn {
    static constexpr bool PERM = true;
    const float* SS; bf16_t *Q, *Kb, *Vb, *U, *G; float* VS; const float* bgate; float *okp, *ovp, *oks, *ovs; float* SSV;
    __device__ __forceinline__ bool keep(const Unit&) const { return false; }
    __device__ __forceinline__ void operator()(f32x4 (&acc)[2][2][4][2], const Unit& u, int wr, int wc, int fr, int fq) const {
        float rs[2][4]; row_rstd(SS, u, wr, fr, fq, rs);
        const int colt = u.pn * 256, cl = wc * 32 + 8 * fq;
        if (colt < 1024) {
#pragma unroll
            for (int ai = 0; ai < 2; ++ai)
#pragma unroll
                for (int m = 0; m < 4; ++m) { const size_t row = EPI_ROWS(ai, m); const float sc = rs[ai][m] * QSCALE;
#pragma unroll
                    for (int bj = 0; bj < 2; ++bj) st16(Q + row * 1024 + colt + bj * 128 + cl, pack8(acc[ai][bj][m][0] * sc, acc[ai][bj][m][1] * sc)); }
        } else if (colt < 3072) {
            const bool isv = colt >= 2048; const int c0 = colt - (isv ? 2048 : 1024) + cl; bf16_t* B = isv ? Vb : Kb;
            float* O = (u.pm < 32) ? (isv ? ovp : okp) : ((isv ? ovs : oks) - (size_t)MP * 1024);
#pragma unroll
            for (int ai = 0; ai < 2; ++ai)
#pragma unroll
                for (int m = 0; m < 4; ++m) { const size_t row = EPI_ROWS(ai, m); const float sc = rs[ai][m];
#pragma unroll
                    for (int bj = 0; bj < 2; ++bj) { const f32x4 v0 = acc[ai][bj][m][0] * sc, v1 = acc[ai][bj][m][1] * sc; const size_t o = row * 1024 + c0 + bj * 128;
                        st16(B + o, pack8(v0, v1)); st16f(O + o, v0); st16f(O + o + 4, v1); } }
        } else if (colt < 5120) {
            const bool isvs = colt >= 4096; const int c0 = colt - (isvs ? 4096 : 3072) + cl;
#pragma unroll
            for (int ai = 0; ai < 2; ++ai)
#pragma unroll
                for (int m = 0; m < 4; ++m) { const size_t row = EPI_ROWS(ai, m); const float sc = rs[ai][m]; float q = 0.f;
#pragma unroll
                    for (int bj = 0; bj < 2; ++bj) { f32x4 v0 = acc[ai][bj][m][0] * sc, v1 = acc[ai][bj][m][1] * sc;
#pragma unroll
                        for (int j = 0; j < 4; ++j) { v0[j] = fgelu(v0[j]); v1[j] = fgelu(v1[j]); }
                        const size_t o = row * 1024 + c0 + bj * 128;
                        if (isvs) { st16f(VS + o, v0); st16f(VS + o + 4, v1);
                            q += ((v0[0] * v0[0] + v0[1] * v0[1]) + (v0[2] * v0[2] + v0[3] * v0[3])) + ((v1[0] * v1[0] + v1[1] * v1[1]) + (v1[2] * v1[2] + v1[3] * v1[3])); }
                        else st16(U + o, pack8(v0, v1)); }
                    if (isvs) { q += __shfl_xor(q, 16); q += __shfl_xor(q, 32); if (fq == 0) SSV[row * 16 + (u.pn - 16) * 4 + wc] = q; } }
        } else {
            const int c0 = colt - 5120 + cl;
#pragma unroll
            for (int bj = 0; bj < 2; ++bj) { const f32x4 b0 = *(const f32x4*)(bgate + c0 + bj * 128), b1 = *(const f32x4*)(bgate + c0 + bj * 128 + 4);
#pragma unroll
                for (int ai = 0; ai < 2; ++ai)
#pragma unroll
                    for (int m = 0; m < 4; ++m) { const size_t row = EPI_ROWS(ai, m); const float sc = rs[ai][m];
                        f32x4 v0 = acc[ai][bj][m][0] * sc + b0, v1 = acc[ai][bj][m][1] * sc + b1;
#pragma unroll
                        for (int j = 0; j < 4; ++j) { v0[j] = GATE_ACT(v0[j]); v1[j] = GATE_ACT(v1[j]); }
                        st16(G + row * 4096 + c0 + bj * 128, pack8(v0, v1)); } }
        }
    }
};
__device__ __forceinline__ void store_slab(float* slab, const f32x4 (&acc)[2][2][4][2], int wr, int wc, int fr, int fq) {
#pragma unroll
    for (int ai = 0; ai < 2; ++ai)
#pragma unroll
        for (int m = 0; m < 4; ++m) { float* rp = slab + (size_t)(ai * 128 + wr * 64 + m * 16 + fr) * 256 + wc * 32 + 8 * fq;
#pragma unroll
            for (int bj = 0; bj < 2; ++bj) { st16f(rp + bj * 128, acc[ai][bj][m][0]); st16f(rp + bj * 128 + 4, acc[ai][bj][m][1]); } }
}
struct EpiMerge {
    static constexpr bool PERM = true;
    const bf16_t* G; bf16_t* MG; float* slab;
    __device__ __forceinline__ bool keep(const Unit& u) const { return u.br == 0; }
    __device__ __forceinline__ void operator()(f32x4 (&acc)[2][2][4][2], const Unit& u, int wr, int wc, int fr, int fq) const {
        const int c0 = u.pn * 256 + wc * 32 + 8 * fq; const int pair = u.br < 2 ? u.br : ((u.br - 2) >> 1);
#pragma unroll
        for (int ai = 0; ai < 2; ++ai) {
            u32x4 gg[4][2], hh[4][2];
#pragma unroll
            for (int m = 0; m < 4; ++m)
#pragma unroll
                for (int bj = 0; bj < 2; ++bj) { const bf16_t* gp = G + (size_t)EPI_ROWS(ai, m) * 4096 + c0 + bj * 128; gg[m][bj] = *(const u32x4*)(gp + pair * 2048); if (u.br == 0) hh[m][bj] = *(const u32x4*)(gp + 2048); }
#pragma unroll
            for (int m = 0; m < 4; ++m) { const size_t row = EPI_ROWS(ai, m);
#pragma unroll
                for (int bj = 0; bj < 2; ++bj) { const int c = c0 + bj * 128; const u32x4 g = gg[m][bj];
                    f32x4 g0 = {bf2f_lo(g.x), bf2f_hi(g.x), bf2f_lo(g.y), bf2f_hi(g.y)}, g1 = {bf2f_lo(g.z), bf2f_hi(g.z), bf2f_lo(g.w), bf2f_hi(g.w)};
                    if (u.br == 0) {
                        const u32x4 h = hh[m][bj];
                        const f32x4 b0 = {bf2f_lo(h.x), bf2f_hi(h.x), bf2f_lo(h.y), bf2f_hi(h.y)}, b1 = {bf2f_lo(h.z), bf2f_hi(h.z), bf2f_lo(h.w), bf2f_hi(h.w)};
#pragma unroll
                        for (int j = 0; j < 4; ++j) { g0[j] *= __builtin_amdgcn_rcpf(fmaxf(b0[j], 1e-30f)); g1[j] *= __builtin_amdgcn_rcpf(fmaxf(b1[j], 1e-30f)); }
                    } else if (u.br == 1) {
#pragma unroll
                        for (int j = 0; j < 4; ++j) { g0[j] = fmaxf(g0[j], 1e-30f); g1[j] = fmaxf(g1[j], 1e-30f); }
                    }
                    acc[ai][bj][m][0] *= g0; acc[ai][bj][m][1] *= g1;
                    if (u.br == 1) st16(MG + row * 2048 + c, pack8(acc[ai][bj][m][0], acc[ai][bj][m][1])); } }
        }
        if (u.br >= 2) store_slab(slab, acc, wr, wc, fr, fq);
    }
};
struct EpiRes {
    static constexpr bool PERM = true;
    const float* base_p; const float* base_s;
    float* H; bf16_t* HB; float* SS; int write_hb; float* slab;
    __device__ __forceinline__ bool keep(const Unit&) const { return false; }
    __device__ __forceinline__ void operator()(f32x4 (&acc)[2][2][4][2], const Unit& u, int wr, int wc, int fr, int fq) const {
        if (u.br) { store_slab(slab, acc, wr, wc, fr, fq); return; }
        const int c0 = u.pn * 256 + wc * 32 + 8 * fq; const float* bb = (u.pm < 32) ? base_p : (base_s - (size_t)MP * 2048);
#pragma unroll
        for (int ai = 0; ai < 2; ++ai) {
            f32x4 bv[4][2][2];
#pragma unroll
            for (int m = 0; m < 4; ++m)
#pragma unroll
                for (int bj = 0; bj < 2; ++bj) { const size_t o = (size_t)EPI_ROWS(ai, m) * 2048 + c0 + bj * 128; bv[m][bj][0] = *(const f32x4*)(bb + o); bv[m][bj][1] = *(const f32x4*)(bb + o + 4); }
#pragma unroll
            for (int m = 0; m < 4; ++m) { const size_t row = EPI_ROWS(ai, m); float q = 0.f;
#pragma unroll
                for (int bj = 0; bj < 2; ++bj) { const size_t o = row * 2048 + c0 + bj * 128;
                    const f32x4 h0 = bv[m][bj][0] + acc[ai][bj][m][0], h1 = bv[m][bj][1] + acc[ai][bj][m][1];
                    st16f(H + o, h0); st16f(H + o + 4, h1);
                    q += ((h0[0] * h0[0] + h0[1] * h0[1]) + (h0[2] * h0[2] + h0[3] * h0[3])) + ((h1[0] * h1[0] + h1[1] * h1[1]) + (h1[2] * h1[2] + h1[3] * h1[3]));
                    if (write_hb) st16(HB + o, pack8(h0, h1)); }
                q += __shfl_xor(q, 16); q += __shfl_xor(q, 32);
                if (fq == 0) SS[row * 32 + u.pn * 4 + wc] = q; }
        }
    }
};
struct EpiGU {
    static constexpr bool PERM = true;
    const float* SS; bf16_t* ACT;
    __device__ __forceinline__ bool keep(const Unit&) const { return false; }
    __device__ __forceinline__ void operator()(f32x4 (&acc)[2][2][4][2], const Unit& u, int wr, int wc, int fr, int fq) const {
        float rs[2][4]; row_rstd(SS, u, wr, fr, fq, rs);
        const int c0 = u.pn * 128 + wc * 32 + 8 * fq;
#pragma unroll
        for (int ai = 0; ai < 2; ++ai)
#pragma unroll
            for (int m = 0; m < 4; ++m) { const size_t row = EPI_ROWS(ai, m); const float sc = rs[ai][m]; f32x4 v0, v1;
#pragma unroll
                for (int j = 0; j < 4; ++j) { const float g0 = acc[ai][0][m][0][j] * sc, g1 = acc[ai][0][m][1][j] * sc;
                    v0[j] = g0 * fsig(g0) * (acc[ai][1][m][0][j] * sc); v1[j] = g1 * fsig(g1) * (acc[ai][1][m][1][j] * sc); }
                st16(ACT + row * 5632 + c0, pack8(v0, v1)); }
    }
};
__device__ __forceinline__ void p0_transpose_item(const float* W, int K, int N, const float* scale, bf16* WT, int drow0, int k0, int n0, LAS float* scr, int lane) {
    float v[32];
#pragma unroll
    for (int i = 0; i < 32; ++i) { const int kk = 2 * i + (lane >> 5); v[i] = W[(size_t)(k0 + kk) * N + n0 + (lane & 31)]; }
    if (scale) {
#pragma unroll
        for (int i = 0; i < 32; ++i) v[i] *= scale[k0 + 2 * i + (lane >> 5)]; }
#pragma unroll
    for (int i = 0; i < 32; ++i) scr[(2 * i + (lane >> 5)) * 33 + (lane & 31)] = v[i];
    LDS_WAIT(); asm volatile("" ::: "memory");
    const int c = lane & 7;
#pragma unroll
    for (int j = 0; j < 4; ++j) { const int n = (lane >> 3) + 8 * j; const LAS float* s = scr + (8 * c) * 33 + n;
        v4u o; o.x = pk2(s[0 * 33], s[1 * 33]); o.y = pk2(s[2 * 33], s[3 * 33]); o.z = pk2(s[4 * 33], s[5 * 33]); o.w = pk2(s[6 * 33], s[7 * 33]);
        *(GAS v4u*)(WT + (size_t)(drow0 + n) * K + k0 + 8 * c) = o; }
    LDS_WAIT(); asm volatile("" ::: "memory");
}
constexpr int I_IN = 32 * 288, I_A = 16 * 64, I_B = 16 * 64, I_O = 32 * 64, I_GU = 32 * 352, I_D = 88 * 64, I_L = I_IN + I_A + I_B + I_O + I_GU + I_D;
__device__ __forceinline__ void p0_weights(Frame& F, int l, int slot, int nslots, int it_lo, int it_hi) {
    const int lane = opq(F.tid) & 63;
    LAS float* scr = (LAS float*)(F.lds + F.wave * 16384); unsigned char* wl = F.ws + W_WL + (size_t)l * WL_STRIDE;
    for (int it = it_lo + slot; it < it_hi; it += nslots) {
        int r = it;
        if (r < I_IN) { const int kb = r / 288, nb = r % 288; p0_transpose_item(F.win + (size_t)l * DM * NIN, DM, NIN, F.nmix + l * DM, (bf16*)(wl + WL_IN), nb * 32, kb * 64, nb * 32, scr, lane); continue; } r -= I_IN;
        if (r < I_A) { const int kb = r / 64, nb = r % 64; p0_transpose_item(F.wa + (size_t)l * 1024 * DM, 1024, DM, nullptr, (bf16*)(wl + WL_A), nb * 32, kb * 64, nb * 32, scr, lane); continue; } r -= I_A;
        if (r < I_B) { const int kb = r / 64, nb = r % 64; p0_transpose_item(F.wb + (size_t)l * 1024 * DM, 1024, DM, nullptr, (bf16*)(wl + WL_B), nb * 32, kb * 64, nb * 32, scr, lane); continue; } r -= I_B;
        if (r < I_O) { const int kb = r / 64, nb = r % 64; p0_transpose_item(F.wout + (size_t)l * DM * DM, DM, DM, nullptr, (bf16*)(wl + WL_OUT), nb * 32, kb * 64, nb * 32, scr, lane); continue; } r -= I_O;
        if (r < I_GU) { const int kb = r / 352, nb = r % 352; const int n0 = nb * 32; const int j0 = n0 < FF ? n0 : n0 - FF;
            const int drow = (j0 >> 7) * 256 + (n0 < FF ? 0 : 128) + (j0 & 127);
            p0_transpose_item(F.wgu + (size_t)l * DM * NGU, DM, NGU, F.nffn + l * DM, (bf16*)(wl + WL_GU), drow, kb * 64, n0, scr, lane); continue; } r -= I_GU;
        { const int kb = r / 64, nb = r % 64; p0_transpose_item(F.wd + (size_t)l * FF * DM, FF, DM, nullptr, (bf16*)(wl + WL_D), nb * 32, kb * 64, nb * 32, scr, lane); }
    }
}
constexpr int L1_R0 = 4608, L1_R1 = 11008, L1_R2 = 19712, L1_R3 = 28416;
#ifndef LATE_W
#define LATE_W 0
#endif
__device__ __forceinline__ void p0_late_weights(Frame& F, int first_idle, int it_lo, int it_hi) {
    if (!LATE_W || F.G != 256 || (int)blockIdx.x < first_idle) return;
    p0_weights(F, 1, ((int)blockIdx.x - first_idle) * NWAVES + F.wave, (256 - first_idle) * NWAVES, it_lo, it_hi);
}
__device__ __forceinline__ void p0_prologue(Frame& F) {
    F.tid = opq(F.tid); F.lane = F.tid & 63;
    const int gw = F.vcu * NWAVES + F.wave, NGW = F.G * NWAVES;
    p0_weights(F, 0, gw, NGW, 0, I_L);
    p0_weights(F, 1, gw, NGW, 0, (LATE_W && F.G == 256) ? L1_R0 : I_L);
    bf16* HB = (bf16*)(F.ws + W_HB); float* SS = (float*)(F.ws + W_SS);
    for (int m = gw; m < M; m += NGW) {
        const float* xr = (m < MP) ? F.xp + (size_t)m * DM : F.xs + (size_t)(m - MP) * DM; float q = 0.f;
        f32x4 v[8];
#pragma unroll
        for (int j = 0; j < 8; ++j) v[j] = *(const f32x4*)(xr + j * 256 + F.lane * 4);
#pragma unroll
        for (int j = 0; j < 8; ++j) { q += (v[j][0] * v[j][0] + v[j][1] * v[j][1]) + (v[j][2] * v[j][2] + v[j][3] * v[j][3]);
            u32x2 w; w.x = cvtpk(v[j][0], v[j][1]); w.y = cvtpk(v[j][2], v[j][3]); *(u32x2*)(HB + (size_t)m * DM + j * 256 + F.lane * 4) = w; }
        q = wave_sum(q);
        if (F.lane < 32) SS[(size_t)m * 32 + F.lane] = F.lane == 0 ? q : 0.f;
    }
    bf16* WM = (bf16*)(F.ws + W_WM);
    for (int i = (F.vcu * NWAVES + F.wave) * 64 + F.lane; i < 2 * 2 * 8 * 128 * 128; i += NGW * 64) {
        const int s = i & 127, t = (i >> 7) & 127, g = (i >> 14) & 7, kind = (i >> 17) & 1, l = i >> 18;
        const float* w = F.wsp + ((size_t)l * 8 + g) * 16384; float v;
        if (kind == 0) v = ((s >> 6) <= (t >> 6)) ? w[t * 128 + s] : 0.f; else v = ((s >> 6) == (t >> 6)) ? w[(t & 63) * 128 + (s & 63)] : 0.f;
        WM[i] = (bf16)f2bf(v);
    }
}
template <int MODE>
__device__ __forceinline__ void p_fixup(Frame& F, const float* base_p, const float* base_s, int write_hb) {
    if (F.G != TAIL_F) return;
    const int tid = opq(F.tid), c = (int)blockIdx.x, q = c & 3; int pm, pn; tile_of(TAIL_F + (c >> 2), 40, 8, pm, pn);
    const float* slab = (const float*)(F.ws + W_SLAB) + (size_t)(c & ~3) * 65536;
    const int col = q * 64 + (tid & 15) * 4, gcol = pn * 256 + col; float* H = F.out + OUT_Y; bf16* HB = (bf16*)(F.ws + W_HB); bf16* MG = (bf16*)(F.ws + W_MG); float* SS = (float*)(F.ws + W_SS);
    const float* bb = (pm < 32) ? base_p : (base_s - (size_t)MP * 2048);
#pragma unroll
    for (int hb = 0; hb < 2; ++hb) { f32x4 s[4][4], bs[4];
#pragma unroll
        for (int i = 0; i < 4; ++i) { const int r = (tid >> 4) + 32 * (hb * 4 + i);
#pragma unroll
            for (int k = 0; k < 4; ++k) s[i][k] = *(const f32x4*)(slab + (size_t)k * 65536 + r * 256 + col);
            if (MODE == 0) bs[i] = *(const f32x4*)(bb + (size_t)(pm * 256 + r) * 2048 + gcol); }
#pragma unroll
        for (int i = 0; i < 4; ++i) { const int r = (tid >> 4) + 32 * (hb * 4 + i); const size_t o = (size_t)(pm * 256 + r) * 2048 + gcol;
            f32x4 v = (s[i][0] + s[i][1]) + (s[i][2] + s[i][3]);
            if (MODE == 0) { v = v + bs[i]; *(f32x4*)(H + o) = v; if (write_hb) { u32x2 w; w.x = cvtpk(v[0], v[1]); w.y = cvtpk(v[2], v[3]); *(u32x2*)(HB + o) = w; }
                float qq = (v[0] * v[0] + v[1] * v[1]) + (v[2] * v[2] + v[3] * v[3]); qq += __shfl_xor(qq, 1); qq += __shfl_xor(qq, 2); qq += __shfl_xor(qq, 4); qq += __shfl_xor(qq, 8);
                if ((tid & 15) == 0) SS[(size_t)(pm * 256 + r) * 32 + pn * 4 + q] = qq; }
            else { u32x2 w; w.x = cvtpk(v[0], v[1]); w.y = cvtpk(v[2], v[3]); *(u32x2*)(MG + o) = w; } } }
}
__device__ __forceinline__ void p_final(Frame& F, float dbg_scale_sample) {
    F.tid = opq(F.tid); F.lane = F.tid & 63;
    const int gw = F.vcu * NWAVES + F.wave, NGW = F.G * NWAVES; const float* SS = (const float*)(F.ws + W_SS);
    f32x4 gg[8];
#pragma unroll
    for (int j = 0; j < 8; ++j) gg[j] = *(const f32x4*)(F.nfin + j * 256 + F.lane * 4);
    for (int m = gw; m < M; m += NGW) {
        float* h = F.out + OUT_Y + (size_t)m * DM; f32x4 v[8];
        float t = F.lane < 32 ? SS[(size_t)m * 32 + F.lane] : 0.f;
#pragma unroll
        for (int j = 0; j < 8; ++j) v[j] = *(const f32x4*)(h + j * 256 + F.lane * 4);
        t = wave_sum(t); float r = __builtin_amdgcn_rsqf(t * (1.0f / 2048.0f) + EPS); if (m >= MP) r *= dbg_scale_sample;
#pragma unroll
        for (int j = 0; j < 8; ++j) *(f32x4*)(h + j * 256 + F.lane * 4) = v[j] * r * gg[j];
    }
}
constexpr int A_VOFF = 0, A_KOFF = 32768, A_TILE = 16384;
#define KSWZ(row, colB) ((row) * 256 + ((colB) ^ (((row) & 7) << 4)))
#define SBAR() __builtin_amdgcn_sched_barrier(0)
__device__ __forceinline__ int crow(int r, int hi) { return (r & 3) + 8 * (r >> 2) + 4 * hi; }
__device__ __forceinline__ int v_st(int k, int c) { const int kk = (k & ~0xC) | ((k & 4) << 1) | ((k & 8) >> 1); return ((kk >> 3) * 4 + (c >> 5)) * 512 + ((kk & 7) * 32 + (c & 31)) * 2; }
__device__ __forceinline__ int v_rd_base(int lane) { return ((lane & 3) << 3) | (((lane >> 2) & 3) << 6) | (((lane >> 4) & 1) << 5) | (((lane >> 5) & 1) << 8); }
constexpr int v_rd_off(int d0, int ks, int half) { return d0 * 512 + ks * 4096 + half * 2048; }
template <int OFF> __device__ __forceinline__ s16x4 tr_read(int vb) { s16x4 r; asm volatile("ds_read_b64_tr_b16 %0, %1 offset:%2" : "=&v"(r) : "v"(vb), "i"(OFF) : "memory"); return r; }
template <int D0> __device__ __forceinline__ void pv_one(f32x16& od, int vb, bf16x8 pa0, bf16x8 pa1, bf16x8 pa2, bf16x8 pa3) {
    const s16x4 l0 = tr_read<v_rd_off(D0, 0, 0)>(vb), h0 = tr_read<v_rd_off(D0, 0, 1)>(vb), l1 = tr_read<v_rd_off(D0, 1, 0)>(vb), h1 = tr_read<v_rd_off(D0, 1, 1)>(vb);
    const s16x4 l2 = tr_read<v_rd_off(D0, 2, 0)>(vb), h2 = tr_read<v_rd_off(D0, 2, 1)>(vb), l3 = tr_read<v_rd_off(D0, 3, 0)>(vb), h3 = tr_read<v_rd_off(D0, 3, 1)>(vb);
    asm volatile("s_waitcnt lgkmcnt(0)" ::: "memory"); SBAR();
#define PK(L, H) (bf16x8){L[0], L[1], L[2], L[3], H[0], H[1], H[2], H[3]}
    od = __builtin_amdgcn_mfma_f32_32x32x16_bf16(pa0, PK(l0, h0), od, 0, 0, 0);
    od = __builtin_amdgcn_mfma_f32_32x32x16_bf16(pa1, PK(l1, h1), od, 0, 0, 0);
    od = __builtin_amdgcn_mfma_f32_32x32x16_bf16(pa2, PK(l2, h2), od, 0, 0, 0);
    od = __builtin_amdgcn_mfma_f32_32x32x16_bf16(pa3, PK(l3, h3), od, 0, 0, 0);
#undef PK
}
__device__ __forceinline__ void qkt(f32x16& p0, f32x16& p1, const LAS unsigned char* Ks, const bf16x8 (&qr)[8], int r32, int hi) {
    p0 = f32x16{}; p1 = f32x16{};
#pragma unroll
    for (int d0 = 0; d0 < 8; ++d0) { const int cb = (d0 * 16 + hi * 8) * 2;
        const bf16x8 b0 = *(const LAS bf16x8*)(Ks + KSWZ(r32, cb)); const bf16x8 b1 = *(const LAS bf16x8*)(Ks + KSWZ(32 + r32, cb));
        p0 = __builtin_amdgcn_mfma_f32_32x32x16_bf16(b0, qr[d0], p0, 0, 0, 0); p1 = __builtin_amdgcn_mfma_f32_32x32x16_bf16(b1, qr[d0], p1, 0, 0, 0); }
}
__device__ __forceinline__ void sb_half(f32x16& p, float& R, int hi, bool need_mask, int kpos0, int qpos) {
    f32x16 st;
#pragma unroll
    for (int r = 0; r < 16; ++r) { const float zz = fmaxf(p[r], -120.f); const float e = __builtin_amdgcn_exp2f(-zz); float bt = __builtin_amdgcn_rcpf(1.f + e); float s = e * bt;
        if (need_mask) { const bool valid = (kpos0 + crow(r, hi)) < qpos; s = valid ? s : 1.f; bt = valid ? bt : 0.f; }
        p[r] = bt; st[r] = s; }
    float x1[4], x2[4], x3[4], c[4], f[4];
#pragma unroll
    for (int q = 0; q < 4; ++q) { x3[q] = st[4 * q + 3]; x2[q] = x3[q] * st[4 * q + 2]; x1[q] = x2[q] * st[4 * q + 1]; const float pq = x1[q] * st[4 * q];
        const auto rr = __builtin_amdgcn_permlane32_swap(__float_as_uint(pq), __float_as_uint(pq), false, false);
        const float v0 = __uint_as_float(rr[0]), v1 = __uint_as_float(rr[1]); c[q] = v0 * v1; f[q] = hi ? 1.f : v1; }
    const float S3 = R, S2 = S3 * c[3], S1 = S2 * c[2], S0 = S1 * c[1]; R = S0 * c[0];
    R = R < 7.8886e-31f ? 0.f : R;
    const float T[4] = {S0 * f[0], S1 * f[1], S2 * f[2], S3 * f[3]};
#pragma unroll
    for (int q = 0; q < 4; ++q) { p[4 * q + 3] *= T[q]; p[4 * q + 2] *= T[q] * x3[q]; p[4 * q + 1] *= T[q] * x2[q]; p[4 * q] *= T[q] * x1[q]; }
}
#define PK4(P, BASE, OUT) do { const unsigned a0 = cvtpk(P[BASE + 0], P[BASE + 1]), a1 = cvtpk(P[BASE + 2], P[BASE + 3]);   \
    const unsigned b0 = cvtpk(P[BASE + 4], P[BASE + 5]), b1 = cvtpk(P[BASE + 6], P[BASE + 7]);                              \
    const auto r0 = __builtin_amdgcn_permlane32_swap(a0, b0, false, false); const auto r1 = __builtin_amdgcn_permlane32_swap(a1, b1, false, false); \
    u32x4 w_ = {r0[0], r1[0], r0[1], r1[1]}; OUT = *reinterpret_cast<bf16x8*>(&w_); } while (0)
template <bool SAMPLE>
__device__ __forceinline__ void attn_unit(Frame& F, int l, int b, int h, int qb) {
    const int tid = opq(F.tid), wid = F.wave, lane = tid & 63, r32 = lane & 31, hi = lane >> 5;
    const LAS unsigned char* Kl = F.lds + A_KOFF; LAS unsigned char* Vl = F.lds + A_VOFF;
    const bool active = SAMPLE ? (wid < 2) : true;
    const int nt = SAMPLE ? 33 : 4 * qb + 4;
    const int wrow_lo = SAMPLE ? 2048 + 32 * wid : 256 * qb + 32 * wid;
    const int qpos = wrow_lo + r32;
    const size_t qrow = SAMPLE ? (size_t)(MP + b * 64 + 32 * wid + r32) : (size_t)(b * 2048 + qpos);
    const bf16* Qp = (const bf16*)(F.ws + W_Q) + qrow * 1024 + h * 128 + hi * 8;
    bf16x8 qr[8];
    if (active) {
#pragma unroll
        for (int d0 = 0; d0 < 8; ++d0) qr[d0] = *(const bf16x8*)(Qp + d0 * 16);
    } else {
#pragma unroll
        for (int d0 = 0; d0 < 8; ++d0) qr[d0] = bf16x8{};
    }
    f32x16 o[4] = {}; float R = 1.f;
    const int sr = tid >> 4, sc = (tid & 15) * 8, vst0 = v_st(sr, sc), vst1 = v_st(32 + sr, sc);
    const int vb0 = (int)(unsigned)(uintptr_t)Vl + v_rd_base(lane);
    const bf16* Kb = (const bf16*)(F.ws + W_K); const bf16* Vb = (const bf16*)(F.ws + W_V);
    const float* nk = F.out + OUT_KS + ((size_t)(l * 32 + b) * 64) * 1024 + h * 128; const float* nv = F.out + OUT_VS + ((size_t)(l * 32 + b) * 64) * 1024 + h * 128;
    const float* ckb = F.ck + ((size_t)(l * 32 + b) * 2048) * 1024 + h * 128; const float* cvb = F.cv + ((size_t)(l * 32 + b) * 2048) * 1024 + h * 128;
#define TILE_POS(j) (SAMPLE ? ((j) == 0 ? 2048 : 2048 - 64 * (j)) : 64 * (nt - 1 - (j)))
    f32x8v fk0, fk1, fv0, fv1; bf16x8 bk0, bk1, bv0, bv1;
#define SLOAD(j) do { if constexpr (SAMPLE) { const float* kp = (j) == 0 ? nk : ckb + (size_t)(2048 - 64 * (j)) * 1024; const float* vp = (j) == 0 ? nv : cvb + (size_t)(2048 - 64 * (j)) * 1024; \
        fk0 = *(const f32x8v*)(kp + (size_t)sr * 1024 + sc); fk1 = *(const f32x8v*)(kp + (size_t)(32 + sr) * 1024 + sc); fv0 = *(const f32x8v*)(vp + (size_t)sr * 1024 + sc); fv1 = *(const f32x8v*)(vp + (size_t)(32 + sr) * 1024 + sc); } \
    else { const size_t ro = ((size_t)(b * 2048 + TILE_POS(j) + sr)) * 1024 + h * 128 + sc; bk0 = *(const bf16x8*)(Kb + ro); bk1 = *(const bf16x8*)(Kb + ro + 32 * 1024); bv0 = *(const bf16x8*)(Vb + ro); bv1 = *(const bf16x8*)(Vb + ro + 32 * 1024); } } while (0)
#define TOBF(x) ({ u32x4 w__ = {cvtpk(x[0], x[1]), cvtpk(x[2], x[3]), cvtpk(x[4], x[5]), cvtpk(x[6], x[7])}; *reinterpret_cast<bf16x8*>(&w__); })
#define SWRITE(bufi) do { LAS unsigned char* vd = Vl + (bufi) * A_TILE; LAS unsigned char* kd = (LAS unsigned char*)Kl + (bufi) * A_TILE; const int kc = sc * 2; \
        if constexpr (SAMPLE) { *(LAS bf16x8*)(vd + vst0) = TOBF(fv0); *(LAS bf16x8*)(vd + vst1) = TOBF(fv1); *(LAS bf16x8*)(kd + KSWZ(sr, kc)) = TOBF(fk0); *(LAS bf16x8*)(kd + KSWZ(32 + sr, kc)) = TOBF(fk1); } \
        else { *(LAS bf16x8*)(vd + vst0) = bv0; *(LAS bf16x8*)(vd + vst1) = bv1; *(LAS bf16x8*)(kd + KSWZ(sr, kc)) = bk0; *(LAS bf16x8*)(kd + KSWZ(32 + sr, kc)) = bk1; } } while (0)
    volatile LAS unsigned* dflag = F.MISC + 16;
    SLOAD(0); asm volatile("s_waitcnt vmcnt(0)" ::: "memory"); SWRITE(0); __syncthreads();
    for (int j = 0; j < nt; ++j) {
        if (j > 0) {
            unsigned alld = 1u;
#pragma unroll
            for (int w = 0; w < 8; ++w) alld &= dflag[((j - 1) & 1) * 8 + w];
            if (alld) break;
        }
        if (j + 1 < nt) SLOAD(j + 1);
        const int kpos0 = TILE_POS(j);
        if (active && kpos0 < wrow_lo + 31) {
            f32x16 p0, p1; bf16x8 pa0, pa1, pa2, pa3;
            qkt(p0, p1, Kl + (j & 1) * A_TILE, qr, r32, hi);
            const bool need_mask = !(kpos0 + 63 < wrow_lo);
            sb_half(p1, R, hi, need_mask, kpos0 + 32, qpos);
            sb_half(p0, R, hi, need_mask, kpos0, qpos);
            PK4(p0, 0, pa0); PK4(p0, 8, pa1); PK4(p1, 0, pa2); PK4(p1, 8, pa3);
            const int vb = vb0 + (j & 1) * A_TILE;
            pv_one<0>(o[0], vb, pa0, pa1, pa2, pa3); pv_one<1>(o[1], vb, pa0, pa1, pa2, pa3); pv_one<2>(o[2], vb, pa0, pa1, pa2, pa3); pv_one<3>(o[3], vb, pa0, pa1, pa2, pa3);
        }
        { const bool wdone = !active || __all(R == 0.f); if (lane == 0) dflag[(j & 1) * 8 + wid] = wdone ? 1u : 0u; }
        if (j + 1 < nt) { asm volatile("s_waitcnt vmcnt(0)" ::: "memory"); SWRITE((j + 1) & 1); }
        __syncthreads();
    }
    if (active) {
        bf16* Ow = (bf16*)(F.ws + W_ATT) + (SAMPLE ? (size_t)(MP + b * 64 + 32 * wid) : (size_t)(b * 2048 + wrow_lo)) * 1024 + h * 128 + r32;
#pragma unroll
        for (int r = 0; r < 16; ++r) { const int orow = crow(r, hi);
#pragma unroll
            for (int d0 = 0; d0 < 4; ++d0) Ow[(size_t)orow * 1024 + d0 * 32] = (bf16)f2bf(o[d0][r]); }
    }
#undef SLOAD
#undef SWRITE
#undef TILE_POS
}
__device__ __forceinline__ void sgu_unit(Frame& F, int l, int tile, int g) {
    const int tid = opq(F.tid), wid = F.wave, lane = tid & 63, r32 = lane & 31, hi = lane >> 5;
    const int row0 = tile * 128; const bool samp = row0 >= MP;
    const float* VS = (const float*)(F.ws + W_VS); const float* SSV = (const float*)(F.ws + W_SSV); const bf16* U = (const bf16*)(F.ws + W_U); bf16* BB = (bf16*)(F.ws + W_BB);
    const bf16* WM = (const bf16*)(F.ws + W_WM) + ((size_t)(l * 2 + (samp ? 1 : 0)) * 8 + g) * 16384;
    const int sr = tid >> 4, sc = (tid & 15) * 8, rg = wid & 3, ch = wid >> 2;
    f32x8v vv[4]; f32x4 sl[4][4];
#pragma unroll
    for (int i = 0; i < 4; ++i) { const size_t grow = (size_t)(row0 + sr + 32 * i); vv[i] = *(const f32x8v*)(VS + grow * 1024 + g * 128 + sc);
#pragma unroll
        for (int j = 0; j < 4; ++j) sl[i][j] = *(const f32x4*)(SSV + grow * 16 + j * 4); }
    const f32x8v gv = *(const f32x8v*)(F.sgun + l * 1024 + g * 128 + sc);
    const bf16* wrow = WM + ((size_t)(rg * 32 + r32)) * 128 + hi * 8;
    bf16x8 pa[2][4];
#pragma unroll
    for (int kt = 0; kt < 2; ++kt)
#pragma unroll
        for (int ks = 0; ks < 4; ++ks) pa[kt][ks] = *(const bf16x8*)(wrow + kt * 64 + ks * 16);
    unsigned short uu[16][2]; float bias[16];
#pragma unroll
    for (int r = 0; r < 16; ++r) { const int t = rg * 32 + crow(r, hi); bias[r] = F.bsp[l * 1024 + g * 128 + (samp ? (t & 63) : t)];
#pragma unroll
        for (int i = 0; i < 2; ++i) uu[r][i] = U[(size_t)(row0 + t) * 1024 + g * 128 + (2 * ch + i) * 32 + r32]; }
    float* sgo = F.out + OUT_SG + ((size_t)l * MS) * 1024;
#pragma unroll
    for (int i = 0; i < 4; ++i) { const int s = sr + 32 * i; const size_t grow = (size_t)(row0 + s);
        float q = 0.f;
#pragma unroll
        for (int j = 0; j < 4; ++j) q += (sl[i][j][0] + sl[i][j][1]) + (sl[i][j][2] + sl[i][j][3]);
        const float rr = __builtin_amdgcn_rsqf(q * (1.0f / 1024.0f) + EPS); f32x8v v = vv[i];
#pragma unroll
        for (int j = 0; j < 8; ++j) v[j] = v[j] * rr * gv[j];
        if (samp) *(f32x8v*)(sgo + (grow - MP) * 1024 + g * 128 + sc) = v;
        u32x4 w = {cvtpk(v[0], v[1]), cvtpk(v[2], v[3]), cvtpk(v[4], v[5]), cvtpk(v[6], v[7])};
        *(LAS u32x4*)(F.lds + (s >> 6) * A_TILE + v_st(s & 63, sc)) = w; }
    __syncthreads();
    const int vb0 = (int)(unsigned)(uintptr_t)F.lds + v_rd_base(lane);
    f32x16 o2[2] = {};
#pragma unroll
    for (int kt = 0; kt < 2; ++kt) { const int vb = vb0 + kt * A_TILE;
        if (ch == 0) { pv_one<0>(o2[0], vb, pa[kt][0], pa[kt][1], pa[kt][2], pa[kt][3]); pv_one<1>(o2[1], vb, pa[kt][0], pa[kt][1], pa[kt][2], pa[kt][3]); }
        else { pv_one<2>(o2[0], vb, pa[kt][0], pa[kt][1], pa[kt][2], pa[kt][3]); pv_one<3>(o2[1], vb, pa[kt][0], pa[kt][1], pa[kt][2], pa[kt][3]); } }
#pragma unroll
    for (int r = 0; r < 16; ++r) { const int t = rg * 32 + crow(r, hi);
#pragma unroll
        for (int i = 0; i < 2; ++i) { const size_t off = (size_t)(row0 + t) * 1024 + g * 128 + (2 * ch + i) * 32 + r32;
            BB[off] = (bf16)f2bf(__uint_as_float(((unsigned)uu[r][i]) << 16) * (o2[i][r] + bias[r])); } }
    __syncthreads();
}
template <bool SAMPLE>
__device__ __forceinline__ void attn_item(Frame& F, int l, int item, LAS unsigned char* pl) {
    const int lane = opq(F.tid) & 63, r32 = lane & 31, hi = lane >> 5;
    int b, h, rg, nt, wrow_lo; size_t qrow0;
    if (SAMPLE) { rg = item & 1; h = (item >> 1) & 7; b = item >> 4; nt = 33; wrow_lo = 2048 + 32 * rg; qrow0 = (size_t)(MP + b * 64 + 32 * rg); }
    else { rg = item & 63; h = (item >> 6) & 7; b = item >> 9; nt = (rg >> 1) + 1; wrow_lo = 32 * rg; qrow0 = (size_t)(b * 2048 + 32 * rg); }
    const int qpos = wrow_lo + r32;
    const bf16* Qp = (const bf16*)(F.ws + W_Q) + (qrow0 + r32) * 1024 + h * 128 + hi * 8;
    bf16x8 qr[8];
#pragma unroll
    for (int d0 = 0; d0 < 8; ++d0) qr[d0] = *(const bf16x8*)(Qp + d0 * 16);
    f32x16 o[4] = {}; float R = 1.f;
    const bf16* Kb = (const bf16*)(F.ws + W_K) + (size_t)b * 2048 * 1024 + h * 128; const bf16* Vb = (const bf16*)(F.ws + W_V) + (size_t)b * 2048 * 1024 + h * 128;
    const float* nk = F.out + OUT_KS + ((size_t)(l * 32 + b) * 64) * 1024 + h * 128; const float* nv = F.out + OUT_VS + ((size_t)(l * 32 + b) * 64) * 1024 + h * 128;
    const float* ckb = F.ck + ((size_t)(l * 32 + b) * 2048) * 1024 + h * 128; const float* cvb = F.cv + ((size_t)(l * 32 + b) * 2048) * 1024 + h * 128;
    const int vb = (int)(unsigned)(uintptr_t)pl + v_rd_base(lane);
    const int vrow = lane >> 4, vcol = (lane & 15) * 8;
    for (int j = 0; j < nt; ++j) {
        if (j > 0 && __all(R == 0.f)) break;
        const int kpos0 = SAMPLE ? (j == 0 ? 2048 : 2048 - 64 * j) : 64 * (nt - 1 - j);
        const bool need_mask = !(kpos0 + 63 < wrow_lo);
        f32x16 p0 = {}, p1 = {};
        if constexpr (SAMPLE) {
            const float* kp = (j == 0 ? nk : ckb + (size_t)kpos0 * 1024) + (size_t)r32 * 1024 + hi * 8;
#pragma unroll
            for (int half = 0; half < 2; ++half) { f32x8v kf[8];
#pragma unroll
                for (int d0 = 0; d0 < 8; ++d0) kf[d0] = *(const f32x8v*)(kp + (size_t)half * 32 * 1024 + d0 * 16);
#pragma unroll
                for (int d0 = 0; d0 < 8; ++d0) { const u32x4 w = {cvtpk(kf[d0][0], kf[d0][1]), cvtpk(kf[d0][2], kf[d0][3]), cvtpk(kf[d0][4], kf[d0][5]), cvtpk(kf[d0][6], kf[d0][7])};
                    if (half == 0) p0 = __builtin_amdgcn_mfma_f32_32x32x16_bf16(*reinterpret_cast<const bf16x8*>(&w), qr[d0], p0, 0, 0, 0);
                    else p1 = __builtin_amdgcn_mfma_f32_32x32x16_bf16(*reinterpret_cast<const bf16x8*>(&w), qr[d0], p1, 0, 0, 0); } }
        } else {
            const bf16* kp = Kb + (size_t)(kpos0 + r32) * 1024 + hi * 8; bf16x8 k0[8], k1[8];
#pragma unroll
            for (int d0 = 0; d0 < 8; ++d0) { k0[d0] = *(const bf16x8*)(kp + d0 * 16); k1[d0] = *(const bf16x8*)(kp + 32 * 1024 + d0 * 16); }
#pragma unroll
            for (int d0 = 0; d0 < 8; ++d0) { p0 = __builtin_amdgcn_mfma_f32_32x32x16_bf16(k0[d0], qr[d0], p0, 0, 0, 0); p1 = __builtin_amdgcn_mfma_f32_32x32x16_bf16(k1[d0], qr[d0], p1, 0, 0, 0); }
        }
        bf16x8 vv[16]; f32x8v vf[8];
        if constexpr (!SAMPLE) { const bf16* vp = Vb + (size_t)(kpos0 + vrow) * 1024 + vcol;
#pragma unroll
            for (int i = 0; i < 16; ++i) vv[i] = *(const bf16x8*)(vp + (size_t)(4 * i) * 1024); }
        const float* vpf = SAMPLE ? (j == 0 ? nv : cvb + (size_t)kpos0 * 1024) + (size_t)vrow * 1024 + vcol : nullptr;
        if constexpr (SAMPLE) {
#pragma unroll
            for (int i = 0; i < 8; ++i) vf[i] = *(const f32x8v*)(vpf + (size_t)(4 * i) * 1024); }
        sb_half(p1, R, hi, need_mask, kpos0 + 32, qpos);
        sb_half(p0, R, hi, need_mask, kpos0, qpos);
        bf16x8 pa0, pa1, pa2, pa3;
        PK4(p0, 0, pa0); PK4(p0, 8, pa1); PK4(p1, 0, pa2); PK4(p1, 8, pa3);
        if constexpr (!SAMPLE) {
#pragma unroll
            for (int i = 0; i < 16; ++i) *(LAS bf16x8*)(pl + v_st(vrow + 4 * i, vcol)) = vv[i];
        } else {
#pragma unroll
            for (int i = 0; i < 8; ++i) { const u32x4 w = {cvtpk(vf[i][0], vf[i][1]), cvtpk(vf[i][2], vf[i][3]), cvtpk(vf[i][4], vf[i][5]), cvtpk(vf[i][6], vf[i][7])}; *(LAS u32x4*)(pl + v_st(vrow + 4 * i, vcol)) = w; }
#pragma unroll
            for (int i = 0; i < 8; ++i) vf[i] = *(const f32x8v*)(vpf + (size_t)(32 + 4 * i) * 1024);
#pragma unroll
            for (int i = 0; i < 8; ++i) { const u32x4 w = {cvtpk(vf[i][0], vf[i][1]), cvtpk(vf[i][2], vf[i][3]), cvtpk(vf[i][4], vf[i][5]), cvtpk(vf[i][6], vf[i][7])}; *(LAS u32x4*)(pl + v_st(32 + vrow + 4 * i, vcol)) = w; }
        }
        asm volatile("s_waitcnt lgkmcnt(0)" ::: "memory");
        pv_one<0>(o[0], vb, pa0, pa1, pa2, pa3); pv_one<1>(o[1], vb, pa0, pa1, pa2, pa3); pv_one<2>(o[2], vb, pa0, pa1, pa2, pa3); pv_one<3>(o[3], vb, pa0, pa1, pa2, pa3);
        asm volatile("" ::: "memory");
    }
#pragma unroll
    for (int r = 0; r < 16; ++r) { const int orow = crow(r, hi);
#pragma unroll
        for (int d0 = 0; d0 < 4; ++d0) *(LAS unsigned short*)(pl + orow * 272 + (d0 * 32 + r32) * 2) = (unsigned short)f2bf(o[d0][r]); }
    asm volatile("s_waitcnt lgkmcnt(0)" ::: "memory");
    bf16* Ow = (bf16*)(F.ws + W_ATT) + qrow0 * 1024 + h * 128;
#pragma unroll
    for (int i = 0; i < 8; ++i) { const int idx = lane + 64 * i, row = idx >> 4, c16 = idx & 15; const u32x4 w = *(const LAS u32x4*)(pl + row * 272 + c16 * 16); *(u32x4*)(Ow + (size_t)row * 1024 + c16 * 8) = w; }
    asm volatile("s_waitcnt lgkmcnt(0)" ::: "memory");
}
__device__ __forceinline__ int v_st_c(int k, int c) { const int kk = (k & ~0xC) | ((k & 4) << 1) | ((k & 8) >> 1); return (kk >> 3) * 512 + ((kk & 7) * 32 + c) * 2; }
template <int KT> __device__ __forceinline__ void pv_c(f32x16& od, int vb, bf16x8 pa0, bf16x8 pa1, bf16x8 pa2, bf16x8 pa3) {
    const s16x4 l0 = tr_read<KT * 4096 + 0>(vb), h0 = tr_read<KT * 4096 + 512>(vb), l1 = tr_read<KT * 4096 + 1024>(vb), h1 = tr_read<KT * 4096 + 1536>(vb);
    const s16x4 l2 = tr_read<KT * 4096 + 2048>(vb), h2 = tr_read<KT * 4096 + 2560>(vb), l3 = tr_read<KT * 4096 + 3072>(vb), h3 = tr_read<KT * 4096 + 3584>(vb);
    asm volatile("s_waitcnt lgkmcnt(0)" ::: "memory"); SBAR();
#define PK(L, H) (bf16x8){L[0], L[1], L[2], L[3], H[0], H[1], H[2], H[3]}
    od = __builtin_amdgcn_mfma_f32_32x32x16_bf16(pa0, PK(l0, h0), od, 0, 0, 0);
    od = __builtin_amdgcn_mfma_f32_32x32x16_bf16(pa1, PK(l1, h1), od, 0, 0, 0);
    od = __builtin_amdgcn_mfma_f32_32x32x16_bf16(pa2, PK(l2, h2), od, 0, 0, 0);
    od = __builtin_amdgcn_mfma_f32_32x32x16_bf16(pa3, PK(l3, h3), od, 0, 0, 0);
#undef PK
}
__device__ __forceinline__ void sgu_item(Frame& F, int l, int item, LAS unsigned char* pl) {
    const int lane = opq(F.tid) & 63, r32 = lane & 31, hi = lane >> 5;
    const int cs = item & 3, g = (item >> 2) & 7, tile = item >> 5, row0 = tile * 128; const bool samp = row0 >= MP;
    const int cb = g * 128 + cs * 32;
    const float* VS = (const float*)(F.ws + W_VS); const float* SSV = (const float*)(F.ws + W_SSV); const bf16* U = (const bf16*)(F.ws + W_U); bf16* BB = (bf16*)(F.ws + W_BB);
    const bf16* WM = (const bf16*)(F.ws + W_WM) + ((size_t)(l * 2 + (samp ? 1 : 0)) * 8 + g) * 16384;
    LAS float* rst = (LAS float*)(pl + 8192); LAS float* bia = (LAS float*)(pl + 8704);
    f32x4 sl[2][4];
#pragma unroll
    for (int i = 0; i < 2; ++i)
#pragma unroll
        for (int k = 0; k < 4; ++k) sl[i][k] = *(const f32x4*)(SSV + (size_t)(row0 + lane + 64 * i) * 16 + k * 4);
    const float b0 = F.bsp[l * 1024 + g * 128 + (samp ? (lane & 63) : lane)], b1 = F.bsp[l * 1024 + g * 128 + (samp ? (lane & 63) : lane + 64)];
    const int srow = lane >> 3, col4 = (lane & 7) * 4;
    f32x4 vv[16];
#pragma unroll
    for (int i = 0; i < 16; ++i) vv[i] = *(const f32x4*)(VS + (size_t)(row0 + srow + 8 * i) * 1024 + cb + col4);
    const f32x4 gv = *(const f32x4*)(F.sgun + l * 1024 + cb + col4);
#pragma unroll
    for (int i = 0; i < 2; ++i) { float q = 0.f;
#pragma unroll
        for (int k = 0; k < 4; ++k) q += (sl[i][k][0] + sl[i][k][1]) + (sl[i][k][2] + sl[i][k][3]);
        rst[lane + 64 * i] = __builtin_amdgcn_rsqf(q * (1.0f / 1024.0f) + EPS); }
    bia[lane] = b0; bia[lane + 64] = b1;
    asm volatile("s_waitcnt lgkmcnt(0)" ::: "memory");
    float* sgo = F.out + OUT_SG + ((size_t)l * MS) * 1024;
#pragma unroll
    for (int i = 0; i < 16; ++i) { const int s = srow + 8 * i; f32x4 v = vv[i] * rst[s] * gv;
        if (samp) *(f32x4*)(sgo + (size_t)(row0 + s - MP) * 1024 + cb + col4) = v;
        u32x2 w; w.x = cvtpk(v[0], v[1]); w.y = cvtpk(v[2], v[3]); *(LAS u32x2*)(pl + (s >> 6) * 4096 + v_st_c(s & 63, col4)) = w; }
    asm volatile("s_waitcnt lgkmcnt(0)" ::: "memory");
    const int vb = (int)(unsigned)(uintptr_t)pl + v_rd_base(lane);
#pragma unroll
    for (int rg = 0; rg < 4; ++rg) {
        const bf16* wrow = WM + ((size_t)(rg * 32 + r32)) * 128 + hi * 8; bf16x8 pa[2][4];
#pragma unroll
        for (int kt = 0; kt < 2; ++kt)
#pragma unroll
            for (int ks = 0; ks < 4; ++ks) pa[kt][ks] = *(const bf16x8*)(wrow + kt * 64 + ks * 16);
        unsigned short uu[16];
#pragma unroll
        for (int r = 0; r < 16; ++r) uu[r] = U[(size_t)(row0 + rg * 32 + crow(r, hi)) * 1024 + cb + r32];
        f32x16 o2 = {};
        pv_c<0>(o2, vb, pa[0][0], pa[0][1], pa[0][2], pa[0][3]); pv_c<1>(o2, vb, pa[1][0], pa[1][1], pa[1][2], pa[1][3]);
#pragma unroll
        for (int r = 0; r < 16; ++r) { const int t = rg * 32 + crow(r, hi);
            BB[(size_t)(row0 + t) * 1024 + cb + r32] = (bf16)f2bf(__uint_as_float(((unsigned)uu[r]) << 16) * (o2[r] + bia[t])); }
    }
    asm volatile("s_waitcnt lgkmcnt(0)" ::: "memory");
}
#ifdef TIMING
#define P2STAMP(k, bx) do { if (l == 0 && blockIdx.x == (bx) && F.tid == 0) __hip_atomic_store((gu64*)((gu32*)(F.ws + W_CTL) + 2048) + (k), (unsigned long long)wall_clock64(), RLX_AGENT); } while (0)
#else
#define P2STAMP(k, bx) do { } while (0)
#endif
__device__ __forceinline__ void p2_items(Frame& F, int l) {
    LAS unsigned char* pl = F.lds + F.wave * 16384;
    const int gw = F.vcu * NWAVES + F.wave, NGW = F.G * NWAVES;
    if (NGW == 2048) {
        if (gw < 512) { attn_item<true>(F, l, gw, pl); P2STAMP(20, 0); }
        else for (int k = 0; k < 3; ++k) { const int it = (gw - 512) + 1536 * k; if (it < 2048) attn_item<false>(F, l, it, pl); else sgu_item(F, l, it - 2048, pl); P2STAMP(21 + k, 58); }
    } else {
        for (int it = gw; it < 5120; it += NGW) { if (it < 512) attn_item<true>(F, l, it, pl); else if (it < 2560) attn_item<false>(F, l, it - 512, pl); else sgu_item(F, l, it - 2560, pl); }
    }
}
constexpr int N_PHASES = 20, PH_L = 9, PH_FINAL = 19;
#ifndef SPLIT_P3
#define SPLIT_P3 0
#endif
#ifndef SPLIT_P4
#define SPLIT_P4 0
#endif
struct Args { const float* in[17]; float* out; unsigned char* ws; int ph_lo, ph_hi, li, pad; };
__global__ void __launch_bounds__(NWAVES * 64, 2) mk_fwd(Args args) {
    extern __shared__ __attribute__((aligned(16))) unsigned char lds_raw[];
    Frame F;
    F.lds = (LAS unsigned char*)lds_raw; F.MISC = (volatile LAS unsigned*)(F.lds + MISC_OFF);
    F.tid = threadIdx.x; F.lane = F.tid & 63; F.wave = __builtin_amdgcn_readfirstlane(F.tid >> 6);
    F.G = gridDim.x; { const int bx = blockIdx.x; F.vcu = (F.G % 8 == 0) ? (bx % 8) * (F.G / 8) + bx / 8 : bx; }
    F.xp = args.in[0]; F.xs = args.in[1]; F.ck = args.in[2]; F.cv = args.in[3]; F.nmix = args.in[4]; F.win = args.in[5]; F.bgate = args.in[6]; F.sgun = args.in[7]; F.wsp = args.in[8]; F.bsp = args.in[9];
    F.wa = args.in[10]; F.wb = args.in[11]; F.wout = args.in[12]; F.nffn = args.in[13]; F.wgu = args.in[14]; F.wd = args.in[15]; F.nfin = args.in[16];
    F.out = args.out; F.ws = args.ws;
    for (int u = F.tid; u < (LDS_BYTES - LDSCTL_OFF) / 4; u += NWAVES * 64) ((LAS unsigned*)(F.lds + LDSCTL_OFF))[u] = 0u;
    __syncthreads();
    gu32* ctl = (gu32*)(F.ws + W_CTL);
    XcdBarrier bar = xcd_barrier_post((unsigned*)(ctl + CW_BAR) + args.li * XCD_BAR_WORDS, F.MISC + 8);
    const int lo = args.ph_lo, hi = args.ph_hi;
#define IN(k) (lo <= (k) && (k) < hi)
#ifdef TIMING_K
#define STAMP_PTR(p) ((p) == TIMING_K && l == 0 ? (unsigned long long*)(ctl + 3072) : nullptr)
#else
#define STAMP_PTR(p) nullptr
#endif
#ifdef TIMING
#define STAMP(k) do { if (blockIdx.x == 0 && F.tid == 0) __hip_atomic_store((gu64*)(ctl + 2048) + (k), (unsigned long long)wall_clock64(), RLX_AGENT); } while (0)
#else
#define STAMP(k) do { } while (0)
#endif
#define SEAM(k) do { if (IN(k) && IN((k) + 1)) xcd_barrier(bar); STAMP((k) + 1); } while (0)
    unsigned char* ws = F.ws;
    bf16_t* HB = (bf16_t*)(ws + W_HB); float* SS = (float*)(ws + W_SS); float* H = F.out + OUT_Y; float* myslab = (float*)(ws + W_SLAB) + (size_t)blockIdx.x * 65536;
    STAMP(0);
    if (IN(0)) p0_prologue(F);
    SEAM(0);
    for (int l = 0; l < 2; ++l) {
        const int pb = 1 + PH_L * l; unsigned char* wl = ws + W_WL + (size_t)l * WL_STRIDE;
        if (IN(pb)) {
            SchedSimple S{40, 36, F.G, (int)blockIdx.x, 2048, 2048, (const char*)HB, (const char*)(wl + WL_IN), STAMP_PTR(1)};
            EpiIn E{SS, (bf16_t*)(ws + W_Q), (bf16_t*)(ws + W_K), (bf16_t*)(ws + W_V), (bf16_t*)(ws + W_U), (bf16_t*)(ws + W_G), (float*)(ws + W_VS), F.bgate + l * 4096,
                    F.out + OUT_KP + (size_t)l * MP * 1024, F.out + OUT_VP + (size_t)l * MP * 1024, F.out + OUT_KS + (size_t)l * MS * 1024, F.out + OUT_VS + (size_t)l * MS * 1024, (float*)(ws + W_SSV)};
            pg8::gemm_phase<EpiIn, SchedSimple>(F.lds, S, E);
            if (l == 0) p0_late_weights(F, 160, L1_R0, L1_R1);
        }
        SEAM(pb);
        if (IN(pb + 1)) {
            p2_items(F, l);
        }
        SEAM(pb + 1);
        if (IN(pb + 2)) {
            SchedBranch S{40, 8, F.G, (int)blockIdx.x, 1024, 1024, (const char*)(ws + W_ATT), (const char*)(wl + WL_A), (const char*)(ws + W_BB), (const char*)(wl + WL_B), STAMP_PTR(3), SPLIT_P3};
            EpiMerge E{(const bf16_t*)(ws + W_G), (bf16_t*)(ws + W_MG), myslab};
            pg8::gemm_phase<EpiMerge, SchedBranch>(F.lds, S, E);
            if (l == 0) p0_late_weights(F, 64, L1_R1, L1_R2);
        }
        SEAM(pb + 2);
        if (SPLIT_P3) { if (IN(pb + 3)) p_fixup<1>(F, nullptr, nullptr, 0); SEAM(pb + 3); }
        const float* base_p = l == 0 ? F.xp : (const float*)H; const float* base_s = l == 0 ? F.xs : (const float*)(H + (size_t)MP * 2048);
        if (IN(pb + 4)) {
            SchedTail S{40, 8, F.G, (int)blockIdx.x, 2048, 2048, (const char*)(ws + W_MG), (const char*)(wl + WL_OUT), STAMP_PTR(4), SPLIT_P4};
            EpiRes E{base_p, base_s, H, HB, SS, 1, myslab};
            pg8::gemm_phase<EpiRes, SchedTail>(F.lds, S, E);
            if (l == 0) p0_late_weights(F, 64, L1_R2, L1_R3);
        }
        SEAM(pb + 4);
        if (SPLIT_P4) { if (IN(pb + 5)) p_fixup<0>(F, base_p, base_s, 1); SEAM(pb + 5); }
        if (IN(pb + 6)) {
            SchedSimple S{40, 44, F.G, (int)blockIdx.x, 2048, 2048, (const char*)HB, (const char*)(wl + WL_GU), STAMP_PTR(5)};
            EpiGU E{SS, (bf16_t*)(ws + W_ACT)};
            pg8::gemm_phase<EpiGU, SchedSimple>(F.lds, S, E);
            if (l == 0) p0_late_weights(F, 224, L1_R3, I_L);
        }
        SEAM(pb + 6);
        if (IN(pb + 7)) {
            SchedTail S{40, 8, F.G, (int)blockIdx.x, 5632, 5632, (const char*)(ws + W_ACT), (const char*)(wl + WL_D), STAMP_PTR(6), 1};
            EpiRes E{(const float*)H, (const float*)(H + (size_t)MP * 2048), H, HB, SS, l == 0 ? 1 : 0, myslab};
            pg8::gemm_phase<EpiRes, SchedTail>(F.lds, S, E);
        }
        SEAM(pb + 7);
        if (IN(pb + 8)) p_fixup<0>(F, (const float*)H, (const float*)(H + (size_t)MP * 2048), l == 0 ? 1 : 0);
        SEAM(pb + 8);
    }
#ifdef TIMING_K
    if (IN(PH_FINAL)) { const gu64* st = (const gu64*)(ctl + 3072); const float cyc = (float)__hip_atomic_load(st, RLX_AGENT), ns = (float)__hip_atomic_load(st + 1, RLX_AGENT) * 10.f, n = (float)__hip_atomic_load(st + 2, RLX_AGENT);
        const float c1 = rintf(cyc / n / TIMING_QC + TIMING_SHIFT), x = rintf(ns / n / TIMING_QN + TIMING_SHIFT);
        p_final(F, 1.f + c1 * TIMING_S1);
        if (blockIdx.x == 0 && F.tid == 0) F.out[OUT_KS] += x * TIMING_S2; }
#elif defined(TIMING)
    if (IN(PH_FINAL)) { p_final(F, 1.f); xcd_barrier(bar); STAMP(20);
        if (blockIdx.x == 0 && F.tid == 0) __hip_atomic_store((gu64*)(ctl + 2048) + 21, (unsigned long long)wall_clock64(), RLX_AGENT);
        xcd_barrier(bar);
        const gu64* st = (const gu64*)(ctl + 2048);
        const float t1 = (float)(__hip_atomic_load(st + TIM_A1, RLX_AGENT) - __hip_atomic_load(st + TIM_A0, RLX_AGENT)) * 0.01f, t2 = (float)(__hip_atomic_load(st + TIM_B1, RLX_AGENT) - __hip_atomic_load(st + TIM_B0, RLX_AGENT)) * 0.01f;
        const float c1 = rintf(t1 / TIMING_Q + TIMING_SHIFT), x = rintf(t2 / TIMING_Q + TIMING_SHIFT);
        { const float sc = 1.f + c1 * 0.002f; const int gw = F.vcu * NWAVES + F.wave, NGW = F.G * NWAVES;
          for (int m = MP + gw; m < M; m += NGW) { float* h = F.out + OUT_Y + (size_t)m * DM;
              for (int j = 0; j < 8; ++j) { f32x4 v = *(const f32x4*)(h + j * 256 + F.lane * 4); *(f32x4*)(h + j * 256 + F.lane * 4) = v * sc; } } }
        if (blockIdx.x == 0 && F.tid == 0) F.out[OUT_KS] += x * 0.1f; }
#else
    if (IN(PH_FINAL)) p_final(F, 1.f);
#endif
#undef IN
#undef SEAM
}
static int g_grid = 0;
static inline bool fast_setup() {
    if (g_grid == 0) {
        int dev = 0, cus = 0;
        if (hipGetDevice(&dev) != hipSuccess || hipDeviceGetAttribute(&cus, hipDeviceAttributeMultiprocessorCount, dev) != hipSuccess) { g_grid = -1; return false; }
        if (hipFuncSetAttribute((const void*)mk_fwd, hipFuncAttributeMaxDynamicSharedMemorySize, LDS_BYTES) != hipSuccess) { fprintf(stderr, "hipFuncSetAttribute failed\n"); g_grid = -1; return false; }
        int per_cu = 0; (void)hipOccupancyMaxActiveBlocksPerMultiprocessor(&per_cu, (const void*)mk_fwd, NWAVES * 64, LDS_BYTES); (void)hipGetLastError();
        if (per_cu < 1) fprintf(stderr, "note: occupancy query reports %d\n", per_cu);
        g_grid = cus;
    }
    return g_grid > 0;
}
static inline void fast_launch(hipStream_t stream, void* const* d_in, float* out, unsigned char* wsbase, int lo, int hi, int li) {
    Args a{}; for (int i = 0; i < 17; ++i) a.in[i] = (const float*)d_in[i];
    a.out = out; a.ws = wsbase; a.ph_lo = lo; a.ph_hi = hi; a.li = li; a.pad = 0;
    hipLaunchKernelGGL(mk_fwd, dim3(g_grid), dim3(NWAVES * 64), LDS_BYTES, stream, a);
}
}
extern "C" void kernel_launch(void* const* d_in, const int* in_sizes, int n_in, void* d_out, int out_size, void* d_ws, size_t ws_size, hipStream_t stream) {
    if (!fk::fast_setup()) return;
    if (n_in != 17 || out_size != (int)fk::OUT_N || ws_size < fk::W_END) { fprintf(stderr, "kernel_launch: unexpected shapes (n_in %d out %d ws %zu)\n", n_in, out_size, ws_size); return; }
    (void)hipMemsetAsync((char*)d_ws + fk::W_CTL, 0, fk::CTL_ZERO_BYTES, stream);
#if defined(PROBE_DUP)
    fk::fast_launch(stream, d_in, (float*)d_out, (unsigned char*)d_ws, 0, PROBE_DUP + 1, 0);
    fk::fast_launch(stream, d_in, (float*)d_out, (unsigned char*)d_ws, PROBE_DUP, fk::N_PHASES, 1);
#elif MK_N_LAUNCHES == 1
    fk::fast_launch(stream, d_in, (float*)d_out, (unsigned char*)d_ws, 0, fk::N_PHASES, 0);
#else
    for (int p = 0; p < fk::N_PHASES; ++p) fk::fast_launch(stream, d_in, (float*)d_out, (unsigned char*)d_ws, p, p + 1, p);
#endif
}
```
